# Optimizing an MI355X kernel written in HIP

```python
import math
import jax, jax.numpy as jnp
from jax import lax
import numpy as np

D_MODEL = 1024
BATCH = 16
SEQ = 256
DEPTH = 4
DEC_BATCH = 8
DEC_SEQ = 1024
PAST_LEN = 512

GRID_W = 64
D_BRANCH = D_MODEL // 2
S5_GROUP = 16
S5_GROUPS = D_BRANCH // S5_GROUP
S5_STATE = 64
N_DIR = 2
DH = 64
N_HEADS = D_BRANCH // (2 * DH)
DV = 2 * DH
POOL_WINDOWS = (2, 4, 8, 16)
POOL_GROUP = D_BRANCH // len(POOL_WINDOWS)
D_FF = ((8 * D_MODEL // 3 + 255) // 256) * 256
N_MOD = 9
N_BRANCH = 3
IN_W = 5 * D_BRANCH + N_BRANCH * D_MODEL
SPLITS = [D_BRANCH, 2 * D_BRANCH, 3 * D_BRANCH, 4 * D_BRANCH, 5 * D_BRANCH]
ROPE_BASE = 10000.0
EPS = 1e-6
Q_BLOCK = 128
DENSE_MAX_KEYS = 2048

kernel_name = 'hybrid_s5_diffattn_pool_diffusion_step'


def rmsnorm(x, g):
    xf = x.astype(jnp.float32)
    y = xf * lax.rsqrt(jnp.mean(xf * xf, axis=-1, keepdims=True) + EPS)
    return (y * g.astype(jnp.float32)).astype(x.dtype)


def swiglu(h, w_in, w_out):
    a, b = jnp.split(h @ w_in, 2, axis=-1)
    return (jax.nn.silu(a) * b) @ w_out


def adaln(cvec, w_mod, b_mod):
    m = jax.nn.silu(cvec) @ w_mod + b_mod
    return m.reshape(cvec.shape[0], 1, N_MOD, D_MODEL)


def axial_rope_tables(L):
    rows = L // GRID_W
    row = jnp.repeat(jnp.arange(rows, dtype=jnp.float32), GRID_W)
    col = jnp.tile(jnp.arange(GRID_W, dtype=jnp.float32), rows)
    n_freq = DH // 4
    inv = ROPE_BASE ** (-jnp.arange(n_freq, dtype=jnp.float32) / n_freq)
    ar = row[:, None] * inv
    ac = col[:, None] * inv
    return jnp.cos(ar), jnp.sin(ar), jnp.cos(ac), jnp.sin(ac)


def apply_rope(x, tabs):
    cr, sr, cc, sc = [t[None, :, None, None, :].astype(x.dtype) for t in tabs]

    def rot(y, cs, sn):
        y1, y2 = jnp.split(y, 2, axis=-1)
        return jnp.concatenate([y1 * cs - y2 * sn, y2 * cs + y1 * sn], axis=-1)

    xr, xc = jnp.split(x, 2, axis=-1)
    return jnp.concatenate([rot(xr, cr, sr), rot(xc, cc, sc)], axis=-1)


def cmul(ar, ai, br, bi):
    return ar * br - ai * bi, ar * bi + ai * br


def scan_combine(e1, e2):
    a1r, a1i, b1r, b1i = e1
    a2r, a2i, b2r, b2i = e2
    ar, ai = cmul(a2r, a2i, a1r, a1i)
    br, bi = cmul(a2r, a2i, b1r, b1i)
    return ar, ai, br + b2r, bi + b2i


def s5_mixer(u, lam_re, lam_im, log_dt, b_re, b_im, c_re, c_im, d_skip, w_glu, h0):
    f32 = jnp.float32
    bsz, L, _ = u.shape
    uf = u.astype(f32).reshape(bsz, L, S5_GROUPS, S5_GROUP)
    y = uf * d_skip.astype(f32).reshape(S5_GROUPS, S5_GROUP)
    finals = []
    for d in range(N_DIR):
        lr = lam_re[d].astype(f32)
        li = lam_im[d].astype(f32)
        dt = jnp.exp(log_dt[d].astype(f32))[:, None]
        mag = jnp.exp(lr * dt)
        abr = mag * jnp.cos(li * dt)
        abi = mag * jnp.sin(li * dt)
        den = lr * lr + li * li
        nr = abr - 1.0
        kr = (nr * lr + abi * li) / den
        ki = (abi * lr - nr * li) / den
        br = b_re[d].astype(f32)
        bi = b_im[d].astype(f32)
        bbr = kr[..., None] * br - ki[..., None] * bi
        bbi = kr[..., None] * bi + ki[..., None] * br
        xr = jnp.einsum('blgc,gpc->blgp', uf, bbr)
        xi = jnp.einsum('blgc,gpc->blgp', uf, bbi)
        ar = jnp.broadcast_to(abr, xr.shape)
        ai = jnp.broadcast_to(abi, xi.shape)
        cum_r, cum_i, hr, hi = lax.associative_scan(scan_combine, (ar, ai, xr, xi), axis=1, reverse=(d == 1))
        if h0 is None:
            end = L - 1 if d == 0 else 0
            finals.append(jnp.stack([hr[:, end], hi[:, end]], axis=1))
        else:
            h0r = h0[:, d, 0].astype(f32)[:, None]
            h0i = h0[:, d, 1].astype(f32)[:, None]
            hr = hr + cum_r * h0r - cum_i * h0i
            hi = hi + cum_r * h0i + cum_i * h0r
        y = y + jnp.einsum('gcp,blgp->blgc', c_re[d].astype(f32), hr) - jnp.einsum('gcp,blgp->blgc', c_im[d].astype(f32), hi)
    y = jax.nn.gelu(y.reshape(bsz, L, D_BRANCH)).astype(u.dtype)
    y = y * jax.nn.sigmoid(y @ w_glu)
    final = jnp.stack(finals, axis=1).astype(u.dtype) if h0 is None else None
    return y, final


def diff_attention(q, keys, vals, lam, lam_init, g):
    bsz, Lq = q.shape[0], q.shape[1]
    scale = DH ** -0.5

    def attend(qb):
        s = jnp.einsum('bqhmd,bkhmd->bhmqk', qb, keys).astype(jnp.float32) * scale
        p = jax.nn.softmax(s, axis=-1)
        a = (p[:, :, 0] - lam * p[:, :, 1]).astype(vals.dtype)
        return jnp.einsum('bhqk,bkhe->bqhe', a, vals)

    if keys.shape[1] >= DENSE_MAX_KEYS:
        nb = Lq // Q_BLOCK
        qb = jnp.moveaxis(q.reshape(bsz, nb, Q_BLOCK, N_HEADS, 2, DH), 1, 0)
        o = lax.map(attend, qb)
        o = jnp.moveaxis(o, 0, 1).reshape(bsz, Lq, N_HEADS, DV)
    else:
        o = attend(q)
    o = rmsnorm(o, g) * (1.0 - lam_init)
    return o.reshape(bsz, Lq, N_HEADS * DV)


def pool_mixer(z, w_pool, scale):
    bsz, L, _ = z.shape
    zf = z.astype(jnp.float32).reshape(bsz, L, len(POOL_WINDOWS), POOL_GROUP)
    cs = jnp.concatenate([jnp.zeros_like(zf[:, :1]), jnp.cumsum(zf, axis=1)], axis=1)
    t = jnp.arange(L)
    outs = []
    for gi, w in enumerate(POOL_WINDOWS):
        lo = jnp.clip(t - w // 2, 0, L)
        hi = jnp.clip(t - w // 2 + w, 0, L)
        csg = cs[:, :, gi]
        mean = (csg[:, hi] - csg[:, lo]) / (hi - lo).astype(jnp.float32)[None, :, None]
        outs.append(mean - zf[:, :, gi])
    pooled = jnp.stack(outs, axis=2).astype(z.dtype)
    y = jnp.einsum('blgc,gcd->blgd', pooled, w_pool).reshape(bsz, L, D_BRANCH)
    return y * scale


def token_mixer(h, lp, layer_idx, ctx):
    bsz, L, _ = h.shape
    u, q, k, v, z, g = jnp.split(h @ lp['w_in'], SPLITS, axis=-1)
    q = q.reshape(bsz, L, N_HEADS, 2, DH)
    k = k.reshape(bsz, L, N_HEADS, 2, DH)
    v = v.reshape(bsz, L, N_HEADS, DV)
    f32 = jnp.float32
    lam_init = 0.8 - 0.6 * math.exp(-0.3 * layer_idx)
    lam = (jnp.exp(jnp.sum(lp['lam_q1'].astype(f32) * lp['lam_k1'].astype(f32)))
           - jnp.exp(jnp.sum(lp['lam_q2'].astype(f32) * lp['lam_k2'].astype(f32))) + lam_init)
    s5_args = (lp['lam_re'], lp['lam_im'], lp['log_dt'], lp['b_re'], lp['b_im'], lp['c_re'], lp['c_im'], lp['d_skip'], lp['w_glu'])
    if ctx is None:
        ya, s_fin = s5_mixer(u, *s5_args, None)
        yb = diff_attention(q, k, v, lam, lam_init, lp['attn_norm_g'])
        new = (k, v, s_fin)
    else:
        k_ctx, v_ctx, s_ctx = ctx
        tabs = axial_rope_tables(L)
        q = apply_rope(q, tabs)
        k = apply_rope(k, tabs)
        ya, _ = s5_mixer(u, *s5_args, s_ctx)
        yb = diff_attention(q, jnp.concatenate([k, k_ctx], axis=1), jnp.concatenate([v, v_ctx], axis=1),
                            lam, lam_init, lp['attn_norm_g'])
        new = None
    yc = pool_mixer(z, lp['w_pool'], lp['pool_scale'])
    ys = jnp.stack([ya, yb, yc], axis=2)
    gates = jax.nn.sigmoid(g.reshape(bsz, L, N_BRANCH, D_MODEL))
    merged = jnp.sum(gates * jnp.einsum('blnc,ncd->blnd', ys, lp['w_branch']), axis=2)
    return merged @ lp['w_out'], new


def trunk_layer(x, mod, lp, layer_idx, ctx):
    ng = lp['norm_g']
    n = rmsnorm(x, ng[0]) * (1.0 + mod[..., 1, :]) + mod[..., 0, :]
    x = x + 0.5 * mod[..., 2, :] * swiglu(n, lp['w_ffn_in'][0], lp['w_ffn_out'][0])
    n = rmsnorm(x, ng[1]) * (1.0 + mod[..., 4, :]) + mod[..., 3, :]
    y, new = token_mixer(n, lp, layer_idx, ctx)
    x = x + mod[..., 5, :] * y
    n = rmsnorm(x, ng[2]) * (1.0 + mod[..., 7, :]) + mod[..., 6, :]
    x = x + 0.5 * mod[..., 8, :] * swiglu(n, lp['w_ffn_in'][1], lp['w_ffn_out'][1])
    return x, new


def setup_inputs(seed: int = 0) -> dict:
    key = jax.random.key(seed)
    keys = list(jax.random.split(key, 40))
    f32 = jnp.float32

    def nrm(shape, s):
        return jax.random.normal(keys.pop(), shape, f32) * s

    G, P = S5_GROUPS, S5_STATE
    return {
        'x_prompt': nrm((BATCH, SEQ, D_MODEL), 1.0),
        'x_sample': nrm((DEC_BATCH, DEC_SEQ, D_MODEL), 1.0),
        'cache_k': nrm((DEC_BATCH, DEPTH, PAST_LEN, N_HEADS, 2, DH), 1.0),
        'cache_v': nrm((DEC_BATCH, DEPTH, PAST_LEN, N_HEADS, DV), 1.0),
        'state_ssm': nrm((DEC_BATCH, DEPTH, N_DIR, 2, G, P), 0.3),
        'c': nrm((DEC_BATCH, D_MODEL), 1.0),
        'c_ctx': nrm((D_MODEL,), 1.0),
        'norm_g': 1.0 + nrm((DEPTH, 3, D_MODEL), 0.02),
        'w_mod': nrm((DEPTH, D_MODEL, N_MOD * D_MODEL), 0.3 * D_MODEL ** -0.5),
        'b_mod': nrm((DEPTH, N_MOD * D_MODEL), 0.02),
        'w_ffn_in': nrm((DEPTH, 2, D_MODEL, 2 * D_FF), D_MODEL ** -0.5),
        'w_ffn_out': nrm((DEPTH, 2, D_FF, D_MODEL), D_FF ** -0.5),
        'w_in': nrm((DEPTH, D_MODEL, IN_W), D_MODEL ** -0.5),
        'ssm_lam_re': -0.5 + nrm((DEPTH, N_DIR, G, P), 0.01),
        'ssm_lam_im': jnp.pi * jnp.arange(P, dtype=f32) + nrm((DEPTH, N_DIR, G, P), 0.01),
        'ssm_log_dt': jax.random.uniform(keys.pop(), (DEPTH, N_DIR, G), f32, math.log(1e-3), math.log(1e-1)),
        'ssm_b_re': nrm((DEPTH, N_DIR, G, P, S5_GROUP), (2 * S5_GROUP) ** -0.5),
        'ssm_b_im': nrm((DEPTH, N_DIR, G, P, S5_GROUP), (2 * S5_GROUP) ** -0.5),
        'ssm_c_re': nrm((DEPTH, N_DIR, G, S5_GROUP, P), 0.5),
        'ssm_c_im': nrm((DEPTH, N_DIR, G, S5_GROUP, P), 0.5),
        'ssm_d': nrm((DEPTH, D_BRANCH), 0.5),
        'w_glu': nrm((DEPTH, D_BRANCH, D_BRANCH), D_BRANCH ** -0.5),
        'lam_q1': nrm((DEPTH, DH), 0.1),
        'lam_k1': nrm((DEPTH, DH), 0.1),
        'lam_q2': nrm((DEPTH, DH), 0.1),
        'lam_k2': nrm((DEPTH, DH), 0.1),
        'attn_norm_g': 1.0 + nrm((DEPTH, DV), 0.02),
        'w_pool': nrm((DEPTH, len(POOL_WINDOWS), POOL_GROUP, POOL_GROUP), POOL_GROUP ** -0.5),
        'pool_scale': 1.0 + nrm((DEPTH, D_BRANCH), 0.02),
        'w_branch': nrm((DEPTH, N_BRANCH, D_BRANCH, D_MODEL), D_BRANCH ** -0.5),
        'w_out': nrm((DEPTH, D_MODEL, D_MODEL), D_MODEL ** -0.5),
        'final_norm_g': 1.0 + nrm((D_MODEL,), 0.02),
    }


def reference(x_prompt, x_sample, cache_k, cache_v, state_ssm, c, c_ctx, norm_g, w_mod, b_mod, w_ffn_in, w_ffn_out,
              w_in, ssm_lam_re, ssm_lam_im, ssm_log_dt, ssm_b_re, ssm_b_im, ssm_c_re, ssm_c_im, ssm_d, w_glu,
              lam_q1, lam_k1, lam_q2, lam_k2, attn_norm_g, w_pool, pool_scale, w_branch, w_out, final_norm_g):
    xp = x_prompt
    xs = x_sample
    new_k, new_v, new_s = [], [], []
    for l in range(DEPTH):
        lp = dict(norm_g=norm_g[l], w_ffn_in=w_ffn_in[l], w_ffn_out=w_ffn_out[l], w_in=w_in[l],
                  lam_re=ssm_lam_re[l], lam_im=ssm_lam_im[l], log_dt=ssm_log_dt[l],
                  b_re=ssm_b_re[l], b_im=ssm_b_im[l], c_re=ssm_c_re[l], c_im=ssm_c_im[l],
                  d_skip=ssm_d[l], w_glu=w_glu[l],
                  lam_q1=lam_q1[l], lam_k1=lam_k1[l], lam_q2=lam_q2[l], lam_k2=lam_k2[l],
                  attn_norm_g=attn_norm_g[l], w_pool=w_pool[l], pool_scale=pool_scale[l],
                  w_branch=w_branch[l], w_out=w_out[l])
        mod_ctx = adaln(c_ctx[None, :], w_mod[l], b_mod[l])
        mod_lat = adaln(c, w_mod[l], b_mod[l])
        xp, (k_l, v_l, s_l) = trunk_layer(xp, mod_ctx, lp, l, None)
        xs, _ = trunk_layer(xs, mod_lat, lp, l, (cache_k[:, l], cache_v[:, l], state_ssm[:, l]))
        new_k.append(k_l)
        new_v.append(v_l)
        new_s.append(s_l)
    y_prompt = rmsnorm(xp, final_norm_g)
    y_sample = rmsnorm(xs, final_norm_g)
    new_cache_k = jnp.stack(new_k, axis=1)
    new_cache_v = jnp.stack(new_v, axis=1)
    new_state_ssm = jnp.stack(new_s, axis=1)
    return (y_prompt, y_sample, new_cache_k, new_cache_v, new_state_ssm)
```

```cpp
#include <hip/hip_runtime.h>
#include <hip/hip_cooperative_groups.h>
#include <cstdio>
namespace cg = cooperative_groups;

#ifndef COOP
#define COOP 1
#endif

#define LAS __attribute__((address_space(3)))
typedef unsigned short bf16_t;
typedef short bf16x8 __attribute__((ext_vector_type(8)));
typedef short s16x4 __attribute__((ext_vector_type(4)));
typedef float f32x2 __attribute__((ext_vector_type(2)));
typedef float f32x4 __attribute__((ext_vector_type(4)));
typedef float f32x16 __attribute__((ext_vector_type(16)));
typedef unsigned u32x4 __attribute__((ext_vector_type(4)));
typedef unsigned u32x2 __attribute__((ext_vector_type(2)));
typedef __bf16 nbf16x2 __attribute__((ext_vector_type(2)));
#define DI __device__ __forceinline__

constexpr int T_CTX = 4096, T_ALL = 12288, DM = 1024, DFF = 2816, INW = 5632, NPH = 50;
constexpr size_t OFF_X = 0;
constexpr size_t OFF_N = OFF_X + 50331648;
constexpr size_t OFF_UH = OFF_N + 25165824;
constexpr size_t OFF_Q = OFF_UH + 138412032;
constexpr size_t OFF_K = OFF_Q + 12582912;
constexpr size_t OFF_V = OFF_K + 12582912;
constexpr size_t OFF_KC = OFF_V + 12582912;
constexpr size_t OFF_VC = OFF_KC + 16777216;
constexpr size_t OFF_YP = OFF_VC + 16777216;
constexpr size_t OFF_YA = OFF_YP + 50331648;
constexpr size_t OFF_YS = OFF_YA + 12582912;
constexpr size_t OFF_MOD = OFF_YS + 37748736;
constexpr size_t OFF_BB = OFF_MOD + 1327104;
constexpr size_t OFF_CM = OFF_BB + 1048576;
constexpr size_t OFF_AT = OFF_CM + 1048576;
constexpr size_t OFF_ROPE = OFF_AT + 131072;
constexpr size_t OFF_LAM = OFF_ROPE + 262144;
constexpr size_t OFF_W = OFF_LAM + 256;
constexpr size_t W_FI = 0;
constexpr size_t W_FO = W_FI + 11534336;
constexpr size_t W_IN = W_FO + 5767168;
constexpr size_t W_GLU = W_IN + 5767168;
constexpr size_t W_BR = W_GLU + 262144;
constexpr size_t W_OUT = W_BR + 1572864;
constexpr size_t W_P = W_OUT + 1048576;
constexpr size_t W_LAYER = W_P + 65536;
constexpr int LDS_BYTES = 131072;

struct Params {
  const float* in[32];
  float* out;
  unsigned char* ws;
  int ph_lo, ph_hi;
};
struct InTab { const Params* pp; __device__ __forceinline__ const float* operator[](int i) const { asm volatile("" : "+s"(i)); return pp->in[i]; } };
struct Ctx { InTab in; float* out; unsigned char* ws; };

DI int opaque_tid() { int t = threadIdx.x; asm volatile("" : "+v"(t)); return t; }
DI unsigned pk2(float lo, float hi) { f32x2 v = {lo, hi}; nbf16x2 b = __builtin_convertvector(v, nbf16x2); return __builtin_bit_cast(unsigned, b); }
DI float bf2f(unsigned short b) { return __uint_as_float(((unsigned)b) << 16); }
DI float bflo(unsigned u) { return __uint_as_float(u << 16); }
DI float bfhi(unsigned u) { return __uint_as_float(u & 0xffff0000u); }
DI float sigmoidf_(float x) { return __builtin_amdgcn_rcpf(1.f + __expf(-x)); }
DI float wave_sum(float v) {
#pragma unroll
  for (int o = 1; o < 64; o <<= 1) v += __shfl_xor(v, o);
  return v;
}
#define LDS_WAIT() asm volatile("s_waitcnt lgkmcnt(0)" ::: "memory")

namespace pg8 {
constexpr int BM = 256, BK = 64, HALF = 128, HTB = HALF * BK * 2, NXCD = 8, WGM = 8;
DI int lds_byte(int r, int c) { const int st = (r >> 4) * 2 + (c >> 5), rr = r & 15, cc = c & 31, ob = rr * 64 + cc * 2; return st * 1024 + (ob ^ (((ob >> 9) & 1) << 5)); }
DI void stage_rc(int b, int& R, int& C) { const int st = b / 1024, sb = b % 1024, swz = sb ^ (((sb >> 9) & 1) << 5); R = (st >> 1) * 16 + swz / 64; C = (st & 1) * 32 + (swz % 64) / 2; }
struct Unit { int pm, pn; };
struct Gemm { const bf16_t* A; const bf16_t* Bt; int M, N, K; };
struct StaticOrder {
  int nM, nN, nwg, G, c;
  DI void init(int M, int N, int G_, int c_) { nM = M / BM; nN = N / BM; nwg = nM * nN; G = G_; c = c_; }
  DI bool next(int i, Unit& u) const {
    const long L = (long)i * G + c; if (L >= nwg) return false;
    int wgid = (int)L; { const int q = nwg / NXCD, r = nwg % NXCD, xcd = wgid % NXCD, off = wgid / NXCD; wgid = (xcd < r ? xcd * (q + 1) : r * (q + 1) + (xcd - r) * q) + off; }
    const int nig = WGM * nN, gid = wgid / nig, fm = gid * WGM, gsz = (nM - fm) < WGM ? (nM - fm) : WGM;
    u.pm = fm + ((wgid % nig) % gsz); u.pn = (wgid % nig) / gsz; return true;
  }
};
struct BranchOrder {
  int G, c;
  DI bool next(int i, Unit& u) const { const int tile = (i / 3) * G + c; if (tile >= 192) return false; const int n = i % 3; u.pm = n * 48 + (tile >> 2); u.pn = n * 4 + (tile & 3); return true; }
};

template <class Epi, class Sched>
DI void gemm_phase(LAS unsigned char* lds, const Gemm g, const Sched& S, const Epi& E) {
  const int tid = opaque_tid(), wid = __builtin_amdgcn_readfirstlane(tid >> 6), lane = tid & 63, wr = wid >> 2, wc = wid & 3, fr = lane & 15, fq = lane >> 4;
  const int K = g.K, nt = K / BK;
  unsigned voffA[2], voffB[2];
#pragma unroll
  for (int i = 0; i < 2; ++i) { int R, C; stage_rc(tid * 16 + i * 8192, R, C); voffA[i] = (unsigned)(R * K + C) * 2u; voffB[i] = voffA[i]; }
  const size_t kstep = (size_t)(BK * 2);
  const size_t hstep = (size_t)HALF * K * 2;
  const size_t tstep = 2 * hstep;
  const unsigned ldsw = (unsigned)wid * 1024u;
  const int aoff = lds_byte(wr * 64 + fr, fq * 8), boff = lds_byte(wc * 32 + fr, fq * 8);
#define PG8_SA(b, h) (((b) * 2 + (h)) * HTB)
#define PG8_SB(b, h) ((4 + (b) * 2 + (h)) * HTB)
#define PG8_STAGE(bufoff, gbase, voff) do { _Pragma("unroll") for (int _i = 0; _i < 2; ++_i) \
    __builtin_amdgcn_global_load_lds((const unsigned*)((const char*)(gbase) + (voff)[_i]), (LAS unsigned*)(lds + (bufoff) + ldsw + _i * 8192), 16, 0, 0); } while (0)
#define PG8_LDA(dst, b, h) do { _Pragma("unroll") for (int m = 0; m < 4; ++m) _Pragma("unroll") for (int k = 0; k < 2; ++k) dst[m][k] = *(const LAS bf16x8*)(lds + PG8_SA(b, h) + aoff + m * 2048 + k * 1024); } while (0)
#define PG8_LDB(dst, b, h) do { _Pragma("unroll") for (int n = 0; n < 2; ++n) _Pragma("unroll") for (int k = 0; k < 2; ++k) dst[n][k] = *(const LAS bf16x8*)(lds + PG8_SB(b, h) + boff + n * 2048 + k * 1024); } while (0)
#define PG8_MMA(ai, bj, At, Bt) do { __builtin_amdgcn_s_setprio(1); _Pragma("unroll") for (int m = 0; m < 4; ++m) _Pragma("unroll") for (int n = 0; n < 2; ++n) _Pragma("unroll") for (int k = 0; k < 2; ++k) \
    acc[ai][bj][m][n] = __builtin_amdgcn_mfma_f32_16x16x32_bf16(Bt[n][k], At[m][k], acc[ai][bj][m][n], 0, 0, 0); __builtin_amdgcn_s_setprio(0); } while (0)
#define PG8_WAIT_V(n) asm volatile("s_waitcnt vmcnt(" #n ")" ::: "memory")
#define PG8_WAIT_L(n) asm volatile("s_waitcnt lgkmcnt(" #n ")" ::: "memory")
#define PG8_BAR __builtin_amdgcn_s_barrier()
#define PG8_SCHED __builtin_amdgcn_sched_barrier(0)
  Unit cur, nxt; int ui = 0;
  if (!S.next(0, cur)) return;
  f32x4 acc[2][2][4][2];
#pragma unroll
  for (int a = 0; a < 2; ++a)
#pragma unroll
    for (int b = 0; b < 2; ++b)
#pragma unroll
      for (int m = 0; m < 4; ++m)
#pragma unroll
        for (int n = 0; n < 2; ++n) acc[a][b][m][n] = (f32x4){0.f, 0.f, 0.f, 0.f};
  bf16x8 At[4][2], B0[2][2], B1[2][2];
  const char* cA = (const char*)g.A + (size_t)cur.pm * tstep; const char* cB = (const char*)g.Bt + (size_t)cur.pn * tstep;
  PG8_STAGE(PG8_SB(0, 0), cB, voffB); PG8_STAGE(PG8_SA(0, 0), cA, voffA); PG8_STAGE(PG8_SB(0, 1), cB + hstep, voffB); PG8_STAGE(PG8_SA(0, 1), cA + hstep, voffA);
  if (wr == 1) PG8_BAR;
  PG8_WAIT_V(4); PG8_BAR;
  PG8_STAGE(PG8_SB(1, 0), cB + kstep, voffB); PG8_STAGE(PG8_SA(1, 0), cA + kstep, voffA); PG8_STAGE(PG8_SB(1, 1), cB + hstep + kstep, voffB);
  PG8_WAIT_V(6); PG8_BAR;
  for (;;) {
    const bool has_next = S.next(ui + 1, nxt);
    const char* nA = has_next ? (const char*)g.A + (size_t)nxt.pm * tstep : cA; const char* nB = has_next ? (const char*)g.Bt + (size_t)nxt.pn * tstep : cB;
    for (int t = 0; t < nt; t += 2) {
      const bool last = (t == nt - 2);
      const char* a1 = cA + (size_t)(t + 1) * kstep;
      const char* a2 = last ? nA : cA + (size_t)(t + 2) * kstep; const char* b2 = last ? nB : cB + (size_t)(t + 2) * kstep;
      const char* a3 = a2 + kstep; const char* b3 = b2 + kstep;
      PG8_LDB(B0, 0, 0); PG8_SCHED; PG8_LDA(At, 0, 0); PG8_STAGE(PG8_SA(1, 1), a1 + hstep, voffA);
      PG8_WAIT_L(8); PG8_BAR; PG8_WAIT_L(0); PG8_MMA(0, 0, At, B0); PG8_BAR; PG8_SCHED;
      PG8_LDB(B1, 0, 1); PG8_STAGE(PG8_SB(0, 0), b2, voffB);
      PG8_BAR; PG8_WAIT_L(0); PG8_MMA(0, 1, At, B1); PG8_BAR;
      PG8_LDA(At, 0, 1); PG8_STAGE(PG8_SA(0, 0), a2, voffA);
      PG8_BAR; PG8_WAIT_L(0); PG8_MMA(1, 0, At, B0); PG8_BAR; PG8_SCHED;
      PG8_STAGE(PG8_SB(0, 1), b2 + hstep, voffB);
      PG8_WAIT_V(6); PG8_BAR; PG8_MMA(1, 1, At, B1); PG8_BAR;
      PG8_LDB(B0, 1, 0); PG8_SCHED; PG8_LDA(At, 1, 0); PG8_STAGE(PG8_SA(0, 1), a2 + hstep, voffA);
      PG8_WAIT_L(8); PG8_BAR; PG8_WAIT_L(0); PG8_MMA(0, 0, At, B0); PG8_BAR; PG8_SCHED;
      PG8_LDB(B1, 1, 1); PG8_STAGE(PG8_SB(1, 0), b3, voffB);
      PG8_BAR; PG8_WAIT_L(0); PG8_MMA(0, 1, At, B1); PG8_BAR;
      PG8_LDA(At, 1, 1); PG8_STAGE(PG8_SA(1, 0), a3, voffA);
      PG8_BAR; PG8_WAIT_L(0); PG8_MMA(1, 0, At, B0); PG8_BAR; PG8_SCHED;
      PG8_STAGE(PG8_SB(1, 1), b3 + hstep, voffB);
      PG8_WAIT_V(6); PG8_BAR; PG8_MMA(1, 1, At, B1); PG8_BAR;
    }
    E(acc, cur, wr, wc, fr, fq);
    if (!has_next) break;
#pragma unroll
    for (int a = 0; a < 2; ++a)
#pragma unroll
      for (int b = 0; b < 2; ++b)
#pragma unroll
        for (int m = 0; m < 4; ++m)
#pragma unroll
          for (int n = 0; n < 2; ++n) acc[a][b][m][n] = (f32x4){0.f, 0.f, 0.f, 0.f};
    cur = nxt; cA = nA; cB = nB; ++ui;
  }
  PG8_WAIT_V(0);
  if (wr == 0) PG8_BAR;
  PG8_BAR;
#undef PG8_SA
#undef PG8_SB
#undef PG8_STAGE
#undef PG8_LDA
#undef PG8_LDB
#undef PG8_MMA
#undef PG8_WAIT_V
#undef PG8_WAIT_L
#undef PG8_BAR
#undef PG8_SCHED
}
}
using pg8::Unit;

typedef f32x4 AccT[2][2][4][2];
DI void st_bf4(bf16_t* p, f32x4 v) { u32x2 w; w.x = pk2(v[0], v[1]); w.y = pk2(v[2], v[3]); *(u32x2*)p = w; }
DI f32x4 ld_bf4(const bf16_t* p) { const u32x2 w = *(const u32x2*)p; return (f32x4){bflo(w.x), bfhi(w.x), bflo(w.y), bfhi(w.y)}; }

struct EpiSwiglu {
  bf16_t* H;
  DI void operator()(const AccT& acc, const Unit& u, int wr, int wc, int fr, int fq) const {
    const int row0 = u.pm * 256 + wr * 64 + fr, col0 = u.pn * 128 + wc * 32 + 4 * fq;
#pragma unroll
    for (int ai = 0; ai < 2; ++ai)
#pragma unroll
      for (int m = 0; m < 4; ++m) {
        bf16_t* rowp = H + (size_t)(row0 + ai * 128 + m * 16) * DFF + col0;
#pragma unroll
        for (int n = 0; n < 2; ++n) {
          const f32x4 a = acc[ai][0][m][n], b = acc[ai][1][m][n]; f32x4 h;
#pragma unroll
          for (int j = 0; j < 4; ++j) h[j] = a[j] * sigmoidf_(a[j]) * b[j];
          st_bf4(rowp + n * 16, h);
        }
      }
  }
};
struct EpiResid {
  float* X; const float* modl; int gate_idx; float coef;
  DI void operator()(const AccT& acc, const Unit& u, int wr, int wc, int fr, int fq) const {
    const int mrow = u.pm < 16 ? 8 : ((u.pm - 16) >> 2);
    const int row0 = u.pm * 256 + wr * 64 + fr, col0 = u.pn * 256 + wc * 32 + 4 * fq;
    const float* gp = modl + (size_t)mrow * 9216 + gate_idx * 1024 + col0;
    f32x4 gv[2][2];
#pragma unroll
    for (int bj = 0; bj < 2; ++bj)
#pragma unroll
      for (int n = 0; n < 2; ++n) gv[bj][n] = *(const f32x4*)(gp + bj * 128 + n * 16) * coef;
#pragma unroll
    for (int ai = 0; ai < 2; ++ai)
#pragma unroll
      for (int m = 0; m < 4; ++m) {
        float* rowp = X + (size_t)(row0 + ai * 128 + m * 16) * DM + col0;
#pragma unroll
        for (int bj = 0; bj < 2; ++bj)
#pragma unroll
          for (int n = 0; n < 2; ++n) { f32x4* q = (f32x4*)(rowp + bj * 128 + n * 16); *q = *q + gv[bj][n] * acc[ai][bj][m][n]; }
      }
  }
};
struct EpiWin {
  bf16_t* U; bf16_t* Q; bf16_t* Kb; bf16_t* Vb; float* outk; float* outv; const float* rope; int layer;
  DI void operator()(const AccT& acc, const Unit& u, int wr, int wc, int fr, int fq) const {
    const int pn = u.pn, row0 = u.pm * 256 + wr * 64 + fr;
    const bool lat = u.pm >= 16;
    if (pn < 2 || pn >= 8) {
      const int col0 = pn * 256 + wc * 32 + 4 * fq;
#pragma unroll
      for (int ai = 0; ai < 2; ++ai)
#pragma unroll
        for (int m = 0; m < 4; ++m) {
          bf16_t* rowp = U + (size_t)(row0 + ai * 128 + m * 16) * INW + col0;
#pragma unroll
          for (int bj = 0; bj < 2; ++bj)
#pragma unroll
            for (int n = 0; n < 2; ++n) st_bf4(rowp + bj * 128 + n * 16, acc[ai][bj][m][n]);
        }
    } else if (pn < 6) {
      const bool isq = pn < 4;
      const int cq0 = (pn & 1) * 256 + wc * 32 + 4 * fq;
      const float scale = isq ? 0.125f * 1.4426950408889634f : 1.f;
      bf16_t* dstb = isq ? Q : Kb;
#pragma unroll
      for (int ai = 0; ai < 2; ++ai)
#pragma unroll
        for (int m = 0; m < 4; ++m) {
          const int row = row0 + ai * 128 + m * 16;
          f32x4 cs = {1.f, 1.f, 1.f, 1.f}, sn = {0.f, 0.f, 0.f, 0.f};
          if (lat) {
            const int pos = (row - T_CTX) & 1023;
            const float* rp = rope + (size_t)pos * 64 + ((wc & 1) * 16 + 4 * fq) * 2;
            const f32x4 r0 = *(const f32x4*)rp, r1 = *(const f32x4*)(rp + 4);
            cs = (f32x4){r0[0], r0[2], r1[0], r1[2]}; sn = (f32x4){r0[1], r0[3], r1[1], r1[3]};
          }
#pragma unroll
          for (int bj = 0; bj < 2; ++bj) {
            const f32x4 y1 = acc[ai][bj][m][0], y2 = acc[ai][bj][m][1];
            const f32x4 o1 = y1 * cs - y2 * sn, o2 = y2 * cs + y1 * sn;
            bf16_t* d = dstb + (size_t)row * 512 + cq0 + bj * 128;
            st_bf4(d, o1 * scale); st_bf4(d + 16, o2 * scale);
            if (!isq && !lat) {
              float* o = outk + ((size_t)((row >> 8) * 4 + layer) * 256 + (row & 255)) * 512 + cq0 + bj * 128;
              *(f32x4*)o = o1; *(f32x4*)(o + 16) = o2;
            }
          }
        }
    } else {
      const int cv0 = (pn & 1) * 256 + wc * 32 + 4 * fq;
#pragma unroll
      for (int ai = 0; ai < 2; ++ai)
#pragma unroll
        for (int m = 0; m < 4; ++m) {
          const int row = row0 + ai * 128 + m * 16;
#pragma unroll
          for (int bj = 0; bj < 2; ++bj)
#pragma unroll
            for (int n = 0; n < 2; ++n) {
              st_bf4(Vb + (size_t)row * 512 + cv0 + bj * 128 + n * 16, acc[ai][bj][m][n]);
              if (!lat) *(f32x4*)(outv + ((size_t)((row >> 8) * 4 + layer) * 256 + (row & 255)) * 512 + cv0 + bj * 128 + n * 16) = acc[ai][bj][m][n];
            }
        }
    }
  }
};
struct EpiGlu {
  const bf16_t* ya; bf16_t* ys0;
  DI void operator()(const AccT& acc, const Unit& u, int wr, int wc, int fr, int fq) const {
    const int row0 = u.pm * 256 + wr * 64 + fr, col0 = u.pn * 256 + wc * 32 + 4 * fq;
#pragma unroll
    for (int ai = 0; ai < 2; ++ai)
#pragma unroll
      for (int m = 0; m < 4; ++m) {
        const size_t ro = (size_t)(row0 + ai * 128 + m * 16) * 512 + col0;
#pragma unroll
        for (int bj = 0; bj < 2; ++bj)
#pragma unroll
          for (int n = 0; n < 2; ++n) {
            const f32x4 y = ld_bf4(ya + ro + bj * 128 + n * 16), a = acc[ai][bj][m][n]; f32x4 o;
#pragma unroll
            for (int j = 0; j < 4; ++j) o[j] = y[j] * sigmoidf_(a[j]);
            st_bf4(ys0 + ro + bj * 128 + n * 16, o);
          }
      }
  }
};
struct EpiBranch {
  const bf16_t* U; float* MRG; bf16_t* MERGED;
  DI void operator()(const AccT& acc, const Unit& u, int wr, int wc, int fr, int fq) const {
    const int n3 = u.pm / 48, pm = u.pm - n3 * 48, pn = u.pn & 3;
    const int row0 = pm * 256 + wr * 64 + fr, col0 = pn * 256 + wc * 32 + 4 * fq;
#pragma unroll
    for (int ai = 0; ai < 2; ++ai)
#pragma unroll
      for (int m = 0; m < 4; ++m) {
        const int row = row0 + ai * 128 + m * 16;
        const bf16_t* gp = U + (size_t)row * INW + 2560 + n3 * 1024 + col0;
        float* mp = MRG + (size_t)row * DM + col0;
        bf16_t* op = MERGED + (size_t)row * DM + col0;
#pragma unroll
        for (int bj = 0; bj < 2; ++bj)
#pragma unroll
          for (int n = 0; n < 2; ++n) {
            const f32x4 gt = ld_bf4(gp + bj * 128 + n * 16), a = acc[ai][bj][m][n]; f32x4 o;
#pragma unroll
            for (int j = 0; j < 4; ++j) o[j] = sigmoidf_(gt[j]) * a[j];
            f32x4* q = (f32x4*)(mp + bj * 128 + n * 16);
            if (n3 == 0) *q = o;
            else if (n3 == 1) *q = *q + o;
            else st_bf4(op + bj * 128 + n * 16, *q + o);
          }
      }
  }
};

DI void transpose_item(const float* W, int K, int N, bf16_t* WT, int swiglu, LAS float* scr, int item, int lane) {
  const int nblk = N / 32, kb = item / nblk, nb = item % nblk, k0 = 64 * kb, n0 = 32 * nb;
#pragma unroll 8
  for (int i = 0; i < 32; ++i) { const int kk = 2 * i + (lane >> 5); scr[kk * 33 + (lane & 31)] = W[(size_t)(k0 + kk) * N + n0 + (lane & 31)]; }
  LDS_WAIT();
  const int c = lane & 7;
#pragma unroll
  for (int j = 0; j < 4; ++j) {
    const int n = (lane >> 3) + 8 * j; const LAS float* s = scr + (8 * c) * 33 + n;
    u32x4 o; o.x = pk2(s[0 * 33], s[1 * 33]); o.y = pk2(s[2 * 33], s[3 * 33]); o.z = pk2(s[4 * 33], s[5 * 33]); o.w = pk2(s[6 * 33], s[7 * 33]);
    int dr = n0 + n;
    if (swiglu) { const int isb = dr >= DFF, hh = isb ? dr - DFF : dr; dr = (hh >> 7) * 256 + isb * 128 + (hh & 127); }
    *(u32x4*)(WT + (size_t)dr * K + k0 + 8 * c) = o;
  }
  LDS_WAIT();
}

DI void prep_phase(const Ctx& p, LAS unsigned char* lds) {
  const int tid = opaque_tid(), lane = tid & 63, wave = tid >> 6;
  unsigned char* ws = p.ws;
  for (int item = blockIdx.x; item < 144; item += gridDim.x) {
    const int l = item / 36, jc = item % 36;
    LAS float* sc = (LAS float*)lds;
    for (int i = tid; i < 9 * 1024; i += 512) { const int r = i >> 10, k = i & 1023; const float v = r < 8 ? p.in[5][r * 1024 + k] : p.in[6][k]; sc[i] = v * sigmoidf_(v); }
    __syncthreads();
    const int col = tid & 255, kh = tid >> 8, j = jc * 256 + col;
    const float* w = p.in[8] + (size_t)l * 1024 * 9216 + (size_t)(kh * 512) * 9216 + j;
    float a0 = 0, a1 = 0, a2 = 0, a3 = 0, a4 = 0, a5 = 0, a6 = 0, a7 = 0, a8 = 0;
    const LAS float* s0 = sc + kh * 512;
#pragma unroll 8
    for (int k = 0; k < 512; ++k) {
      const float wv = w[(size_t)k * 9216];
      a0 += s0[k] * wv; a1 += s0[1024 + k] * wv; a2 += s0[2048 + k] * wv; a3 += s0[3072 + k] * wv; a4 += s0[4096 + k] * wv;
      a5 += s0[5120 + k] * wv; a6 += s0[6144 + k] * wv; a7 += s0[7168 + k] * wv; a8 += s0[8192 + k] * wv;
    }
    LAS float* red = sc + 9 * 1024;
    if (kh == 1) { red[col] = a0; red[256 + col] = a1; red[512 + col] = a2; red[768 + col] = a3; red[1024 + col] = a4; red[1280 + col] = a5; red[1536 + col] = a6; red[1792 + col] = a7; red[2048 + col] = a8; }
    __syncthreads();
    if (kh == 0) {
      float* mo = (float*)(ws + OFF_MOD) + (size_t)l * 9 * 9216 + j; const float bb = p.in[9][l * 9216 + j];
      mo[0] = a0 + red[col] + bb; mo[9216] = a1 + red[256 + col] + bb; mo[2 * 9216] = a2 + red[512 + col] + bb; mo[3 * 9216] = a3 + red[768 + col] + bb;
      mo[4 * 9216] = a4 + red[1024 + col] + bb; mo[5 * 9216] = a5 + red[1280 + col] + bb; mo[6 * 9216] = a6 + red[1536 + col] + bb; mo[7 * 9216] = a7 + red[1792 + col] + bb;
      mo[8 * 9216] = a8 + red[2048 + col] + bb;
    }
    __syncthreads();
  }
  {
    LAS float* scr = (LAS float*)(lds + wave * 8448);
    const int gw = blockIdx.x * 8 + wave, NGW = gridDim.x * 8;
    constexpr int I_FI = 16 * 176, I_FO = 44 * 32, I_IN = 16 * 176, I_GLU = 8 * 16, I_BR = 8 * 32, I_OUT = 16 * 32, I_P = 2 * 4;
    constexpr int I_LAYER = 2 * I_FI + 2 * I_FO + I_IN + I_GLU + 3 * I_BR + I_OUT + 4 * I_P;
    for (int it = gw; it < 4 * I_LAYER; it += NGW) {
      const int l = it / I_LAYER; int r = it % I_LAYER;
      bf16_t* wl = (bf16_t*)(ws + OFF_W) + (size_t)l * W_LAYER;
      if (r < 2 * I_FI) { const int s = r / I_FI; transpose_item(p.in[10] + (size_t)(l * 2 + s) * 1024 * 5632, 1024, 5632, wl + W_FI + (size_t)s * 5632 * 1024, 1, scr, r % I_FI, lane); continue; } r -= 2 * I_FI;
      if (r < 2 * I_FO) { const int s = r / I_FO; transpose_item(p.in[11] + (size_t)(l * 2 + s) * 2816 * 1024, 2816, 1024, wl + W_FO + (size_t)s * 1024 * 2816, 0, scr, r % I_FO, lane); continue; } r -= 2 * I_FO;
      if (r < I_IN) { transpose_item(p.in[12] + (size_t)l * 1024 * 5632, 1024, 5632, wl + W_IN, 0, scr, r, lane); continue; } r -= I_IN;
      if (r < I_GLU) { transpose_item(p.in[21] + (size_t)l * 512 * 512, 512, 512, wl + W_GLU, 0, scr, r, lane); continue; } r -= I_GLU;
      if (r < 3 * I_BR) { const int s = r / I_BR; transpose_item(p.in[29] + (size_t)(l * 3 + s) * 512 * 1024, 512, 1024, wl + W_BR + (size_t)s * 1024 * 512, 0, scr, r % I_BR, lane); continue; } r -= 3 * I_BR;
      if (r < I_OUT) { transpose_item(p.in[30] + (size_t)l * 1024 * 1024, 1024, 1024, wl + W_OUT, 0, scr, r, lane); continue; } r -= I_OUT;
      { const int s = r / I_P; transpose_item(p.in[27] + (size_t)(l * 4 + s) * 128 * 128, 128, 128, wl + W_P + (size_t)s * 128 * 128, 0, scr, r % I_P, lane); }
    }
  }
  const size_t gt = (size_t)blockIdx.x * 512 + tid, GT = (size_t)gridDim.x * 512;
  for (size_t i = gt; i < 2 * 1048576; i += GT) {
    const int which = i >= 1048576; const size_t e = (i & 1048575) * 8;
    const float* src = (which ? p.in[3] : p.in[2]) + e;
    const f32x4 a = *(const f32x4*)src, b = *(const f32x4*)(src + 4);
    u32x4 o; o.x = pk2(a[0], a[1]); o.y = pk2(a[2], a[3]); o.z = pk2(b[0], b[1]); o.w = pk2(b[2], b[3]);
    *(u32x4*)((bf16_t*)(ws + (which ? OFF_VC : OFF_KC)) + e) = o;
  }
  for (size_t i = gt; i < 16384; i += GT) {
    const int pI = (int)(i & 63), ldg = (int)(i >> 6);
    const float lr = p.in[13][i], li = p.in[14][i], dt = expf(p.in[15][ldg]);
    const float mag = expf(lr * dt), abr = mag * cosf(li * dt), abi = mag * sinf(li * dt);
    const float den = lr * lr + li * li, nr = abr - 1.0f, kr = (nr * lr + abi * li) / den, ki = (abi * lr - nr * li) / den;
    float* at = (float*)(ws + OFF_AT) + i * 2; at[0] = abr; at[1] = abi;
    bf16_t* bbp = (bf16_t*)(ws + OFF_BB) + (size_t)ldg * 2048;
    const float* bre = p.in[16] + i * 16; const float* bim = p.in[17] + i * 16;
    for (int c = 0; c < 16; c += 2) {
      const float br0 = bre[c], bi0 = bim[c], br1 = bre[c + 1], bi1 = bim[c + 1];
      *(unsigned*)(bbp + (size_t)pI * 16 + c) = pk2(kr * br0 - ki * bi0, kr * br1 - ki * bi1);
      *(unsigned*)(bbp + (size_t)(64 + pI) * 16 + c) = pk2(kr * bi0 + ki * br0, kr * bi1 + ki * br1);
    }
    bf16_t* cmp = (bf16_t*)(ws + OFF_CM) + (size_t)ldg * 2048;
    for (int c = 0; c < 16; ++c) {
      const float cr = p.in[18][((size_t)ldg * 16 + c) * 64 + pI], ci = p.in[19][((size_t)ldg * 16 + c) * 64 + pI];
      *(unsigned*)(cmp + (size_t)c * 128 + 2 * pI) = pk2(cr, -ci);
    }
  }
  for (size_t i = gt; i < 32768; i += GT) {
    const int pos = (int)(i >> 5), j = (int)(i & 31);
    const float inv = powf(10000.0f, -(float)(j & 15) / 16.0f);
    const float ang = (float)(j < 16 ? (pos >> 6) : (pos & 63)) * inv;
    float* rp = (float*)(ws + OFF_ROPE) + i * 2; rp[0] = cosf(ang); rp[1] = sinf(ang);
  }
  if (gt < 4) {
    const int l = (int)gt; float s1 = 0.f, s2 = 0.f;
    for (int k = 0; k < 64; ++k) { s1 += p.in[22][l * 64 + k] * p.in[23][l * 64 + k]; s2 += p.in[24][l * 64 + k] * p.in[25][l * 64 + k]; }
    const float lam_init = 0.8f - 0.6f * expf(-0.3f * (float)l);
    ((float*)(ws + OFF_LAM))[l] = expf(s1) - expf(s2) + lam_init;
  }
}

DI void norm_phase(const Ctx& p, int layer, int sub, bool first, bool final_) {
  const int tid = opaque_tid(), lane = tid & 63, wave = tid >> 6;
  float* X = (float*)(p.ws + OFF_X); bf16_t* Nb = (bf16_t*)(p.ws + OFF_N);
  const int gw = blockIdx.x * 8 + wave, NGW = gridDim.x * 8;
  for (int row = gw; row < T_ALL; row += NGW) {
    const float* src = first ? (row < T_CTX ? p.in[0] + (size_t)row * DM : p.in[1] + (size_t)(row - T_CTX) * DM) : X + (size_t)row * DM;
    f32x4 v[4]; float ss = 0.f;
#pragma unroll
    for (int j = 0; j < 4; ++j) { v[j] = ((const f32x4*)src)[lane + 64 * j]; ss += (v[j][0] * v[j][0] + v[j][1] * v[j][1]) + (v[j][2] * v[j][2] + v[j][3] * v[j][3]); }
    const float rstd = 1.0f / sqrtf(wave_sum(ss) * (1.f / DM) + 1e-6f);
    if (final_) {
      const float* g = p.in[31];
#pragma unroll
      for (int j = 0; j < 4; ++j) { const f32x4 gv = ((const f32x4*)g)[lane + 64 * j]; ((f32x4*)(p.out + (size_t)row * DM))[lane + 64 * j] = v[j] * rstd * gv; }
    } else {
      const int mrow = row < T_CTX ? 8 : ((row - T_CTX) >> 10);
      const float* md = (const float*)(p.ws + OFF_MOD) + ((size_t)layer * 9 + mrow) * 9216;
      const float* sh = md + (3 * sub) * 1024; const float* sc = md + (3 * sub + 1) * 1024; const float* g = p.in[7] + (size_t)(layer * 3 + sub) * DM;
#pragma unroll
      for (int j = 0; j < 4; ++j) {
        const f32x4 gv = ((const f32x4*)g)[lane + 64 * j], sv = ((const f32x4*)sc)[lane + 64 * j], hv = ((const f32x4*)sh)[lane + 64 * j];
        const f32x4 y = v[j] * rstd * gv * (sv + 1.f) + hv;
        st_bf4(Nb + (size_t)row * DM + (lane + 64 * j) * 4, y);
        if (first) ((f32x4*)(X + (size_t)row * DM))[lane + 64 * j] = v[j];
      }
    }
  }
}

DI s16x4 tr_read(unsigned lds_addr) { s16x4 r; asm volatile("ds_read_b64_tr_b16 %0, %1\n\ts_waitcnt lgkmcnt(0)" : "=&v"(r) : "v"(lds_addr) : "memory"); return r; }
#define MFMA32(a, b, c) __builtin_amdgcn_mfma_f32_32x32x16_bf16((a), (b), (c), 0, 0, 0)
#define MFMA16(a, b, c) __builtin_amdgcn_mfma_f32_16x16x32_bf16((a), (b), (c), 0, 0, 0)

DI void attn_item(const Ctx& p, int layer, bool lat, int seq, int head, int qblk, LAS unsigned char* lds) {
  const int tid = opaque_tid(), lane = tid & 63, wave = tid >> 6, r16 = lane & 15, g4 = lane >> 4;
  unsigned char* ws = p.ws;
  const bf16_t* Qg = (const bf16_t*)(ws + OFF_Q); const bf16_t* Kg = (const bf16_t*)(ws + OFF_K); const bf16_t* Vg = (const bf16_t*)(ws + OFF_V);
  const int tok0 = lat ? T_CTX + seq * 1024 : seq * 256;
  const int n_own = lat ? 16 : 4, n_tiles = lat ? 24 : 4;
  const bf16_t* Kc = (const bf16_t*)(ws + OFF_KC) + (size_t)(seq * 4 + layer) * 512 * 512;
  const bf16_t* Vc = (const bf16_t*)(ws + OFF_VC) + (size_t)(seq * 4 + layer) * 512 * 512;
  constexpr int RS = 272;
  LAS unsigned char* Kt = lds; LAS unsigned char* Vt = lds + 64 * RS;
  const int qtok = tok0 + qblk * 128 + wave * 16 + r16;
  bf16x8 Qf[2][2];
#pragma unroll
  for (int m = 0; m < 2; ++m)
#pragma unroll
    for (int kk = 0; kk < 2; ++kk) Qf[m][kk] = *(const bf16x8*)(Qg + (size_t)qtok * 512 + head * 128 + m * 64 + g4 * 8 + 32 * kk);
  u32x4 kreg[2], vreg[2];
  auto issue = [&](int kt) {
    const bf16_t* kb; const bf16_t* vb;
    if (kt < n_own) { kb = Kg + (size_t)(tok0 + kt * 64) * 512 + head * 128; vb = Vg + (size_t)(tok0 + kt * 64) * 512 + head * 128; }
    else { kb = Kc + (size_t)((kt - n_own) * 64) * 512 + head * 128; vb = Vc + (size_t)((kt - n_own) * 64) * 512 + head * 128; }
#pragma unroll
    for (int i = 0; i < 2; ++i) { const int ci = tid + 512 * i, row = ci >> 4, part = ci & 15; kreg[i] = *(const u32x4*)(kb + (size_t)row * 512 + part * 8); vreg[i] = *(const u32x4*)(vb + (size_t)row * 512 + part * 8); }
  };
  issue(0);
  f32x4 O[2][8];
#pragma unroll
  for (int m = 0; m < 2; ++m)
#pragma unroll
    for (int d = 0; d < 8; ++d) O[m][d] = (f32x4){0.f, 0.f, 0.f, 0.f};
  float mrun[2] = {-1e30f, -1e30f}, lsum[2] = {0.f, 0.f};
  const unsigned vbase = (unsigned)(size_t)Vt;
  const int tq = r16 >> 2, tp = r16 & 3;
  for (int kt = 0; kt < n_tiles; ++kt) {
    __syncthreads();
#pragma unroll
    for (int i = 0; i < 2; ++i) { const int ci = tid + 512 * i, row = ci >> 4, part = ci & 15; *(LAS u32x4*)(Kt + row * RS + part * 16) = kreg[i]; *(LAS u32x4*)(Vt + row * RS + part * 16) = vreg[i]; }
    __syncthreads();
    if (kt + 1 < n_tiles) issue(kt + 1);
    bf16x8 P[2][2];
#pragma unroll
    for (int m = 0; m < 2; ++m) {
      f32x4 S[4];
#pragma unroll
      for (int kb = 0; kb < 4; ++kb) {
        S[kb] = (f32x4){0.f, 0.f, 0.f, 0.f};
#pragma unroll
        for (int kk = 0; kk < 2; ++kk) { const bf16x8 Kf = *(const LAS bf16x8*)(Kt + (16 * kb + r16) * RS + m * 128 + (g4 * 8 + 32 * kk) * 2); S[kb] = MFMA16(Kf, Qf[m][kk], S[kb]); }
      }
      float mx = S[0][0];
#pragma unroll
      for (int kb = 0; kb < 4; ++kb)
#pragma unroll
        for (int j = 0; j < 4; ++j) mx = fmaxf(mx, S[kb][j]);
      mx = fmaxf(mx, __shfl_xor(mx, 16)); mx = fmaxf(mx, __shfl_xor(mx, 32));
      const float mnew = fmaxf(mrun[m], mx), alpha = __builtin_amdgcn_exp2f(mrun[m] - mnew);
      mrun[m] = mnew;
      float ps = 0.f;
#pragma unroll
      for (int kb = 0; kb < 4; ++kb)
#pragma unroll
        for (int j = 0; j < 4; ++j) { S[kb][j] = __builtin_amdgcn_exp2f(S[kb][j] - mnew); ps += S[kb][j]; }
      lsum[m] = lsum[m] * alpha + ps;
#pragma unroll
      for (int d = 0; d < 8; ++d) O[m][d] *= alpha;
#pragma unroll
      for (int s = 0; s < 2; ++s) {
        u32x4 w; w.x = pk2(S[2 * s][0], S[2 * s][1]); w.y = pk2(S[2 * s][2], S[2 * s][3]); w.z = pk2(S[2 * s + 1][0], S[2 * s + 1][1]); w.w = pk2(S[2 * s + 1][2], S[2 * s + 1][3]);
        P[m][s] = __builtin_bit_cast(bf16x8, w);
      }
    }
#pragma unroll
    for (int s = 0; s < 2; ++s)
#pragma unroll
      for (int d = 0; d < 8; ++d) {
        const unsigned a0 = vbase + (32 * s + 4 * g4 + tq) * RS + (16 * d) * 2 + 8 * tp;
        const s16x4 lo = tr_read(a0), hi = tr_read(a0 + 16 * RS);
        const bf16x8 Vf = __builtin_shufflevector(lo, hi, 0, 1, 2, 3, 4, 5, 6, 7);
        O[0][d] = MFMA16(Vf, P[0][s], O[0][d]);
        O[1][d] = MFMA16(Vf, P[1][s], O[1][d]);
      }
  }
  float l1 = lsum[0], l2 = lsum[1];
  l1 += __shfl_xor(l1, 16); l1 += __shfl_xor(l1, 32); l2 += __shfl_xor(l2, 16); l2 += __shfl_xor(l2, 32);
  const float lam = ((const float*)(ws + OFF_LAM))[layer];
  const float lam_init = 0.8f - 0.6f * expf(-0.3f * (float)layer);
  const float c1 = 1.f / l1, c2 = lam / l2;
  float ss = 0.f;
#pragma unroll
  for (int d = 0; d < 8; ++d) { const f32x4 o = O[0][d] * c1 - O[1][d] * c2; O[0][d] = o; ss += (o[0] * o[0] + o[1] * o[1]) + (o[2] * o[2] + o[3] * o[3]); }
  ss += __shfl_xor(ss, 16); ss += __shfl_xor(ss, 32);
  const float rn = (1.f - lam_init) / sqrtf(ss * (1.f / 128.f) + 1e-6f);
  const float* ag = p.in[26] + layer * 128;
  bf16_t* yb = (bf16_t*)(ws + OFF_YS) + (size_t)T_ALL * 512 + (size_t)qtok * 512 + head * 128;
#pragma unroll
  for (int d = 0; d < 8; ++d) {
    const int dv = 16 * d + 4 * g4;
    const f32x4 gv = *(const f32x4*)(ag + dv);
    st_bf4(yb + dv, O[0][d] * rn * gv);
  }
}

DI void s5_item(const Ctx& p, int layer, int pairIdx, int gq, LAS unsigned char* lds) {
  const int tid = opaque_tid(), lane = tid & 63, wave = __builtin_amdgcn_readfirstlane(tid >> 6), r32 = lane & 31, h = lane >> 5;
  unsigned char* ws = p.ws;
  const int g = gq * 4 + (wave >> 1), d = wave & 1;
  const bool lat = pairIdx < 4;
  const int L = lat ? 1024 : 256, nt = L / 16;
  const int seq0 = (lat ? pairIdx : pairIdx - 4) * 2;
  const int tb0 = lat ? T_CTX + seq0 * 1024 : seq0 * 256;
  const int ldg = (layer * 2 + d) * 32 + g;
  const float* at = (const float*)(ws + OFF_AT) + (size_t)ldg * 128;
  const float a0r = at[r32 * 2], a0i = at[r32 * 2 + 1], a1r = at[(r32 + 32) * 2], a1i = at[(r32 + 32) * 2 + 1];
  float h0r = 0.f, h0i = 0.f, h1r = 0.f, h1i = 0.f;
  if (lat) {
    const float* st = p.in[4] + ((size_t)(((seq0 + h) * 4 + layer) * 2 + d) * 2) * 2048 + g * 64;
    h0r = st[r32]; h1r = st[r32 + 32]; h0i = st[2048 + r32]; h1i = st[2048 + r32 + 32];
  }
  bf16x8 BBf[4], Cmf[4];
  {
    const bf16_t* bb = (const bf16_t*)(ws + OFF_BB) + (size_t)ldg * 2048;
    const bf16_t* cm = (const bf16_t*)(ws + OFF_CM) + (size_t)ldg * 2048;
#pragma unroll
    for (int b = 0; b < 4; ++b) { BBf[b] = *(const bf16x8*)(bb + (size_t)(b * 32 + r32) * 16 + h * 8); Cmf[b] = *(const bf16x8*)(cm + (size_t)(lane & 15) * 128 + (lane >> 4) * 8 + 32 * b); }
  }
  const bf16_t* U = (const bf16_t*)(ws + OFF_UH);
  float* YP = (float*)(ws + OFF_YP);
  bf16_t* YA = (bf16_t*)(ws + OFF_YA);
  const int sA = (r32 >> 2) & 1, iA = 4 * (r32 >> 3) + (r32 & 3);
  const bf16_t* uA = U + (size_t)(tb0 + sA * L + iA) * INW + g * 16 + h * 8;
  constexpr int RS = 272;
  LAS unsigned char* hb = lds + wave * (32 * RS);
  const f32x4 dsk = *(const f32x4*)(p.in[20] + layer * 512 + g * 16 + (lane >> 4) * 4);
  __syncthreads();
  for (int n = 0; n < nt; ++n) {
    if (n == nt / 2) __syncthreads();
    const int tile = d ? nt - 1 - n : n;
    const bf16x8 Af = *(const bf16x8*)(uA + (size_t)tile * 16 * INW);
    f32x16 x0, x1, x2, x3;
#pragma unroll
    for (int i = 0; i < 16; ++i) { x0[i] = 0.f; x1[i] = 0.f; x2[i] = 0.f; x3[i] = 0.f; }
    x0 = MFMA32(Af, BBf[0], x0); x1 = MFMA32(Af, BBf[1], x1); x2 = MFMA32(Af, BBf[2], x2); x3 = MFMA32(Af, BBf[3], x3);
#define S5_STEP(i) { const float nr0 = a0r * h0r - a0i * h0i + x0[i], ni0 = a0r * h0i + a0i * h0r + x2[i]; h0r = nr0; h0i = ni0; \
                     const float nr1 = a1r * h1r - a1i * h1i + x1[i], ni1 = a1r * h1i + a1i * h1r + x3[i]; h1r = nr1; h1i = ni1; \
                     *(LAS unsigned*)(hb + (h * 16 + (i)) * RS + r32 * 4) = pk2(h0r, h0i); *(LAS unsigned*)(hb + (h * 16 + (i)) * RS + (r32 + 32) * 4) = pk2(h1r, h1i); }
    if (d == 0) {
#pragma unroll
      for (int i = 0; i < 16; ++i) S5_STEP(i)
    } else {
#pragma unroll
      for (int i = 15; i >= 0; --i) S5_STEP(i)
    }
#undef S5_STEP
    LDS_WAIT();
#pragma unroll
    for (int ss = 0; ss < 2; ++ss) {
      f32x4 y = {0.f, 0.f, 0.f, 0.f};
#pragma unroll
      for (int kb = 0; kb < 4; ++kb) { const bf16x8 Hf = *(const LAS bf16x8*)(hb + (ss * 16 + (lane & 15)) * RS + ((lane >> 4) * 8 + 32 * kb) * 2); y = MFMA16(Cmf[kb], Hf, y); }
      const int tok = tb0 + ss * L + tile * 16 + (lane & 15), ch = g * 16 + (lane >> 4) * 4;
      if (n < nt / 2) {
        *(f32x4*)(YP + ((size_t)d * T_ALL + tok) * 512 + ch) = y;
      } else {
        const f32x4 o = *(const f32x4*)(YP + ((size_t)(1 - d) * T_ALL + tok) * 512 + ch);
        const f32x4 uu = ld_bf4(U + (size_t)tok * INW + ch);
        f32x4 v = y + o + uu * dsk, r;
#pragma unroll
        for (int j = 0; j < 4; ++j) { const float t = v[j]; r[j] = t * sigmoidf_(1.5957691216057308f * (t + 0.044715f * t * t * t)); }
        st_bf4(YA + (size_t)tok * 512 + ch, r);
      }
    }
    LDS_WAIT();
  }
  if (!lat) {
    float* so = p.out + 12582912 + 8388608 + 8388608 + ((size_t)(((seq0 + h) * 4 + layer) * 2 + d) * 2) * 2048 + g * 64;
    so[r32] = h0r; so[r32 + 32] = h1r; so[2048 + r32] = h0i; so[2048 + r32 + 32] = h1i;
  }
}

DI void pool_item(const Ctx& p, int layer, int item) {
  const int tid = opaque_tid(), lane = tid & 63, wave = __builtin_amdgcn_readfirstlane(tid >> 6), r32 = lane & 31, h = lane >> 5;
  unsigned char* ws = p.ws;
  const int wi = item * 8 + wave, tt = wi >> 2, g = wi & 3, t0 = tt * 32;
  const int t = t0 + r32;
  const int sbase = t < T_CTX ? (t & ~255) : T_CTX + ((t - T_CTX) & ~1023), L = t < T_CTX ? 256 : 1024, tl = t - sbase;
  const int w = 2 << g;
  int lo = tl - (w >> 1), hi = lo + w; lo = lo < 0 ? 0 : lo; hi = hi > L ? L : hi;
  const float inv = 1.f / (float)(hi - lo);
  const bf16_t* Z = (const bf16_t*)(ws + OFF_UH) + 2048 + g * 128 + h * 8;
  bf16x8 Af[8];
#pragma unroll
  for (int kk = 0; kk < 8; ++kk) {
    float s[8];
#pragma unroll
    for (int j = 0; j < 8; ++j) s[j] = 0.f;
    for (int dt = 0; dt < w; ++dt) {
      const int tp = tl - (w >> 1) + dt; const bool ok = tp >= 0 && tp < L; const int tc = ok ? tp : tl; const float f = ok ? 1.f : 0.f;
      const u32x4 z = *(const u32x4*)(Z + (size_t)(sbase + tc) * INW + 16 * kk);
      s[0] += f * bflo(z.x); s[1] += f * bfhi(z.x); s[2] += f * bflo(z.y); s[3] += f * bfhi(z.y); s[4] += f * bflo(z.z); s[5] += f * bfhi(z.z); s[6] += f * bflo(z.w); s[7] += f * bfhi(z.w);
    }
    const u32x4 z = *(const u32x4*)(Z + (size_t)t * INW + 16 * kk);
    u32x4 o;
    o.x = pk2(s[0] * inv - bflo(z.x), s[1] * inv - bfhi(z.x)); o.y = pk2(s[2] * inv - bflo(z.y), s[3] * inv - bfhi(z.y));
    o.z = pk2(s[4] * inv - bflo(z.z), s[5] * inv - bfhi(z.z)); o.w = pk2(s[6] * inv - bflo(z.w), s[7] * inv - bfhi(z.w));
    Af[kk] = __builtin_bit_cast(bf16x8, o);
  }
  const bf16_t* Wp = (const bf16_t*)(ws + OFF_W) + (size_t)layer * W_LAYER + W_P + (size_t)g * 16384;
  bf16_t* yc = (bf16_t*)(ws + OFF_YS) + (size_t)2 * T_ALL * 512;
#pragma unroll
  for (int nb = 0; nb < 4; ++nb) {
    f32x16 acc;
#pragma unroll
    for (int i = 0; i < 16; ++i) acc[i] = 0.f;
#pragma unroll
    for (int kk = 0; kk < 8; ++kk) { const bf16x8 Bf = *(const bf16x8*)(Wp + (size_t)(nb * 32 + r32) * 128 + h * 8 + 16 * kk); acc = MFMA32(Af[kk], Bf, acc); }
    const int dcol = g * 128 + nb * 32 + r32;
    const float sc = p.in[28][layer * 512 + dcol];
#pragma unroll
    for (int i = 0; i < 16; ++i) { const int row = 8 * (i >> 2) + 4 * h + (i & 3); yc[(size_t)(t0 + row) * 512 + dcol] = (bf16_t)(pk2(acc[i] * sc, 0.f) & 0xffffu); }
  }
}

DI void mixer_item(const Ctx& p, int layer, int it, LAS unsigned char* lds) {
  if (it < 32) s5_item(p, layer, it >> 3, it & 7, lds);
  else if (it < 288) { const int j = it - 32; attn_item(p, layer, true, j >> 5, (j >> 3) & 3, j & 7, lds); }
  else if (it < 352) { const int j = it - 288; s5_item(p, layer, 4 + (j >> 3), j & 7, lds); }
  else if (it < 480) { const int j = it - 352; attn_item(p, layer, false, j >> 3, (j >> 1) & 3, j & 1, lds); }
  else pool_item(p, layer, it - 480);
}
DI void mixer_phase(const Ctx& p, int layer, LAS unsigned char* lds) {
  constexpr int NIT = 480 + 192;
  const int Gd = gridDim.x, w = blockIdx.x;
  for (int r = 0;; ++r) {
    const int it = r * Gd + ((r & 1) ? Gd - 1 - w : w);
    if (r * Gd >= NIT) break;
    if (it < NIT) mixer_item(p, layer, it, lds);
  }
}

__global__ void __launch_bounds__(512, 2) fwd_megakernel(Params p0) {
  extern __shared__ __attribute__((aligned(16))) unsigned char shm[];
  LAS unsigned char* lds = (LAS unsigned char*)shm;
  const int G = gridDim.x, c = blockIdx.x;
  for (int phi = p0.ph_lo; phi < p0.ph_hi; ++phi) {
    int ph = phi; asm volatile("" : "+s"(ph));
    Ctx p; p.in.pp = &p0; p.out = p0.out; p.ws = p0.ws;
    asm volatile("" : "+s"(p.out)); asm volatile("" : "+s"(p.ws));
    unsigned char* ws = p.ws;
    if (ph == 0) prep_phase(p, lds);
    else if (ph == NPH - 1) norm_phase(p, 0, 0, false, true);
    else {
      const int layer = (ph - 1) / 12, s = (ph - 1) % 12;
      const bf16_t* wl = (const bf16_t*)(ws + OFF_W) + (size_t)layer * W_LAYER;
      const float* modl = (const float*)(ws + OFF_MOD) + (size_t)layer * 9 * 9216;
      bf16_t* Nb = (bf16_t*)(ws + OFF_N); bf16_t* UH = (bf16_t*)(ws + OFF_UH); float* X = (float*)(ws + OFF_X);
      if (s == 0) norm_phase(p, layer, 0, layer == 0, false);
      else if (s == 3) norm_phase(p, layer, 1, false, false);
      else if (s == 9) norm_phase(p, layer, 2, false, false);
      else if (s == 1 || s == 10) {
        const int f = s == 10;
        pg8::Gemm g{Nb, wl + W_FI + (size_t)f * 5632 * 1024, T_ALL, 5632, 1024};
        pg8::StaticOrder S; S.init(g.M, g.N, G, c);
        EpiSwiglu E{UH};
        pg8::gemm_phase(lds, g, S, E);
      } else if (s == 2 || s == 11) {
        const int f = s == 11;
        pg8::Gemm g{UH, wl + W_FO + (size_t)f * 1024 * 2816, T_ALL, 1024, 2816};
        pg8::StaticOrder S; S.init(g.M, g.N, G, c);
        EpiResid E{X, modl, f ? 8 : 2, 0.5f};
        pg8::gemm_phase(lds, g, S, E);
      } else if (s == 4) {
        pg8::Gemm g{Nb, wl + W_IN, T_ALL, 5632, 1024};
        pg8::StaticOrder S; S.init(g.M, g.N, G, c);
        EpiWin E{UH, (bf16_t*)(ws + OFF_Q), (bf16_t*)(ws + OFF_K), (bf16_t*)(ws + OFF_V), p.out + 12582912, p.out + 12582912 + 8388608, (const float*)(ws + OFF_ROPE), layer};
        pg8::gemm_phase(lds, g, S, E);
      } else if (s == 5) {
        mixer_phase(p, layer, lds);
      } else if (s == 6) {
        pg8::Gemm g{(const bf16_t*)(ws + OFF_YA), wl + W_GLU, T_ALL, 512, 512};
        pg8::StaticOrder S; S.init(g.M, g.N, G, c);
        EpiGlu E{(const bf16_t*)(ws + OFF_YA), (bf16_t*)(ws + OFF_YS)};
        pg8::gemm_phase(lds, g, S, E);
      } else if (s == 7) {
        pg8::Gemm g{(const bf16_t*)(ws + OFF_YS), wl + W_BR, 3 * T_ALL, 3072, 512};
        pg8::BranchOrder S{G, c};
        EpiBranch E{UH, (float*)(ws + OFF_YP), Nb};
        pg8::gemm_phase(lds, g, S, E);
      } else if (s == 8) {
        pg8::Gemm g{Nb, wl + W_OUT, T_ALL, 1024, 1024};
        pg8::StaticOrder S; S.init(g.M, g.N, G, c);
        EpiResid E{X, modl, 5, 1.0f};
        pg8::gemm_phase(lds, g, S, E);
      }
    }
    if (phi + 1 < p0.ph_hi) cg::this_grid().sync();
  }
}

extern "C" void kernel_launch(void* const* d_in, const int* in_sizes, int n_in, void* d_out, int out_size, void* d_ws, size_t ws_size, hipStream_t stream) {
  static int grid = 0;
  if (grid == 0) {
    int dev = 0, cus = 0, per_cu = 0;
    hipGetDevice(&dev);
    hipDeviceGetAttribute(&cus, hipDeviceAttributeMultiprocessorCount, dev);
    if (hipFuncSetAttribute((const void*)fwd_megakernel, hipFuncAttributeMaxDynamicSharedMemorySize, LDS_BYTES) != hipSuccess) fprintf(stderr, "hipFuncSetAttribute failed\n");
    hipOccupancyMaxActiveBlocksPerMultiprocessor(&per_cu, (const void*)fwd_megakernel, 512, LDS_BYTES);
    if (per_cu < 1) { fprintf(stderr, "occupancy query gave %d\n", per_cu); per_cu = 1; }
    (void)hipGetLastError();
    grid = cus * per_cu;
    if (ws_size < OFF_W + 4 * W_LAYER * 2) fprintf(stderr, "workspace too small: %zu\n", ws_size);
  }
  Params p{};
  for (int i = 0; i < 32; ++i) p.in[i] = (const float*)d_in[i];
  p.out = (float*)d_out; p.ws = (unsigned char*)d_ws;
#if COOP
  p.ph_lo = 0; p.ph_hi = NPH;
  void* args[] = {&p};
  hipError_t e = hipLaunchCooperativeKernel((const void*)fwd_megakernel, dim3(grid), dim3(512), args, LDS_BYTES, stream);
  if (e != hipSuccess) fprintf(stderr, "cooperative launch failed: %s (grid %d)\n", hipGetErrorString(e), grid);
#else
  for (int ph = 0; ph < NPH; ++ph) {
    p.ph_lo = ph; p.ph_hi = ph + 1;
    hipLaunchKernelGGL(fwd_megakernel, dim3(grid), dim3(512), LDS_BYTES, stream, p);
  }
#endif
}
```

```cpp
#include <hip/hip_runtime.h>
#include <hip/hip_cooperative_groups.h>
#include <cstdio>
namespace cg = cooperative_groups;

#ifndef COOP
#define COOP 1
#endif

#define LAS __attribute__((address_space(3)))
typedef unsigned short bf16_t;
typedef short bf16x8 __attribute__((ext_vector_type(8)));
typedef short s16x4 __attribute__((ext_vector_type(4)));
typedef float f32x2 __attribute__((ext_vector_type(2)));
typedef float f32x4 __attribute__((ext_vector_type(4)));
typedef float f32x16 __attribute__((ext_vector_type(16)));
typedef unsigned u32x4 __attribute__((ext_vector_type(4)));
typedef unsigned u32x2 __attribute__((ext_vector_type(2)));
typedef __bf16 nbf16x2 __attribute__((ext_vector_type(2)));
#define DI __device__ __forceinline__

constexpr int T_CTX = 4096, T_ALL = 12288, DM = 1024, DFF = 2816, INW = 5632, NPH = 50;
constexpr size_t OFF_X = 0;
constexpr size_t OFF_N = OFF_X + 50331648;
constexpr size_t OFF_UH = OFF_N + 25165824;
constexpr size_t OFF_Q = OFF_UH + 138412032;
constexpr size_t OFF_K = OFF_Q + 12582912;
constexpr size_t OFF_V = OFF_K + 12582912;
constexpr size_t OFF_KC = OFF_V + 12582912;
constexpr size_t OFF_VC = OFF_KC + 16777216;
constexpr size_t OFF_YP = OFF_VC + 16777216;
constexpr size_t OFF_YA = OFF_YP + 50331648;
constexpr size_t OFF_YS = OFF_YA + 12582912;
constexpr size_t OFF_MOD = OFF_YS + 37748736;
constexpr size_t OFF_BB = OFF_MOD + 1327104;
constexpr size_t OFF_CM = OFF_BB + 1048576;
constexpr size_t OFF_AT = OFF_CM + 1048576;
constexpr size_t OFF_ROPE = OFF_AT + 131072;
constexpr size_t OFF_LAM = OFF_ROPE + 262144;
constexpr size_t OFF_W = OFF_LAM + 256;
constexpr size_t W_FI = 0;
constexpr size_t W_FO = W_FI + 11534336;
constexpr size_t W_IN = W_FO + 5767168;
constexpr size_t W_GLU = W_IN + 5767168;
constexpr size_t W_BR = W_GLU + 262144;
constexpr size_t W_OUT = W_BR + 1572864;
constexpr size_t W_P = W_OUT + 1048576;
constexpr size_t W_LAYER = W_P + 65536;
constexpr size_t OFF_BAR = OFF_W + 4 * W_LAYER * 2;
constexpr size_t WS_END = OFF_BAR + 16384;
constexpr int LDS_BYTES = 131072;

struct Params {
  const float* in[32];
  float* out;
  unsigned char* ws;
  int ph_lo, ph_hi;
};
struct InTab { const Params* pp; __device__ __forceinline__ const float* operator[](int i) const { asm volatile("" : "+s"(i)); return pp->in[i]; } };
struct Ctx { InTab in; float* out; unsigned char* ws; };

DI int opaque_tid() { int t = threadIdx.x; asm volatile("" : "+v"(t)); return t; }
DI unsigned pk2(float lo, float hi) { f32x2 v = {lo, hi}; nbf16x2 b = __builtin_convertvector(v, nbf16x2); return __builtin_bit_cast(unsigned, b); }
DI float bf2f(unsigned short b) { return __uint_as_float(((unsigned)b) << 16); }
DI float bflo(unsigned u) { return __uint_as_float(u << 16); }
DI float bfhi(unsigned u) { return __uint_as_float(u & 0xffff0000u); }
DI float sigmoidf_(float x) { return __builtin_amdgcn_rcpf(1.f + __expf(-x)); }
DI float wave_sum(float v) {
#pragma unroll
  for (int o = 1; o < 64; o <<= 1) v += __shfl_xor(v, o);
  return v;
}
#define LDS_WAIT() asm volatile("s_waitcnt lgkmcnt(0)" ::: "memory")

namespace pg8 {
constexpr int BM = 256, BK = 64, HALF = 128, HTB = HALF * BK * 2, NXCD = 8, WGM = 8;
DI int lds_byte(int r, int c) { const int st = (r >> 4) * 2 + (c >> 5), rr = r & 15, cc = c & 31, ob = rr * 64 + cc * 2; return st * 1024 + (ob ^ (((ob >> 9) & 1) << 5)); }
DI void stage_rc(int b, int& R, int& C) { const int st = b / 1024, sb = b % 1024, swz = sb ^ (((sb >> 9) & 1) << 5); R = (st >> 1) * 16 + swz / 64; C = (st & 1) * 32 + (swz % 64) / 2; }
struct Unit { int pm, pn; };
struct Gemm { const bf16_t* A; const bf16_t* Bt; int M, N, K; };
struct StaticOrder {
  int nM, nN, nwg, G, c;
  DI void init(int M, int N, int G_, int c_) { nM = M / BM; nN = N / BM; nwg = nM * nN; G = G_; c = c_; }
  DI bool next(int i, Unit& u) const {
    const long L = (long)i * G + c; if (L >= nwg) return false;
    int wgid = (int)L; { const int q = nwg / NXCD, r = nwg % NXCD, xcd = wgid % NXCD, off = wgid / NXCD; wgid = (xcd < r ? xcd * (q + 1) : r * (q + 1) + (xcd - r) * q) + off; }
    const int nig = WGM * nN, gid = wgid / nig, fm = gid * WGM, gsz = (nM - fm) < WGM ? (nM - fm) : WGM;
    u.pm = fm + ((wgid % nig) % gsz); u.pn = (wgid % nig) / gsz; return true;
  }
};
struct BranchOrder {
  int G, c;
  DI bool next(int i, Unit& u) const { const int tile = (i / 3) * G + c; if (tile >= 192) return false; const int n = i % 3; u.pm = n * 48 + (tile >> 2); u.pn = n * 4 + (tile & 3); return true; }
};

template <class Epi, class Sched>
DI void gemm_phase(LAS unsigned char* lds, const Gemm g, const Sched& S, const Epi& E) {
  const int tid = opaque_tid(), wid = __builtin_amdgcn_readfirstlane(tid >> 6), lane = tid & 63, wr = wid >> 2, wc = wid & 3, fr = lane & 15, fq = lane >> 4;
  const int K = g.K, nt = K / BK;
  unsigned voffA[2], voffB[2];
#pragma unroll
  for (int i = 0; i < 2; ++i) { int R, C; stage_rc(tid * 16 + i * 8192, R, C); voffA[i] = (unsigned)(R * K + C) * 2u; voffB[i] = voffA[i]; }
  const size_t kstep = (size_t)(BK * 2);
  const size_t hstep = (size_t)HALF * K * 2;
  const size_t tstep = 2 * hstep;
  const unsigned ldsw = (unsigned)wid * 1024u;
  const int aoff = lds_byte(wr * 64 + fr, fq * 8), boff = lds_byte(wc * 32 + fr, fq * 8);
#define PG8_SA(b, h) (((b) * 2 + (h)) * HTB)
#define PG8_SB(b, h) ((4 + (b) * 2 + (h)) * HTB)
#define PG8_STAGE(bufoff, gbase, voff) do { _Pragma("unroll") for (int _i = 0; _i < 2; ++_i) \
    __builtin_amdgcn_global_load_lds((const unsigned*)((const char*)(gbase) + (voff)[_i]), (LAS unsigned*)(lds + (bufoff) + ldsw + _i * 8192), 16, 0, 0); } while (0)
#define PG8_LDA(dst, b, h) do { _Pragma("unroll") for (int m = 0; m < 4; ++m) _Pragma("unroll") for (int k = 0; k < 2; ++k) dst[m][k] = *(const LAS bf16x8*)(lds + PG8_SA(b, h) + aoff + m * 2048 + k * 1024); } while (0)
#define PG8_LDB(dst, b, h) do { _Pragma("unroll") for (int n = 0; n < 2; ++n) _Pragma("unroll") for (int k = 0; k < 2; ++k) dst[n][k] = *(const LAS bf16x8*)(lds + PG8_SB(b, h) + boff + n * 2048 + k * 1024); } while (0)
#define PG8_MMA(ai, bj, At, Bt) do { __builtin_amdgcn_s_setprio(1); _Pragma("unroll") for (int m = 0; m < 4; ++m) _Pragma("unroll") for (int n = 0; n < 2; ++n) _Pragma("unroll") for (int k = 0; k < 2; ++k) \
    acc[ai][bj][m][n] = __builtin_amdgcn_mfma_f32_16x16x32_bf16(Bt[n][k], At[m][k], acc[ai][bj][m][n], 0, 0, 0); __builtin_amdgcn_s_setprio(0); } while (0)
#define PG8_WAIT_V(n) asm volatile("s_waitcnt vmcnt(" #n ")" ::: "memory")
#define PG8_WAIT_L(n) asm volatile("s_waitcnt lgkmcnt(" #n ")" ::: "memory")
#define PG8_BAR __builtin_amdgcn_s_barrier()
#define PG8_SCHED __builtin_amdgcn_sched_barrier(0)
  Unit cur, nxt; int ui = 0;
  if (!S.next(0, cur)) return;
  f32x4 acc[2][2][4][2];
#pragma unroll
  for (int a = 0; a < 2; ++a)
#pragma unroll
    for (int b = 0; b < 2; ++b)
#pragma unroll
      for (int m = 0; m < 4; ++m)
#pragma unroll
        for (int n = 0; n < 2; ++n) acc[a][b][m][n] = (f32x4){0.f, 0.f, 0.f, 0.f};
  bf16x8 At[4][2], B0[2][2], B1[2][2];
  const char* cA = (const char*)g.A + (size_t)cur.pm * tstep; const char* cB = (const char*)g.Bt + (size_t)cur.pn * tstep;
  PG8_STAGE(PG8_SB(0, 0), cB, voffB); PG8_STAGE(PG8_SA(0, 0), cA, voffA); PG8_STAGE(PG8_SB(0, 1), cB + hstep, voffB); PG8_STAGE(PG8_SA(0, 1), cA + hstep, voffA);
  if (wr == 1) PG8_BAR;
  PG8_WAIT_V(4); PG8_BAR;
  PG8_STAGE(PG8_SB(1, 0), cB + kstep, voffB); PG8_STAGE(PG8_SA(1, 0), cA + kstep, voffA); PG8_STAGE(PG8_SB(1, 1), cB + hstep + kstep, voffB);
  PG8_WAIT_V(6); PG8_BAR;
  for (;;) {
    const bool has_next = S.next(ui + 1, nxt);
    const char* nA = has_next ? (const char*)g.A + (size_t)nxt.pm * tstep : cA; const char* nB = has_next ? (const char*)g.Bt + (size_t)nxt.pn * tstep : cB;
    for (int t = 0; t < nt; t += 2) {
      const bool last = (t == nt - 2);
      const char* a1 = cA + (size_t)(t + 1) * kstep;
      const char* a2 = last ? nA : cA + (size_t)(t + 2) * kstep; const char* b2 = last ? nB : cB + (size_t)(t + 2) * kstep;
      const char* a3 = a2 + kstep; const char* b3 = b2 + kstep;
      PG8_LDB(B0, 0, 0); PG8_SCHED; PG8_LDA(At, 0, 0); PG8_STAGE(PG8_SA(1, 1), a1 + hstep, voffA);
      PG8_WAIT_L(8); PG8_BAR; PG8_WAIT_L(0); PG8_MMA(0, 0, At, B0); PG8_BAR; PG8_SCHED;
      PG8_LDB(B1, 0, 1); PG8_STAGE(PG8_SB(0, 0), b2, voffB);
      PG8_BAR; PG8_WAIT_L(0); PG8_MMA(0, 1, At, B1); PG8_BAR;
      PG8_LDA(At, 0, 1); PG8_STAGE(PG8_SA(0, 0), a2, voffA);
      PG8_BAR; PG8_WAIT_L(0); PG8_MMA(1, 0, At, B0); PG8_BAR; PG8_SCHED;
      PG8_STAGE(PG8_SB(0, 1), b2 + hstep, voffB);
      PG8_WAIT_V(6); PG8_BAR; PG8_MMA(1, 1, At, B1); PG8_BAR;
      PG8_LDB(B0, 1, 0); PG8_SCHED; PG8_LDA(At, 1, 0); PG8_STAGE(PG8_SA(0, 1), a2 + hstep, voffA);
      PG8_WAIT_L(8); PG8_BAR; PG8_WAIT_L(0); PG8_MMA(0, 0, At, B0); PG8_BAR; PG8_SCHED;
      PG8_LDB(B1, 1, 1); PG8_STAGE(PG8_SB(1, 0), b3, voffB);
      PG8_BAR; PG8_WAIT_L(0); PG8_MMA(0, 1, At, B1); PG8_BAR;
      PG8_LDA(At, 1, 1); PG8_STAGE(PG8_SA(1, 0), a3, voffA);
      PG8_BAR; PG8_WAIT_L(0); PG8_MMA(1, 0, At, B0); PG8_BAR; PG8_SCHED;
      PG8_STAGE(PG8_SB(1, 1), b3 + hstep, voffB);
      PG8_WAIT_V(6); PG8_BAR; PG8_MMA(1, 1, At, B1); PG8_BAR;
    }
    E(acc, cur, wr, wc, fr, fq);
    if (!has_next) break;
#pragma unroll
    for (int a = 0; a < 2; ++a)
#pragma unroll
      for (int b = 0; b < 2; ++b)
#pragma unroll
        for (int m = 0; m < 4; ++m)
#pragma unroll
          for (int n = 0; n < 2; ++n) acc[a][b][m][n] = (f32x4){0.f, 0.f, 0.f, 0.f};
    cur = nxt; cA = nA; cB = nB; ++ui;
  }
  PG8_WAIT_V(0);
  if (wr == 0) PG8_BAR;
  PG8_BAR;
#undef PG8_SA
#undef PG8_SB
#undef PG8_STAGE
#undef PG8_LDA
#undef PG8_LDB
#undef PG8_MMA
#undef PG8_WAIT_V
#undef PG8_WAIT_L
#undef PG8_BAR
#undef PG8_SCHED
}
}
using pg8::Unit;

typedef f32x4 AccT[2][2][4][2];
DI void st_bf4(bf16_t* p, f32x4 v) { u32x2 w; w.x = pk2(v[0], v[1]); w.y = pk2(v[2], v[3]); *(u32x2*)p = w; }
DI f32x4 ld_bf4(const bf16_t* p) { const u32x2 w = *(const u32x2*)p; return (f32x4){bflo(w.x), bfhi(w.x), bflo(w.y), bfhi(w.y)}; }

struct EpiSwiglu {
  bf16_t* H;
  DI void operator()(const AccT& acc, const Unit& u, int wr, int wc, int fr, int fq) const {
    const int row0 = u.pm * 256 + wr * 64 + fr, col0 = u.pn * 128 + wc * 32 + 4 * fq;
#pragma unroll
    for (int ai = 0; ai < 2; ++ai)
#pragma unroll
      for (int m = 0; m < 4; ++m) {
        bf16_t* rowp = H + (size_t)(row0 + ai * 128 + m * 16) * DFF + col0;
#pragma unroll
        for (int n = 0; n < 2; ++n) {
          const f32x4 a = acc[ai][0][m][n], b = acc[ai][1][m][n]; f32x4 h;
#pragma unroll
          for (int j = 0; j < 4; ++j) h[j] = a[j] * sigmoidf_(a[j]) * b[j];
          st_bf4(rowp + n * 16, h);
        }
      }
  }
};
struct EpiResid {
  float* X; const float* modl; int gate_idx; float coef;
  DI void operator()(const AccT& acc, const Unit& u, int wr, int wc, int fr, int fq) const {
    const int mrow = u.pm < 16 ? 8 : ((u.pm - 16) >> 2);
    const int row0 = u.pm * 256 + wr * 64 + fr, col0 = u.pn * 256 + wc * 32 + 4 * fq;
    const float* gp = modl + (size_t)mrow * 9216 + gate_idx * 1024 + col0;
    f32x4 gv[2][2];
#pragma unroll
    for (int bj = 0; bj < 2; ++bj)
#pragma unroll
      for (int n = 0; n < 2; ++n) gv[bj][n] = *(const f32x4*)(gp + bj * 128 + n * 16) * coef;
#pragma unroll
    for (int ai = 0; ai < 2; ++ai)
#pragma unroll
      for (int m = 0; m < 4; ++m) {
        float* rowp = X + (size_t)(row0 + ai * 128 + m * 16) * DM + col0;
#pragma unroll
        for (int bj = 0; bj < 2; ++bj)
#pragma unroll
          for (int n = 0; n < 2; ++n) { f32x4* q = (f32x4*)(rowp + bj * 128 + n * 16); *q = *q + gv[bj][n] * acc[ai][bj][m][n]; }
      }
  }
};
struct EpiWin {
  bf16_t* U; bf16_t* Q; bf16_t* Kb; bf16_t* Vb; float* outk; float* outv; const float* rope; int layer;
  DI void operator()(const AccT& acc, const Unit& u, int wr, int wc, int fr, int fq) const {
    const int pn = u.pn, row0 = u.pm * 256 + wr * 64 + fr;
    const bool lat = u.pm >= 16;
    if (pn < 2 || pn >= 8) {
      const int col0 = pn * 256 + wc * 32 + 4 * fq;
#pragma unroll
      for (int ai = 0; ai < 2; ++ai)
#pragma unroll
        for (int m = 0; m < 4; ++m) {
          bf16_t* rowp = U + (size_t)(row0 + ai * 128 + m * 16) * INW + col0;
#pragma unroll
          for (int bj = 0; bj < 2; ++bj)
#pragma unroll
            for (int n = 0; n < 2; ++n) st_bf4(rowp + bj * 128 + n * 16, acc[ai][bj][m][n]);
        }
    } else if (pn < 6) {
      const bool isq = pn < 4;
      const int cq0 = (pn & 1) * 256 + wc * 32 + 4 * fq;
      const float scale = isq ? 0.125f * 1.4426950408889634f : 1.f;
      bf16_t* dstb = isq ? Q : Kb;
#pragma unroll
      for (int ai = 0; ai < 2; ++ai)
#pragma unroll
        for (int m = 0; m < 4; ++m) {
          const int row = row0 + ai * 128 + m * 16;
          f32x4 cs = {1.f, 1.f, 1.f, 1.f}, sn = {0.f, 0.f, 0.f, 0.f};
          if (lat) {
            const int pos = (row - T_CTX) & 1023;
            const float* rp = rope + (size_t)pos * 64 + ((wc & 1) * 16 + 4 * fq) * 2;
            const f32x4 r0 = *(const f32x4*)rp, r1 = *(const f32x4*)(rp + 4);
            cs = (f32x4){r0[0], r0[2], r1[0], r1[2]}; sn = (f32x4){r0[1], r0[3], r1[1], r1[3]};
          }
#pragma unroll
          for (int bj = 0; bj < 2; ++bj) {
            const f32x4 y1 = acc[ai][bj][m][0], y2 = acc[ai][bj][m][1];
            const f32x4 o1 = y1 * cs - y2 * sn, o2 = y2 * cs + y1 * sn;
            bf16_t* d = dstb + (size_t)row * 512 + cq0 + bj * 128;
            st_bf4(d, o1 * scale); st_bf4(d + 16, o2 * scale);
            if (!isq && !lat) {
              float* o = outk + ((size_t)((row >> 8) * 4 + layer) * 256 + (row & 255)) * 512 + cq0 + bj * 128;
              *(f32x4*)o = o1; *(f32x4*)(o + 16) = o2;
            }
          }
        }
    } else {
      const int cv0 = (pn & 1) * 256 + wc * 32 + 4 * fq;
#pragma unroll
      for (int ai = 0; ai < 2; ++ai)
#pragma unroll
        for (int m = 0; m < 4; ++m) {
          const int row = row0 + ai * 128 + m * 16;
#pragma unroll
          for (int bj = 0; bj < 2; ++bj)
#pragma unroll
            for (int n = 0; n < 2; ++n) {
              st_bf4(Vb + (size_t)row * 512 + cv0 + bj * 128 + n * 16, acc[ai][bj][m][n]);
              if (!lat) *(f32x4*)(outv + ((size_t)((row >> 8) * 4 + layer) * 256 + (row & 255)) * 512 + cv0 + bj * 128 + n * 16) = acc[ai][bj][m][n];
            }
        }
    }
  }
};
struct EpiGlu {
  const bf16_t* ya; bf16_t* ys0;
  DI void operator()(const AccT& acc, const Unit& u, int wr, int wc, int fr, int fq) const {
    const int row0 = u.pm * 256 + wr * 64 + fr, col0 = u.pn * 256 + wc * 32 + 4 * fq;
#pragma unroll
    for (int ai = 0; ai < 2; ++ai)
#pragma unroll
      for (int m = 0; m < 4; ++m) {
        const size_t ro = (size_t)(row0 + ai * 128 + m * 16) * 512 + col0;
#pragma unroll
        for (int bj = 0; bj < 2; ++bj)
#pragma unroll
          for (int n = 0; n < 2; ++n) {
            const f32x4 y = ld_bf4(ya + ro + bj * 128 + n * 16), a = acc[ai][bj][m][n]; f32x4 o;
#pragma unroll
            for (int j = 0; j < 4; ++j) o[j] = y[j] * sigmoidf_(a[j]);
            st_bf4(ys0 + ro + bj * 128 + n * 16, o);
          }
      }
  }
};
struct EpiBranch {
  const bf16_t* U; float* MRG; bf16_t* MERGED;
  DI void operator()(const AccT& acc, const Unit& u, int wr, int wc, int fr, int fq) const {
    const int n3 = u.pm / 48, pm = u.pm - n3 * 48, pn = u.pn & 3;
    const int row0 = pm * 256 + wr * 64 + fr, col0 = pn * 256 + wc * 32 + 4 * fq;
#pragma unroll
    for (int ai = 0; ai < 2; ++ai)
#pragma unroll
      for (int m = 0; m < 4; ++m) {
        const int row = row0 + ai * 128 + m * 16;
        const bf16_t* gp = U + (size_t)row * INW + 2560 + n3 * 1024 + col0;
        float* mp = MRG + (size_t)row * DM + col0;
        bf16_t* op = MERGED + (size_t)row * DM + col0;
#pragma unroll
        for (int bj = 0; bj < 2; ++bj)
#pragma unroll
          for (int n = 0; n < 2; ++n) {
            const f32x4 gt = ld_bf4(gp + bj * 128 + n * 16), a = acc[ai][bj][m][n]; f32x4 o;
#pragma unroll
            for (int j = 0; j < 4; ++j) o[j] = sigmoidf_(gt[j]) * a[j];
            f32x4* q = (f32x4*)(mp + bj * 128 + n * 16);
            if (n3 == 0) *q = o;
            else if (n3 == 1) *q = *q + o;
            else st_bf4(op + bj * 128 + n * 16, *q + o);
          }
      }
  }
};

DI void transpose_item(const float* W, int K, int N, bf16_t* WT, int swiglu, LAS float* scr, int item, int lane) {
  const int nblk = N / 32, kb = item / nblk, nb = item % nblk, k0 = 64 * kb, n0 = 32 * nb;
#pragma unroll
  for (int i = 0; i < 32; ++i) { const int kk = 2 * i + (lane >> 5); scr[kk * 33 + (lane & 31)] = W[(size_t)(k0 + kk) * N + n0 + (lane & 31)]; }
  LDS_WAIT();
  const int c = lane & 7;
#pragma unroll
  for (int j = 0; j < 4; ++j) {
    const int n = (lane >> 3) + 8 * j; const LAS float* s = scr + (8 * c) * 33 + n;
    u32x4 o; o.x = pk2(s[0 * 33], s[1 * 33]); o.y = pk2(s[2 * 33], s[3 * 33]); o.z = pk2(s[4 * 33], s[5 * 33]); o.w = pk2(s[6 * 33], s[7 * 33]);
    int dr = n0 + n;
    if (swiglu) { const int isb = dr >= DFF, hh = isb ? dr - DFF : dr; dr = (hh >> 7) * 256 + isb * 128 + (hh & 127); }
    *(u32x4*)(WT + (size_t)dr * K + k0 + 8 * c) = o;
  }
  LDS_WAIT();
}

DI void prep_phase(const Ctx& p, LAS unsigned char* lds) {
  const int tid = opaque_tid(), lane = tid & 63, wave = tid >> 6;
  unsigned char* ws = p.ws;
  for (int item = blockIdx.x; item < 144; item += gridDim.x) {
    const int l = item / 36, jc = item % 36;
    LAS float* sc = (LAS float*)lds;
    for (int i = tid; i < 9 * 1024; i += 512) { const int r = i >> 10, k = i & 1023; const float v = r < 8 ? p.in[5][r * 1024 + k] : p.in[6][k]; sc[i] = v * sigmoidf_(v); }
    __syncthreads();
    const int col = tid & 255, kh = tid >> 8, j = jc * 256 + col;
    const float* w = p.in[8] + (size_t)l * 1024 * 9216 + (size_t)(kh * 512) * 9216 + j;
    float a0 = 0, a1 = 0, a2 = 0, a3 = 0, a4 = 0, a5 = 0, a6 = 0, a7 = 0, a8 = 0;
    const LAS float* s0 = sc + kh * 512;
#pragma unroll 16
    for (int k = 0; k < 512; ++k) {
      const float wv = w[(size_t)k * 9216];
      a0 += s0[k] * wv; a1 += s0[1024 + k] * wv; a2 += s0[2048 + k] * wv; a3 += s0[3072 + k] * wv; a4 += s0[4096 + k] * wv;
      a5 += s0[5120 + k] * wv; a6 += s0[6144 + k] * wv; a7 += s0[7168 + k] * wv; a8 += s0[8192 + k] * wv;
    }
    LAS float* red = sc + 9 * 1024;
    if (kh == 1) { red[col] = a0; red[256 + col] = a1; red[512 + col] = a2; red[768 + col] = a3; red[1024 + col] = a4; red[1280 + col] = a5; red[1536 + col] = a6; red[1792 + col] = a7; red[2048 + col] = a8; }
    __syncthreads();
    if (kh == 0) {
      float* mo = (float*)(ws + OFF_MOD) + (size_t)l * 9 * 9216 + j; const float bb = p.in[9][l * 9216 + j];
      mo[0] = a0 + red[col] + bb; mo[9216] = a1 + red[256 + col] + bb; mo[2 * 9216] = a2 + red[512 + col] + bb; mo[3 * 9216] = a3 + red[768 + col] + bb;
      mo[4 * 9216] = a4 + red[1024 + col] + bb; mo[5 * 9216] = a5 + red[1280 + col] + bb; mo[6 * 9216] = a6 + red[1536 + col] + bb; mo[7 * 9216] = a7 + red[1792 + col] + bb;
      mo[8 * 9216] = a8 + red[2048 + col] + bb;
    }
    __syncthreads();
  }
  {
    LAS float* scr = (LAS float*)(lds + wave * 8448);
    const int gw = blockIdx.x * 8 + wave, NGW = gridDim.x * 8;
    constexpr int I_FI = 16 * 176, I_FO = 44 * 32, I_IN = 16 * 176, I_GLU = 8 * 16, I_BR = 8 * 32, I_OUT = 16 * 32, I_P = 2 * 4;
    constexpr int I_LAYER = 2 * I_FI + 2 * I_FO + I_IN + I_GLU + 3 * I_BR + I_OUT + 4 * I_P;
    for (int it = gw; it < 4 * I_LAYER; it += NGW) {
      const int l = it / I_LAYER; int r = it % I_LAYER;
      bf16_t* wl = (bf16_t*)(ws + OFF_W) + (size_t)l * W_LAYER;
      if (r < 2 * I_FI) { const int s = r / I_FI; transpose_item(p.in[10] + (size_t)(l * 2 + s) * 1024 * 5632, 1024, 5632, wl + W_FI + (size_t)s * 5632 * 1024, 1, scr, r % I_FI, lane); continue; } r -= 2 * I_FI;
      if (r < 2 * I_FO) { const int s = r / I_FO; transpose_item(p.in[11] + (size_t)(l * 2 + s) * 2816 * 1024, 2816, 1024, wl + W_FO + (size_t)s * 1024 * 2816, 0, scr, r % I_FO, lane); continue; } r -= 2 * I_FO;
      if (r < I_IN) { transpose_item(p.in[12] + (size_t)l * 1024 * 5632, 1024, 5632, wl + W_IN, 0, scr, r, lane); continue; } r -= I_IN;
      if (r < I_GLU) { transpose_item(p.in[21] + (size_t)l * 512 * 512, 512, 512, wl + W_GLU, 0, scr, r, lane); continue; } r -= I_GLU;
      if (r < 3 * I_BR) { const int s = r / I_BR; transpose_item(p.in[29] + (size_t)(l * 3 + s) * 512 * 1024, 512, 1024, wl + W_BR + (size_t)s * 1024 * 512, 0, scr, r % I_BR, lane); continue; } r -= 3 * I_BR;
      if (r < I_OUT) { transpose_item(p.in[30] + (size_t)l * 1024 * 1024, 1024, 1024, wl + W_OUT, 0, scr, r, lane); continue; } r -= I_OUT;
      { const int s = r / I_P; transpose_item(p.in[27] + (size_t)(l * 4 + s) * 128 * 128, 128, 128, wl + W_P + (size_t)s * 128 * 128, 0, scr, r % I_P, lane); }
    }
  }
  const size_t gt = (size_t)blockIdx.x * 512 + tid, GT = (size_t)gridDim.x * 512;
  for (size_t i = gt; i < 2 * 1048576; i += GT) {
    const int which = i >= 1048576; const size_t e = (i & 1048575) * 8;
    const float* src = (which ? p.in[3] : p.in[2]) + e;
    const f32x4 a = *(const f32x4*)src, b = *(const f32x4*)(src + 4);
    u32x4 o; o.x = pk2(a[0], a[1]); o.y = pk2(a[2], a[3]); o.z = pk2(b[0], b[1]); o.w = pk2(b[2], b[3]);
    *(u32x4*)((bf16_t*)(ws + (which ? OFF_VC : OFF_KC)) + e) = o;
  }
  for (size_t i = gt; i < 16384; i += GT) {
    const int pI = (int)(i & 63), ldg = (int)(i >> 6);
    const float lr = p.in[13][i], li = p.in[14][i], dt = expf(p.in[15][ldg]);
    const float mag = expf(lr * dt), abr = mag * cosf(li * dt), abi = mag * sinf(li * dt);
    const float den = lr * lr + li * li, nr = abr - 1.0f, kr = (nr * lr + abi * li) / den, ki = (abi * lr - nr * li) / den;
    float* at = (float*)(ws + OFF_AT) + i * 2; at[0] = abr; at[1] = abi;
    bf16_t* bbp = (bf16_t*)(ws + OFF_BB) + (size_t)ldg * 2048;
    const float* bre = p.in[16] + i * 16; const float* bim = p.in[17] + i * 16;
    for (int c = 0; c < 16; c += 2) {
      const float br0 = bre[c], bi0 = bim[c], br1 = bre[c + 1], bi1 = bim[c + 1];
      *(unsigned*)(bbp + (size_t)pI * 16 + c) = pk2(kr * br0 - ki * bi0, kr * br1 - ki * bi1);
      *(unsigned*)(bbp + (size_t)(64 + pI) * 16 + c) = pk2(kr * bi0 + ki * br0, kr * bi1 + ki * br1);
    }
    bf16_t* cmp = (bf16_t*)(ws + OFF_CM) + (size_t)ldg * 2048;
    for (int c = 0; c < 16; ++c) {
      const float cr = p.in[18][((size_t)ldg * 16 + c) * 64 + pI], ci = p.in[19][((size_t)ldg * 16 + c) * 64 + pI];
      *(unsigned*)(cmp + (size_t)c * 128 + 2 * pI) = pk2(cr, -ci);
    }
  }
  for (size_t i = gt; i < 32768; i += GT) {
    const int pos = (int)(i >> 5), j = (int)(i & 31);
    const float inv = powf(10000.0f, -(float)(j & 15) / 16.0f);
    const float ang = (float)(j < 16 ? (pos >> 6) : (pos & 63)) * inv;
    float* rp = (float*)(ws + OFF_ROPE) + i * 2; rp[0] = cosf(ang); rp[1] = sinf(ang);
  }
  if (gt < 4) {
    const int l = (int)gt; float s1 = 0.f, s2 = 0.f;
    for (int k = 0; k < 64; ++k) { s1 += p.in[22][l * 64 + k] * p.in[23][l * 64 + k]; s2 += p.in[24][l * 64 + k] * p.in[25][l * 64 + k]; }
    const float lam_init = 0.8f - 0.6f * expf(-0.3f * (float)l);
    ((float*)(ws + OFF_LAM))[l] = expf(s1) - expf(s2) + lam_init;
  }
}

DI void norm_phase(const Ctx& p, int layer, int sub, bool first, bool final_) {
  const int tid = opaque_tid(), lane = tid & 63, wave = tid >> 6;
  float* X = (float*)(p.ws + OFF_X); bf16_t* Nb = (bf16_t*)(p.ws + OFF_N);
  const int gw = blockIdx.x * 8 + wave, NGW = gridDim.x * 8;
  for (int row = gw; row < T_ALL; row += NGW) {
    const float* src = first ? (row < T_CTX ? p.in[0] + (size_t)row * DM : p.in[1] + (size_t)(row - T_CTX) * DM) : X + (size_t)row * DM;
    f32x4 v[4]; float ss = 0.f;
#pragma unroll
    for (int j = 0; j < 4; ++j) { v[j] = ((const f32x4*)src)[lane + 64 * j]; ss += (v[j][0] * v[j][0] + v[j][1] * v[j][1]) + (v[j][2] * v[j][2] + v[j][3] * v[j][3]); }
    const float rstd = 1.0f / sqrtf(wave_sum(ss) * (1.f / DM) + 1e-6f);
    if (final_) {
      const float* g = p.in[31];
#pragma unroll
      for (int j = 0; j < 4; ++j) { const f32x4 gv = ((const f32x4*)g)[lane + 64 * j]; ((f32x4*)(p.out + (size_t)row * DM))[lane + 64 * j] = v[j] * rstd * gv; }
    } else {
      const int mrow = row < T_CTX ? 8 : ((row - T_CTX) >> 10);
      const float* md = (const float*)(p.ws + OFF_MOD) + ((size_t)layer * 9 + mrow) * 9216;
      const float* sh = md + (3 * sub) * 1024; const float* sc = md + (3 * sub + 1) * 1024; const float* g = p.in[7] + (size_t)(layer * 3 + sub) * DM;
#pragma unroll
      for (int j = 0; j < 4; ++j) {
        const f32x4 gv = ((const f32x4*)g)[lane + 64 * j], sv = ((const f32x4*)sc)[lane + 64 * j], hv = ((const f32x4*)sh)[lane + 64 * j];
        const f32x4 y = v[j] * rstd * gv * (sv + 1.f) + hv;
        st_bf4(Nb + (size_t)row * DM + (lane + 64 * j) * 4, y);
        if (first) ((f32x4*)(X + (size_t)row * DM))[lane + 64 * j] = v[j];
      }
    }
  }
}

DI s16x4 tr_read(unsigned lds_addr) { s16x4 r; asm volatile("ds_read_b64_tr_b16 %0, %1\n\ts_waitcnt lgkmcnt(0)" : "=&v"(r) : "v"(lds_addr) : "memory"); return r; }
#define MFMA32(a, b, c) __builtin_amdgcn_mfma_f32_32x32x16_bf16((a), (b), (c), 0, 0, 0)
#define MFMA16(a, b, c) __builtin_amdgcn_mfma_f32_16x16x32_bf16((a), (b), (c), 0, 0, 0)

DI void attn_item(const Ctx& p, int layer, bool lat, int seq, int head, int qblk, LAS unsigned char* lds) {
  const int tid = opaque_tid(), lane = tid & 63, wave = tid >> 6, r16 = lane & 15, g4 = lane >> 4;
  unsigned char* ws = p.ws;
  const bf16_t* Qg = (const bf16_t*)(ws + OFF_Q); const bf16_t* Kg = (const bf16_t*)(ws + OFF_K); const bf16_t* Vg = (const bf16_t*)(ws + OFF_V);
  const int tok0 = lat ? T_CTX + seq * 1024 : seq * 256;
  const int n_own = lat ? 16 : 4, n_tiles = lat ? 24 : 4;
  const bf16_t* Kc = (const bf16_t*)(ws + OFF_KC) + (size_t)(seq * 4 + layer) * 512 * 512;
  const bf16_t* Vc = (const bf16_t*)(ws + OFF_VC) + (size_t)(seq * 4 + layer) * 512 * 512;
  constexpr int RS = 272;
  LAS unsigned char* Kt = lds; LAS unsigned char* Vt = lds + 64 * RS;
  const int qtok = tok0 + qblk * 128 + wave * 16 + r16;
  bf16x8 Qf[2][2];
#pragma unroll
  for (int m = 0; m < 2; ++m)
#pragma unroll
    for (int kk = 0; kk < 2; ++kk) Qf[m][kk] = *(const bf16x8*)(Qg + (size_t)qtok * 512 + head * 128 + m * 64 + g4 * 8 + 32 * kk);
  u32x4 kreg[2], vreg[2];
  auto issue = [&](int kt) {
    const bf16_t* kb; const bf16_t* vb;
    if (kt < n_own) { kb = Kg + (size_t)(tok0 + kt * 64) * 512 + head * 128; vb = Vg + (size_t)(tok0 + kt * 64) * 512 + head * 128; }
    else { kb = Kc + (size_t)((kt - n_own) * 64) * 512 + head * 128; vb = Vc + (size_t)((kt - n_own) * 64) * 512 + head * 128; }
#pragma unroll
    for (int i = 0; i < 2; ++i) { const int ci = tid + 512 * i, row = ci >> 4, part = ci & 15; kreg[i] = *(const u32x4*)(kb + (size_t)row * 512 + part * 8); vreg[i] = *(const u32x4*)(vb + (size_t)row * 512 + part * 8); }
  };
  issue(0);
  f32x4 O[2][8];
#pragma unroll
  for (int m = 0; m < 2; ++m)
#pragma unroll
    for (int d = 0; d < 8; ++d) O[m][d] = (f32x4){0.f, 0.f, 0.f, 0.f};
  float mrun[2] = {-1e30f, -1e30f}, lsum[2] = {0.f, 0.f};
  const unsigned vbase = (unsigned)(size_t)Vt;
  const int tq = r16 >> 2, tp = r16 & 3;
  for (int kt = 0; kt < n_tiles; ++kt) {
    __syncthreads();
#pragma unroll
    for (int i = 0; i < 2; ++i) { const int ci = tid + 512 * i, row = ci >> 4, part = ci & 15; *(LAS u32x4*)(Kt + row * RS + part * 16) = kreg[i]; *(LAS u32x4*)(Vt + row * RS + part * 16) = vreg[i]; }
    __syncthreads();
    if (kt + 1 < n_tiles) issue(kt + 1);
    bf16x8 P[2][2];
#pragma unroll
    for (int m = 0; m < 2; ++m) {
      f32x4 S[4];
#pragma unroll
      for (int kb = 0; kb < 4; ++kb) {
        S[kb] = (f32x4){0.f, 0.f, 0.f, 0.f};
#pragma unroll
        for (int kk = 0; kk < 2; ++kk) { const bf16x8 Kf = *(const LAS bf16x8*)(Kt + (16 * kb + r16) * RS + m * 128 + (g4 * 8 + 32 * kk) * 2); S[kb] = MFMA16(Kf, Qf[m][kk], S[kb]); }
      }
      float mx = S[0][0];
#pragma unroll
      for (int kb = 0; kb < 4; ++kb)
#pragma unroll
        for (int j = 0; j < 4; ++j) mx = fmaxf(mx, S[kb][j]);
      mx = fmaxf(mx, __shfl_xor(mx, 16)); mx = fmaxf(mx, __shfl_xor(mx, 32));
      const float mnew = fmaxf(mrun[m], mx), alpha = __builtin_amdgcn_exp2f(mrun[m] - mnew);
      mrun[m] = mnew;
      float ps = 0.f;
#pragma unroll
      for (int kb = 0; kb < 4; ++kb)
#pragma unroll
        for (int j = 0; j < 4; ++j) { S[kb][j] = __builtin_amdgcn_exp2f(S[kb][j] - mnew); ps += S[kb][j]; }
      lsum[m] = lsum[m] * alpha + ps;
#pragma unroll
      for (int d = 0; d < 8; ++d) O[m][d] *= alpha;
#pragma unroll
      for (int s = 0; s < 2; ++s) {
        u32x4 w; w.x = pk2(S[2 * s][0], S[2 * s][1]); w.y = pk2(S[2 * s][2], S[2 * s][3]); w.z = pk2(S[2 * s + 1][0], S[2 * s + 1][1]); w.w = pk2(S[2 * s + 1][2], S[2 * s + 1][3]);
        P[m][s] = __builtin_bit_cast(bf16x8, w);
      }
    }
#pragma unroll
    for (int s = 0; s < 2; ++s)
#pragma unroll
      for (int d = 0; d < 8; ++d) {
        const unsigned a0 = vbase + (32 * s + 4 * g4 + tq) * RS + (16 * d) * 2 + 8 * tp;
        const s16x4 lo = tr_read(a0), hi = tr_read(a0 + 16 * RS);
        const bf16x8 Vf = __builtin_shufflevector(lo, hi, 0, 1, 2, 3, 4, 5, 6, 7);
        O[0][d] = MFMA16(Vf, P[0][s], O[0][d]);
        O[1][d] = MFMA16(Vf, P[1][s], O[1][d]);
      }
  }
  float l1 = lsum[0], l2 = lsum[1];
  l1 += __shfl_xor(l1, 16); l1 += __shfl_xor(l1, 32); l2 += __shfl_xor(l2, 16); l2 += __shfl_xor(l2, 32);
  const float lam = ((const float*)(ws + OFF_LAM))[layer];
  const float lam_init = 0.8f - 0.6f * expf(-0.3f * (float)layer);
  const float c1 = 1.f / l1, c2 = lam / l2;
  float ss = 0.f;
#pragma unroll
  for (int d = 0; d < 8; ++d) { const f32x4 o = O[0][d] * c1 - O[1][d] * c2; O[0][d] = o; ss += (o[0] * o[0] + o[1] * o[1]) + (o[2] * o[2] + o[3] * o[3]); }
  ss += __shfl_xor(ss, 16); ss += __shfl_xor(ss, 32);
  const float rn = (1.f - lam_init) / sqrtf(ss * (1.f / 128.f) + 1e-6f);
  const float* ag = p.in[26] + layer * 128;
  bf16_t* yb = (bf16_t*)(ws + OFF_YS) + (size_t)T_ALL * 512 + (size_t)qtok * 512 + head * 128;
#pragma unroll
  for (int d = 0; d < 8; ++d) {
    const int dv = 16 * d + 4 * g4;
    const f32x4 gv = *(const f32x4*)(ag + dv);
    st_bf4(yb + dv, O[0][d] * rn * gv);
  }
}

DI void s5_item(const Ctx& p, int layer, int pairIdx, int gq, LAS unsigned char* lds) {
  const int tid = opaque_tid(), lane = tid & 63, wave = __builtin_amdgcn_readfirstlane(tid >> 6), r32 = lane & 31, h = lane >> 5;
  unsigned char* ws = p.ws;
  const int g = gq * 4 + (wave >> 1), d = wave & 1;
  const bool lat = pairIdx < 4;
  const int L = lat ? 1024 : 256, nt = L / 16;
  const int seq0 = (lat ? pairIdx : pairIdx - 4) * 2;
  const int tb0 = lat ? T_CTX + seq0 * 1024 : seq0 * 256;
  const int ldg = (layer * 2 + d) * 32 + g;
  const float* at = (const float*)(ws + OFF_AT) + (size_t)ldg * 128;
  const float a0r = at[r32 * 2], a0i = at[r32 * 2 + 1], a1r = at[(r32 + 32) * 2], a1i = at[(r32 + 32) * 2 + 1];
  float h0r = 0.f, h0i = 0.f, h1r = 0.f, h1i = 0.f;
  if (lat) {
    const float* st = p.in[4] + ((size_t)(((seq0 + h) * 4 + layer) * 2 + d) * 2) * 2048 + g * 64;
    h0r = st[r32]; h1r = st[r32 + 32]; h0i = st[2048 + r32]; h1i = st[2048 + r32 + 32];
  }
  bf16x8 BBf[4], Cmf[4];
  {
    const bf16_t* bb = (const bf16_t*)(ws + OFF_BB) + (size_t)ldg * 2048;
    const bf16_t* cm = (const bf16_t*)(ws + OFF_CM) + (size_t)ldg * 2048;
#pragma unroll
    for (int b = 0; b < 4; ++b) { BBf[b] = *(const bf16x8*)(bb + (size_t)(b * 32 + r32) * 16 + h * 8); Cmf[b] = *(const bf16x8*)(cm + (size_t)(lane & 15) * 128 + (lane >> 4) * 8 + 32 * b); }
  }
  const bf16_t* U = (const bf16_t*)(ws + OFF_UH);
  float* YP = (float*)(ws + OFF_YP);
  bf16_t* YA = (bf16_t*)(ws + OFF_YA);
  const int sA = (r32 >> 2) & 1, iA = 4 * (r32 >> 3) + (r32 & 3);
  const bf16_t* uA = U + (size_t)(tb0 + sA * L + iA) * INW + g * 16 + h * 8;
  constexpr int RS = 272;
  LAS unsigned char* hb = lds + wave * (32 * RS);
  const f32x4 dsk = *(const f32x4*)(p.in[20] + layer * 512 + g * 16 + (lane >> 4) * 4);
  __syncthreads();
  bf16x8 Af = *(const bf16x8*)(uA + (size_t)(d ? nt - 1 : 0) * 16 * INW);
  for (int n = 0; n < nt; ++n) {
    if (n == nt / 2) __syncthreads();
    const int tile = d ? nt - 1 - n : n;
    const int tilen = (n + 1 < nt) ? (d ? tile - 1 : tile + 1) : tile;
    const bf16x8 Afn = *(const bf16x8*)(uA + (size_t)tilen * 16 * INW);
    const bool second = n >= nt / 2;
    f32x4 po[2] = {{0.f, 0.f, 0.f, 0.f}, {0.f, 0.f, 0.f, 0.f}}; u32x2 pu[2] = {{0u, 0u}, {0u, 0u}};
    if (second) {
#pragma unroll
      for (int ss = 0; ss < 2; ++ss) {
        const int tok = tb0 + ss * L + tile * 16 + (lane & 15), ch = g * 16 + (lane >> 4) * 4;
        po[ss] = *(const f32x4*)(YP + ((size_t)(1 - d) * T_ALL + tok) * 512 + ch);
        pu[ss] = *(const u32x2*)(U + (size_t)tok * INW + ch);
      }
    }
    f32x16 x0, x1, x2, x3;
#pragma unroll
    for (int i = 0; i < 16; ++i) { x0[i] = 0.f; x1[i] = 0.f; x2[i] = 0.f; x3[i] = 0.f; }
    x0 = MFMA32(Af, BBf[0], x0); x1 = MFMA32(Af, BBf[1], x1); x2 = MFMA32(Af, BBf[2], x2); x3 = MFMA32(Af, BBf[3], x3);
#define S5_STEP(i) { const float nr0 = a0r * h0r - a0i * h0i + x0[i], ni0 = a0r * h0i + a0i * h0r + x2[i]; h0r = nr0; h0i = ni0; \
                     const float nr1 = a1r * h1r - a1i * h1i + x1[i], ni1 = a1r * h1i + a1i * h1r + x3[i]; h1r = nr1; h1i = ni1; \
                     *(LAS unsigned*)(hb + (h * 16 + (i)) * RS + r32 * 4) = pk2(h0r, h0i); *(LAS unsigned*)(hb + (h * 16 + (i)) * RS + (r32 + 32) * 4) = pk2(h1r, h1i); }
    if (d == 0) {
#pragma unroll
      for (int i = 0; i < 16; ++i) S5_STEP(i)
    } else {
#pragma unroll
      for (int i = 15; i >= 0; --i) S5_STEP(i)
    }
#undef S5_STEP
    LDS_WAIT();
#pragma unroll
    for (int ss = 0; ss < 2; ++ss) {
      f32x4 y = {0.f, 0.f, 0.f, 0.f};
#pragma unroll
      for (int kb = 0; kb < 4; ++kb) { const bf16x8 Hf = *(const LAS bf16x8*)(hb + (ss * 16 + (lane & 15)) * RS + ((lane >> 4) * 8 + 32 * kb) * 2); y = MFMA16(Cmf[kb], Hf, y); }
      const int tok = tb0 + ss * L + tile * 16 + (lane & 15), ch = g * 16 + (lane >> 4) * 4;
      if (!second) {
        *(f32x4*)(YP + ((size_t)d * T_ALL + tok) * 512 + ch) = y;
      } else {
        const f32x4 uu = {bflo(pu[ss].x), bfhi(pu[ss].x), bflo(pu[ss].y), bfhi(pu[ss].y)};
        f32x4 v = y + po[ss] + uu * dsk, r;
#pragma unroll
        for (int j = 0; j < 4; ++j) { const float t = v[j]; r[j] = t * sigmoidf_(1.5957691216057308f * (t + 0.044715f * t * t * t)); }
        st_bf4(YA + (size_t)tok * 512 + ch, r);
      }
    }
    LDS_WAIT();
    Af = Afn;
  }
  if (!lat) {
    float* so = p.out + 12582912 + 8388608 + 8388608 + ((size_t)(((seq0 + h) * 4 + layer) * 2 + d) * 2) * 2048 + g * 64;
    so[r32] = h0r; so[r32 + 32] = h1r; so[2048 + r32] = h0i; so[2048 + r32 + 32] = h1i;
  }
}

DI void pool_item(const Ctx& p, int layer, int item) {
  const int tid = opaque_tid(), lane = tid & 63, wave = __builtin_amdgcn_readfirstlane(tid >> 6), r32 = lane & 31, h = lane >> 5;
  unsigned char* ws = p.ws;
  const int wi = item * 8 + wave, tt = wi >> 2, g = wi & 3, t0 = tt * 32;
  const int t = t0 + r32;
  const int sbase = t < T_CTX ? (t & ~255) : T_CTX + ((t - T_CTX) & ~1023), L = t < T_CTX ? 256 : 1024, tl = t - sbase;
  const int w = 2 << g;
  int lo = tl - (w >> 1), hi = lo + w; lo = lo < 0 ? 0 : lo; hi = hi > L ? L : hi;
  const float inv = 1.f / (float)(hi - lo);
  const bf16_t* Z = (const bf16_t*)(ws + OFF_UH) + 2048 + g * 128 + h * 8;
  bf16x8 Af[8];
#pragma unroll
  for (int kk = 0; kk < 8; ++kk) {
    float s[8];
#pragma unroll
    for (int j = 0; j < 8; ++j) s[j] = 0.f;
    for (int dt = 0; dt < w; ++dt) {
      const int tp = tl - (w >> 1) + dt; const bool ok = tp >= 0 && tp < L; const int tc = ok ? tp : tl; const float f = ok ? 1.f : 0.f;
      const u32x4 z = *(const u32x4*)(Z + (size_t)(sbase + tc) * INW + 16 * kk);
      s[0] += f * bflo(z.x); s[1] += f * bfhi(z.x); s[2] += f * bflo(z.y); s[3] += f * bfhi(z.y); s[4] += f * bflo(z.z); s[5] += f * bfhi(z.z); s[6] += f * bflo(z.w); s[7] += f * bfhi(z.w);
    }
    const u32x4 z = *(const u32x4*)(Z + (size_t)t * INW + 16 * kk);
    u32x4 o;
    o.x = pk2(s[0] * inv - bflo(z.x), s[1] * inv - bfhi(z.x)); o.y = pk2(s[2] * inv - bflo(z.y), s[3] * inv - bfhi(z.y));
    o.z = pk2(s[4] * inv - bflo(z.z), s[5] * inv - bfhi(z.z)); o.w = pk2(s[6] * inv - bflo(z.w), s[7] * inv - bfhi(z.w));
    Af[kk] = __builtin_bit_cast(bf16x8, o);
  }
  const bf16_t* Wp = (const bf16_t*)(ws + OFF_W) + (size_t)layer * W_LAYER + W_P + (size_t)g * 16384;
  bf16_t* yc = (bf16_t*)(ws + OFF_YS) + (size_t)2 * T_ALL * 512;
#pragma unroll
  for (int nb = 0; nb < 4; ++nb) {
    f32x16 acc;
#pragma unroll
    for (int i = 0; i < 16; ++i) acc[i] = 0.f;
#pragma unroll
    for (int kk = 0; kk < 8; ++kk) { const bf16x8 Bf = *(const bf16x8*)(Wp + (size_t)(nb * 32 + r32) * 128 + h * 8 + 16 * kk); acc = MFMA32(Af[kk], Bf, acc); }
    const int dcol = g * 128 + nb * 32 + r32;
    const float sc = p.in[28][layer * 512 + dcol];
#pragma unroll
    for (int i = 0; i < 16; ++i) { const int row = 8 * (i >> 2) + 4 * h + (i & 3); yc[(size_t)(t0 + row) * 512 + dcol] = (bf16_t)(pk2(acc[i] * sc, 0.f) & 0xffffu); }
  }
}

DI void mixer_item(const Ctx& p, int layer, int it, LAS unsigned char* lds) {
  if (it < 32) s5_item(p, layer, it >> 3, it & 7, lds);
  else if (it < 288) { const int j = it - 32; attn_item(p, layer, true, j >> 5, (j >> 3) & 3, j & 7, lds); }
  else if (it < 352) { const int j = it - 288; s5_item(p, layer, 4 + (j >> 3), j & 7, lds); }
  else if (it < 480) { const int j = it - 352; attn_item(p, layer, false, j >> 3, (j >> 1) & 3, j & 1, lds); }
  else pool_item(p, layer, it - 480);
}
DI void mixer_phase(const Ctx& p, int layer, LAS unsigned char* lds) {
  constexpr int NIT = 480 + 192;
  const int Gd = gridDim.x, w = blockIdx.x;
  for (int r = 0;; ++r) {
    const int it = r * Gd + ((r & 1) ? Gd - 1 - w : w);
    if (r * Gd >= NIT) break;
    if (it < NIT) mixer_item(p, layer, it, lds);
  }
}


#define XB_TMO      128
#define XB_XCNT(j)  (256  + 64 * (j))
#define XB_XSUB(j)  (1280 + 64 * (j))
#define XB_XGEN(j)  (2304 + 64 * (j))
#define XB_TOP      3328
#define XB_TOPGEN   3392
#define XCD_BAR_WORDS 3456
#define XB_SPIN_CAP (1u << 22)
DI unsigned xb_ld(unsigned* p)              { return __hip_atomic_load(p, __ATOMIC_RELAXED, __HIP_MEMORY_SCOPE_AGENT); }
DI unsigned xb_add(unsigned* p, unsigned v) { return __hip_atomic_fetch_add(p, v, __ATOMIC_RELAXED, __HIP_MEMORY_SCOPE_AGENT); }
DI unsigned xb_xcc_id() { return (unsigned)__builtin_amdgcn_s_getreg((3 << 11) | 20) & 0xFu; }
#define XB_SPIN(cond, bar) do { unsigned _sp = 0; while (cond) { __builtin_amdgcn_s_sleep(1); \
    if ((++_sp & 255u) == 0u) { if (xb_ld(&(bar)[XB_TMO])) break; if (_sp > XB_SPIN_CAP) { atomicAdd(&(bar)[XB_TMO], 1u); break; } } } } while (0)
struct XcdBarrier { unsigned* bar; unsigned x; volatile LAS unsigned* st; };
DI XcdBarrier xcd_barrier_post(unsigned* bar, volatile LAS unsigned* st) {
  XcdBarrier b; b.bar = bar; b.x = xb_xcc_id(); b.st = st;
  if (threadIdx.x == 0) (void)xb_add(&bar[XB_XCNT(b.x)], 1u);
  return b;
}
DI void xcd_barrier_complete(unsigned* bar, unsigned x, unsigned& nloc, unsigned& nx) {
  const unsigned G = gridDim.x * gridDim.y * gridDim.z;
  unsigned sum, cnt, mine, sp = 0u;
  for (;;) {
    sum = 0u; cnt = 0u; mine = 0u;
#pragma unroll
    for (unsigned j = 0; j < 16; ++j) { const unsigned c = xb_ld(&bar[XB_XCNT(j)]); sum += c; cnt += (c > 0u) ? 1u : 0u; mine = (j == x) ? c : mine; }
    if (sum == G) break;
    __builtin_amdgcn_s_sleep(1);
    if ((++sp & 255u) == 0u) { if (xb_ld(&bar[XB_TMO])) break; if (sp > XB_SPIN_CAP) { atomicAdd(&bar[XB_TMO], 1u); break; } }
  }
  nloc = mine > 0u ? mine : 1u; nx = cnt > 0u ? cnt : 1u;
}
DI void xcd_barrier(const XcdBarrier& b) {
  asm volatile("s_waitcnt vmcnt(0)" ::: "memory");
  __syncthreads();
  if (threadIdx.x == 0) {
    unsigned* bar = b.bar;
    __builtin_amdgcn_s_waitcnt(0);
    unsigned nloc = b.st[0], nx = b.st[1];
    if (nloc == 0u) { xcd_barrier_complete(bar, b.x, nloc, nx); b.st[0] = nloc; b.st[1] = nx; }
    const unsigned old = xb_add(&bar[XB_XSUB(b.x)], 1u);
    const unsigned gen = old / nloc;
    if (old + 1u == (gen + 1u) * nloc) {
      __builtin_amdgcn_fence(__ATOMIC_RELEASE, "agent");
      asm volatile("s_waitcnt vmcnt(0)" ::: "memory");
      const unsigned og = xb_add(&bar[XB_TOP], 1u);
      const unsigned tg = og / nx;
      if (og + 1u == (tg + 1u) * nx) xb_add(&bar[XB_TOPGEN], 1u);
      else XB_SPIN(xb_ld(&bar[XB_TOPGEN]) == tg, bar);
      __builtin_amdgcn_fence(__ATOMIC_ACQUIRE, "agent");
      xb_add(&bar[XB_XGEN(b.x)], 1u);
      asm volatile("s_waitcnt vmcnt(0)" ::: "memory");
    } else {
      XB_SPIN(xb_ld(&bar[XB_XGEN(b.x)]) == gen, bar);
      __builtin_amdgcn_fence(__ATOMIC_ACQUIRE, "agent");
      asm volatile("s_waitcnt vmcnt(0)" ::: "memory");
    }
  }
  __syncthreads();
}

__global__ void __launch_bounds__(512, 2) fwd_megakernel(Params p0) {
  extern __shared__ __attribute__((aligned(16))) unsigned char shm[];
  LAS unsigned char* lds = (LAS unsigned char*)shm;
  const int G = gridDim.x, c = blockIdx.x;
  __shared__ uint4 xb_words;
  if (threadIdx.x == 0) xb_words = make_uint4(0u, 0u, 0u, 0u);
  __syncthreads();
  const XcdBarrier xb = xcd_barrier_post((unsigned*)(p0.ws + OFF_BAR), (volatile LAS unsigned*)&xb_words);
  for (int phi = p0.ph_lo; phi < p0.ph_hi; ++phi) {
    int ph = phi; asm volatile("" : "+s"(ph));
    Ctx p; p.in.pp = &p0; p.out = p0.out; p.ws = p0.ws;
    asm volatile("" : "+s"(p.out)); asm volatile("" : "+s"(p.ws));
    unsigned char* ws = p.ws;
    if (ph == 0) prep_phase(p, lds);
    else if (ph == NPH - 1) norm_phase(p, 0, 0, false, true);
    else {
      const int layer = (ph - 1) / 12, s = (ph - 1) % 12;
      const bf16_t* wl = (const bf16_t*)(ws + OFF_W) + (size_t)layer * W_LAYER;
      const float* modl = (const float*)(ws + OFF_MOD) + (size_t)layer * 9 * 9216;
      bf16_t* Nb = (bf16_t*)(ws + OFF_N); bf16_t* UH = (bf16_t*)(ws + OFF_UH); float* X = (float*)(ws + OFF_X);
      if (s == 0) norm_phase(p, layer, 0, layer == 0, false);
      else if (s == 3) norm_phase(p, layer, 1, false, false);
      else if (s == 9) norm_phase(p, layer, 2, false, false);
      else if (s == 1 || s == 10) {
        const int f = s == 10;
        pg8::Gemm g{Nb, wl + W_FI + (size_t)f * 5632 * 1024, T_ALL, 5632, 1024};
        pg8::StaticOrder S; S.init(g.M, g.N, G, c);
        EpiSwiglu E{UH};
        pg8::gemm_phase(lds, g, S, E);
      } else if (s == 2 || s == 11) {
        const int f = s == 11;
        pg8::Gemm g{UH, wl + W_FO + (size_t)f * 1024 * 2816, T_ALL, 1024, 2816};
        pg8::StaticOrder S; S.init(g.M, g.N, G, c);
        EpiResid E{X, modl, f ? 8 : 2, 0.5f};
        pg8::gemm_phase(lds, g, S, E);
      } else if (s == 4) {
        pg8::Gemm g{Nb, wl + W_IN, T_ALL, 5632, 1024};
        pg8::StaticOrder S; S.init(g.M, g.N, G, c);
        EpiWin E{UH, (bf16_t*)(ws + OFF_Q), (bf16_t*)(ws + OFF_K), (bf16_t*)(ws + OFF_V), p.out + 12582912, p.out + 12582912 + 8388608, (const float*)(ws + OFF_ROPE), layer};
        pg8::gemm_phase(lds, g, S, E);
      } else if (s == 5) {
        mixer_phase(p, layer, lds);
      } else if (s == 6) {
        pg8::Gemm g{(const bf16_t*)(ws + OFF_YA), wl + W_GLU, T_ALL, 512, 512};
        pg8::StaticOrder S; S.init(g.M, g.N, G, c);
        EpiGlu E{(const bf16_t*)(ws + OFF_YA), (bf16_t*)(ws + OFF_YS)};
        pg8::gemm_phase(lds, g, S, E);
      } else if (s == 7) {
        pg8::Gemm g{(const bf16_t*)(ws + OFF_YS), wl + W_BR, 3 * T_ALL, 3072, 512};
        pg8::BranchOrder S{G, c};
        EpiBranch E{UH, (float*)(ws + OFF_YP), Nb};
        pg8::gemm_phase(lds, g, S, E);
      } else if (s == 8) {
        pg8::Gemm g{Nb, wl + W_OUT, T_ALL, 1024, 1024};
        pg8::StaticOrder S; S.init(g.M, g.N, G, c);
        EpiResid E{X, modl, 5, 1.0f};
        pg8::gemm_phase(lds, g, S, E);
      }
    }
    if (phi + 1 < p0.ph_hi) { if (phi == p0.ph_lo) cg::this_grid().sync(); else xcd_barrier(xb); }
  }
}

extern "C" void kernel_launch(void* const* d_in, const int* in_sizes, int n_in, void* d_out, int out_size, void* d_ws, size_t ws_size, hipStream_t stream) {
  static int grid = 0;
  if (grid == 0) {
    int dev = 0, cus = 0, per_cu = 0;
    hipGetDevice(&dev);
    hipDeviceGetAttribute(&cus, hipDeviceAttributeMultiprocessorCount, dev);
    if (hipFuncSetAttribute((const void*)fwd_megakernel, hipFuncAttributeMaxDynamicSharedMemorySize, LDS_BYTES) != hipSuccess) fprintf(stderr, "hipFuncSetAttribute failed\n");
    hipOccupancyMaxActiveBlocksPerMultiprocessor(&per_cu, (const void*)fwd_megakernel, 512, LDS_BYTES);
    if (per_cu < 1) { fprintf(stderr, "occupancy query gave %d\n", per_cu); per_cu = 1; }
    (void)hipGetLastError();
    grid = cus * per_cu;
    if (ws_size < WS_END) fprintf(stderr, "workspace too small: %zu\n", ws_size);
  }
  if (hipMemsetAsync((unsigned char*)d_ws + OFF_BAR, 0, 16384, stream) != hipSuccess) fprintf(stderr, "memset failed\n");
  Params p{};
  for (int i = 0; i < 32; ++i) p.in[i] = (const float*)d_in[i];
  p.out = (float*)d_out; p.ws = (unsigned char*)d_ws;
#if COOP
  p.ph_lo = 0; p.ph_hi = NPH;
  void* args[] = {&p};
  hipError_t e = hipLaunchCooperativeKernel((const void*)fwd_megakernel, dim3(grid), dim3(512), args, LDS_BYTES, stream);
  if (e != hipSuccess) fprintf(stderr, "cooperative launch failed: %s (grid %d)\n", hipGetErrorString(e), grid);
#else
  for (int ph = 0; ph < NPH; ++ph) {
    p.ph_lo = ph; p.ph_hi = ph + 1;
    hipLaunchKernelGGL(fwd_megakernel, dim3(grid), dim3(512), LDS_BYTES, stream, p);
  }
#endif
}
```

```cpp
#include <hip/hip_runtime.h>
#include <hip/hip_cooperative_groups.h>
#include <cstdio>
namespace cg = cooperative_groups;

#ifndef COOP
#define COOP 1
#endif

#define LAS __attribute__((address_space(3)))
#define GAS __attribute__((address_space(1)))
typedef unsigned short bf16_t;
typedef short bf16x8 __attribute__((ext_vector_type(8)));
typedef short s16x4 __attribute__((ext_vector_type(4)));
typedef float f32x2 __attribute__((ext_vector_type(2)));
typedef float f32x4 __attribute__((ext_vector_type(4)));
typedef float f32x16 __attribute__((ext_vector_type(16)));
typedef unsigned u32x4 __attribute__((ext_vector_type(4)));
typedef unsigned u32x2 __attribute__((ext_vector_type(2)));
typedef __bf16 nbf16x2 __attribute__((ext_vector_type(2)));
#define DI __device__ __forceinline__

constexpr int T_CTX = 4096, T_ALL = 12288, DM = 1024, DFF = 2816, INW = 5632, NPH = 50;
constexpr size_t OFF_X = 0;
constexpr size_t OFF_N = OFF_X + 50331648;
constexpr size_t OFF_UH = OFF_N + 25165824;
constexpr size_t OFF_Q = OFF_UH + 138412032;
constexpr size_t OFF_K = OFF_Q + 12582912;
constexpr size_t OFF_V = OFF_K + 12582912;
constexpr size_t OFF_KC = OFF_V + 12582912;
constexpr size_t OFF_VC = OFF_KC + 16777216;
constexpr size_t OFF_YP = OFF_VC + 16777216;
constexpr size_t OFF_YA = OFF_YP + 50331648;
constexpr size_t OFF_YS = OFF_YA + 12582912;
constexpr size_t OFF_MOD = OFF_YS + 37748736;
constexpr size_t OFF_BB = OFF_MOD + 1327104;
constexpr size_t OFF_CM = OFF_BB + 1048576;
constexpr size_t OFF_AT = OFF_CM + 1048576;
constexpr size_t OFF_ROPE = OFF_AT + 131072;
constexpr size_t OFF_LAM = OFF_ROPE + 262144;
constexpr size_t OFF_W = OFF_LAM + 256;
constexpr size_t W_FI = 0;
constexpr size_t W_FO = W_FI + 11534336;
constexpr size_t W_IN = W_FO + 5767168;
constexpr size_t W_GLU = W_IN + 5767168;
constexpr size_t W_BR = W_GLU + 262144;
constexpr size_t W_OUT = W_BR + 1572864;
constexpr size_t W_P = W_OUT + 1048576;
constexpr size_t W_LAYER = W_P + 65536;
constexpr size_t OFF_BAR = OFF_W + 4 * W_LAYER * 2;
constexpr size_t WS_END = OFF_BAR + 16384;
constexpr int LDS_BYTES = 131072;

struct Params {
  const float* in[32];
  float* out;
  unsigned char* ws;
  int ph_lo, ph_hi;
};
struct InTab { const Params* pp; __device__ __forceinline__ const float* operator[](int i) const { asm volatile("" : "+s"(i)); return pp->in[i]; } };
struct Ctx { InTab in; float* out; unsigned char* ws; };

DI int opaque_tid() { int t = threadIdx.x; asm volatile("" : "+v"(t)); return t; }
DI unsigned pk2(float lo, float hi) { f32x2 v = {lo, hi}; nbf16x2 b = __builtin_convertvector(v, nbf16x2); return __builtin_bit_cast(unsigned, b); }
DI float gldf(const float* p) { return *(const GAS float*)p; }
DI void gstf(float* p, float v) { *(GAS float*)p = v; }
DI float bf2f(unsigned short b) { return __uint_as_float(((unsigned)b) << 16); }
DI float bflo(unsigned u) { return __uint_as_float(u << 16); }
DI float bfhi(unsigned u) { return __uint_as_float(u & 0xffff0000u); }
DI float sigmoidf_(float x) { return __builtin_amdgcn_rcpf(1.f + __expf(-x)); }
DI float wave_sum(float v) {
#pragma unroll
  for (int o = 1; o < 64; o <<= 1) v += __shfl_xor(v, o);
  return v;
}
#define LDS_WAIT() asm volatile("s_waitcnt lgkmcnt(0)" ::: "memory")

namespace pg8 {
constexpr int BM = 256, BK = 64, HALF = 128, HTB = HALF * BK * 2, NXCD = 8, WGM = 8;
DI int lds_byte(int r, int c) { const int st = (r >> 4) * 2 + (c >> 5), rr = r & 15, cc = c & 31, ob = rr * 64 + cc * 2; return st * 1024 + (ob ^ (((ob >> 9) & 1) << 5)); }
DI void stage_rc(int b, int& R, int& C) { const int st = b / 1024, sb = b % 1024, swz = sb ^ (((sb >> 9) & 1) << 5); R = (st >> 1) * 16 + swz / 64; C = (st & 1) * 32 + (swz % 64) / 2; }
struct Unit { int pm, pn; };
struct Gemm { const bf16_t* A; const bf16_t* Bt; int M, N, K; };
struct StaticOrder {
  int nM, nN, nwg, G, c;
  DI void init(int M, int N, int G_, int c_) { nM = M / BM; nN = N / BM; nwg = nM * nN; G = G_; c = c_; }
  DI bool next(int i, Unit& u) const {
    const long L = (long)i * G + c; if (L >= nwg) return false;
    int wgid = (int)L; { const int q = nwg / NXCD, r = nwg % NXCD, xcd = wgid % NXCD, off = wgid / NXCD; wgid = (xcd < r ? xcd * (q + 1) : r * (q + 1) + (xcd - r) * q) + off; }
    const int nig = WGM * nN, gid = wgid / nig, fm = gid * WGM, gsz = (nM - fm) < WGM ? (nM - fm) : WGM;
    u.pm = fm + ((wgid % nig) % gsz); u.pn = (wgid % nig) / gsz; return true;
  }
};
struct BranchOrder {
  int G, c;
  DI bool next(int i, Unit& u) const { const int tile = (i / 3) * G + c; if (tile >= 192) return false; const int n = i % 3; u.pm = n * 48 + (tile >> 2); u.pn = n * 4 + (tile & 3); return true; }
};

template <class Epi, class Sched>
DI void gemm_phase(LAS unsigned char* lds, const Gemm g, const Sched& S, const Epi& E) {
  const int tid = opaque_tid(), wid = __builtin_amdgcn_readfirstlane(tid >> 6), lane = tid & 63, wr = wid >> 2, wc = wid & 3, fr = lane & 15, fq = lane >> 4;
  const int K = g.K, nt = K / BK;
  unsigned voffA[2], voffB[2];
#pragma unroll
  for (int i = 0; i < 2; ++i) { int R, C; stage_rc(tid * 16 + i * 8192, R, C); voffA[i] = (unsigned)(R * K + C) * 2u; voffB[i] = voffA[i]; }
  const size_t kstep = (size_t)(BK * 2);
  const size_t hstep = (size_t)HALF * K * 2;
  const size_t tstep = 2 * hstep;
  const unsigned ldsw = (unsigned)wid * 1024u;
  const int aoff = lds_byte(wr * 64 + fr, fq * 8), boff = lds_byte(wc * 32 + fr, fq * 8);
#define PG8_SA(b, h) (((b) * 2 + (h)) * HTB)
#define PG8_SB(b, h) ((4 + (b) * 2 + (h)) * HTB)
#define PG8_STAGE(bufoff, gbase, voff) do { _Pragma("unroll") for (int _i = 0; _i < 2; ++_i) \
    __builtin_amdgcn_global_load_lds((const unsigned*)((const char*)(gbase) + (voff)[_i]), (LAS unsigned*)(lds + (bufoff) + ldsw + _i * 8192), 16, 0, 0); } while (0)
#define PG8_LDA(dst, b, h) do { _Pragma("unroll") for (int m = 0; m < 4; ++m) _Pragma("unroll") for (int k = 0; k < 2; ++k) dst[m][k] = *(const LAS bf16x8*)(lds + PG8_SA(b, h) + aoff + m * 2048 + k * 1024); } while (0)
#define PG8_LDB(dst, b, h) do { _Pragma("unroll") for (int n = 0; n < 2; ++n) _Pragma("unroll") for (int k = 0; k < 2; ++k) dst[n][k] = *(const LAS bf16x8*)(lds + PG8_SB(b, h) + boff + n * 2048 + k * 1024); } while (0)
#define PG8_MMA(ai, bj, At, Bt) do { __builtin_amdgcn_s_setprio(1); _Pragma("unroll") for (int m = 0; m < 4; ++m) _Pragma("unroll") for (int n = 0; n < 2; ++n) _Pragma("unroll") for (int k = 0; k < 2; ++k) \
    acc[ai][bj][m][n] = __builtin_amdgcn_mfma_f32_16x16x32_bf16(Bt[n][k], At[m][k], acc[ai][bj][m][n], 0, 0, 0); __builtin_amdgcn_s_setprio(0); } while (0)
#define PG8_WAIT_V(n) asm volatile("s_waitcnt vmcnt(" #n ")" ::: "memory")
#define PG8_WAIT_L(n) asm volatile("s_waitcnt lgkmcnt(" #n ")" ::: "memory")
#define PG8_BAR __builtin_amdgcn_s_barrier()
#define PG8_SCHED __builtin_amdgcn_sched_barrier(0)
  Unit cur, nxt; int ui = 0;
  if (!S.next(0, cur)) return;
  f32x4 acc[2][2][4][2];
#pragma unroll
  for (int a = 0; a < 2; ++a)
#pragma unroll
    for (int b = 0; b < 2; ++b)
#pragma unroll
      for (int m = 0; m < 4; ++m)
#pragma unroll
        for (int n = 0; n < 2; ++n) acc[a][b][m][n] = (f32x4){0.f, 0.f, 0.f, 0.f};
  bf16x8 At[4][2], B0[2][2], B1[2][2];
  const char* cA = (const char*)g.A + (size_t)cur.pm * tstep; const char* cB = (const char*)g.Bt + (size_t)cur.pn * tstep;
  PG8_STAGE(PG8_SB(0, 0), cB, voffB); PG8_STAGE(PG8_SA(0, 0), cA, voffA); PG8_STAGE(PG8_SB(0, 1), cB + hstep, voffB); PG8_STAGE(PG8_SA(0, 1), cA + hstep, voffA);
  if (wr == 1) PG8_BAR;
  PG8_WAIT_V(4); PG8_BAR;
  PG8_STAGE(PG8_SB(1, 0), cB + kstep, voffB); PG8_STAGE(PG8_SA(1, 0), cA + kstep, voffA); PG8_STAGE(PG8_SB(1, 1), cB + hstep + kstep, voffB);
  PG8_WAIT_V(6); PG8_BAR;
  for (;;) {
    const bool has_next = S.next(ui + 1, nxt);
    const char* nA = has_next ? (const char*)g.A + (size_t)nxt.pm * tstep : cA; const char* nB = has_next ? (const char*)g.Bt + (size_t)nxt.pn * tstep : cB;
    for (int t = 0; t < nt; t += 2) {
      const bool last = (t == nt - 2);
      const char* a1 = cA + (size_t)(t + 1) * kstep;
      const char* a2 = last ? nA : cA + (size_t)(t + 2) * kstep; const char* b2 = last ? nB : cB + (size_t)(t + 2) * kstep;
      const char* a3 = a2 + kstep; const char* b3 = b2 + kstep;
      PG8_LDB(B0, 0, 0); PG8_SCHED; PG8_LDA(At, 0, 0); PG8_STAGE(PG8_SA(1, 1), a1 + hstep, voffA);
      PG8_WAIT_L(8); PG8_BAR; PG8_WAIT_L(0); PG8_MMA(0, 0, At, B0); PG8_BAR; PG8_SCHED;
      PG8_LDB(B1, 0, 1); PG8_STAGE(PG8_SB(0, 0), b2, voffB);
      PG8_BAR; PG8_WAIT_L(0); PG8_MMA(0, 1, At, B1); PG8_BAR;
      PG8_LDA(At, 0, 1); PG8_STAGE(PG8_SA(0, 0), a2, voffA);
      PG8_BAR; PG8_WAIT_L(0); PG8_MMA(1, 0, At, B0); PG8_BAR; PG8_SCHED;
      PG8_STAGE(PG8_SB(0, 1), b2 + hstep, voffB);
      PG8_WAIT_V(6); PG8_BAR; PG8_MMA(1, 1, At, B1); PG8_BAR;
      PG8_LDB(B0, 1, 0); PG8_SCHED; PG8_LDA(At, 1, 0); PG8_STAGE(PG8_SA(0, 1), a2 + hstep, voffA);
      PG8_WAIT_L(8); PG8_BAR; PG8_WAIT_L(0); PG8_MMA(0, 0, At, B0); PG8_BAR; PG8_SCHED;
      PG8_LDB(B1, 1, 1); PG8_STAGE(PG8_SB(1, 0), b3, voffB);
      PG8_BAR; PG8_WAIT_L(0); PG8_MMA(0, 1, At, B1); PG8_BAR;
      PG8_LDA(At, 1, 1); PG8_STAGE(PG8_SA(1, 0), a3, voffA);
      PG8_BAR; PG8_WAIT_L(0); PG8_MMA(1, 0, At, B0); PG8_BAR; PG8_SCHED;
      PG8_STAGE(PG8_SB(1, 1), b3 + hstep, voffB);
      PG8_WAIT_V(6); PG8_BAR; PG8_MMA(1, 1, At, B1); PG8_BAR;
    }
    E(acc, cur, wr, wc, fr, fq);
    if (!has_next) break;
#pragma unroll
    for (int a = 0; a < 2; ++a)
#pragma unroll
      for (int b = 0; b < 2; ++b)
#pragma unroll
        for (int m = 0; m < 4; ++m)
#pragma unroll
          for (int n = 0; n < 2; ++n) acc[a][b][m][n] = (f32x4){0.f, 0.f, 0.f, 0.f};
    cur = nxt; cA = nA; cB = nB; ++ui;
  }
  PG8_WAIT_V(0);
  if (wr == 0) PG8_BAR;
  PG8_BAR;
#undef PG8_SA
#undef PG8_SB
#undef PG8_STAGE
#undef PG8_LDA
#undef PG8_LDB
#undef PG8_MMA
#undef PG8_WAIT_V
#undef PG8_WAIT_L
#undef PG8_BAR
#undef PG8_SCHED
}
}
using pg8::Unit;

typedef f32x4 AccT[2][2][4][2];
DI void st_bf4(bf16_t* p, f32x4 v) { u32x2 w; w.x = pk2(v[0], v[1]); w.y = pk2(v[2], v[3]); *(GAS u32x2*)p = w; }
DI f32x4 ld_bf4(const bf16_t* p) { const u32x2 w = *(const GAS u32x2*)p; return (f32x4){bflo(w.x), bfhi(w.x), bflo(w.y), bfhi(w.y)}; }

struct EpiSwiglu {
  bf16_t* H;
  DI void operator()(const AccT& acc, const Unit& u, int wr, int wc, int fr, int fq) const {
    const int row0 = u.pm * 256 + wr * 64 + fr, col0 = u.pn * 128 + wc * 32 + 4 * fq;
#pragma unroll
    for (int ai = 0; ai < 2; ++ai)
#pragma unroll
      for (int m = 0; m < 4; ++m) {
        bf16_t* rowp = H + (size_t)(row0 + ai * 128 + m * 16) * DFF + col0;
#pragma unroll
        for (int n = 0; n < 2; ++n) {
          const f32x4 a = acc[ai][0][m][n], b = acc[ai][1][m][n]; f32x4 h;
#pragma unroll
          for (int j = 0; j < 4; ++j) h[j] = a[j] * sigmoidf_(a[j]) * b[j];
          st_bf4(rowp + n * 16, h);
        }
      }
  }
};
struct EpiResid {
  float* X; const float* modl; int gate_idx; float coef;
  DI void operator()(const AccT& acc, const Unit& u, int wr, int wc, int fr, int fq) const {
    const int mrow = u.pm < 16 ? 8 : ((u.pm - 16) >> 2);
    const int row0 = u.pm * 256 + wr * 64 + fr, col0 = u.pn * 256 + wc * 32 + 4 * fq;
    const float* gp = modl + (size_t)mrow * 9216 + gate_idx * 1024 + col0;
    f32x4 gv[2][2];
#pragma unroll
    for (int bj = 0; bj < 2; ++bj)
#pragma unroll
      for (int n = 0; n < 2; ++n) gv[bj][n] = *(const GAS f32x4*)(gp + bj * 128 + n * 16) * coef;
#pragma unroll
    for (int ai = 0; ai < 2; ++ai)
#pragma unroll
      for (int m = 0; m < 4; ++m) {
        float* rowp = X + (size_t)(row0 + ai * 128 + m * 16) * DM + col0;
#pragma unroll
        for (int bj = 0; bj < 2; ++bj)
#pragma unroll
          for (int n = 0; n < 2; ++n) { GAS f32x4* q = (GAS f32x4*)(rowp + bj * 128 + n * 16); *q = *q + gv[bj][n] * acc[ai][bj][m][n]; }
      }
  }
};
struct EpiWin {
  bf16_t* U; bf16_t* Q; bf16_t* Kb; bf16_t* Vb; float* outk; float* outv; const float* rope; int layer;
  DI void operator()(const AccT& acc, const Unit& u, int wr, int wc, int fr, int fq) const {
    const int pn = u.pn, row0 = u.pm * 256 + wr * 64 + fr;
    const bool lat = u.pm >= 16;
    if (pn < 2 || pn >= 8) {
      const int col0 = pn * 256 + wc * 32 + 4 * fq;
#pragma unroll
      for (int ai = 0; ai < 2; ++ai)
#pragma unroll
        for (int m = 0; m < 4; ++m) {
          bf16_t* rowp = U + (size_t)(row0 + ai * 128 + m * 16) * INW + col0;
#pragma unroll
          for (int bj = 0; bj < 2; ++bj)
#pragma unroll
            for (int n = 0; n < 2; ++n) st_bf4(rowp + bj * 128 + n * 16, acc[ai][bj][m][n]);
        }
    } else if (pn < 6) {
      const bool isq = pn < 4;
      const int cq0 = (pn & 1) * 256 + wc * 32 + 4 * fq;
      const float scale = isq ? 0.125f * 1.4426950408889634f : 1.f;
      bf16_t* dstb = isq ? Q : Kb;
#pragma unroll
      for (int ai = 0; ai < 2; ++ai)
#pragma unroll
        for (int m = 0; m < 4; ++m) {
          const int row = row0 + ai * 128 + m * 16;
          f32x4 cs = {1.f, 1.f, 1.f, 1.f}, sn = {0.f, 0.f, 0.f, 0.f};
          if (lat) {
            const int pos = (row - T_CTX) & 1023;
            const float* rp = rope + (size_t)pos * 64 + ((wc & 1) * 16 + 4 * fq) * 2;
            const f32x4 r0 = *(const GAS f32x4*)rp, r1 = *(const GAS f32x4*)(rp + 4);
            cs = (f32x4){r0[0], r0[2], r1[0], r1[2]}; sn = (f32x4){r0[1], r0[3], r1[1], r1[3]};
          }
#pragma unroll
          for (int bj = 0; bj < 2; ++bj) {
            const f32x4 y1 = acc[ai][bj][m][0], y2 = acc[ai][bj][m][1];
            const f32x4 o1 = y1 * cs - y2 * sn, o2 = y2 * cs + y1 * sn;
            bf16_t* d = dstb + (size_t)row * 512 + cq0 + bj * 128;
            st_bf4(d, o1 * scale); st_bf4(d + 16, o2 * scale);
            if (!isq && !lat) {
              float* o = outk + ((size_t)((row >> 8) * 4 + layer) * 256 + (row & 255)) * 512 + cq0 + bj * 128;
              *(GAS f32x4*)o = o1; *(GAS f32x4*)(o + 16) = o2;
            }
          }
        }
    } else {
      const int cv0 = (pn & 1) * 256 + wc * 32 + 4 * fq;
#pragma unroll
      for (int ai = 0; ai < 2; ++ai)
#pragma unroll
        for (int m = 0; m < 4; ++m) {
          const int row = row0 + ai * 128 + m * 16;
#pragma unroll
          for (int bj = 0; bj < 2; ++bj)
#pragma unroll
            for (int n = 0; n < 2; ++n) {
              st_bf4(Vb + (size_t)row * 512 + cv0 + bj * 128 + n * 16, acc[ai][bj][m][n]);
              if (!lat) *(GAS f32x4*)(outv + ((size_t)((row >> 8) * 4 + layer) * 256 + (row & 255)) * 512 + cv0 + bj * 128 + n * 16) = acc[ai][bj][m][n];
            }
        }
    }
  }
};
struct EpiGlu {
  const bf16_t* ya; bf16_t* ys0;
  DI void operator()(const AccT& acc, const Unit& u, int wr, int wc, int fr, int fq) const {
    const int row0 = u.pm * 256 + wr * 64 + fr, col0 = u.pn * 256 + wc * 32 + 4 * fq;
#pragma unroll
    for (int ai = 0; ai < 2; ++ai)
#pragma unroll
      for (int m = 0; m < 4; ++m) {
        const size_t ro = (size_t)(row0 + ai * 128 + m * 16) * 512 + col0;
#pragma unroll
        for (int bj = 0; bj < 2; ++bj)
#pragma unroll
          for (int n = 0; n < 2; ++n) {
            const f32x4 y = ld_bf4(ya + ro + bj * 128 + n * 16), a = acc[ai][bj][m][n]; f32x4 o;
#pragma unroll
            for (int j = 0; j < 4; ++j) o[j] = y[j] * sigmoidf_(a[j]);
            st_bf4(ys0 + ro + bj * 128 + n * 16, o);
          }
      }
  }
};
struct EpiBranch {
  const bf16_t* U; float* MRG; bf16_t* MERGED;
  DI void operator()(const AccT& acc, const Unit& u, int wr, int wc, int fr, int fq) const {
    const int n3 = u.pm / 48, pm = u.pm - n3 * 48, pn = u.pn & 3;
    const int row0 = pm * 256 + wr * 64 + fr, col0 = pn * 256 + wc * 32 + 4 * fq;
#pragma unroll
    for (int ai = 0; ai < 2; ++ai)
#pragma unroll
      for (int m = 0; m < 4; ++m) {
        const int row = row0 + ai * 128 + m * 16;
        const bf16_t* gp = U + (size_t)row * INW + 2560 + n3 * 1024 + col0;
        float* mp = MRG + (size_t)row * DM + col0;
        bf16_t* op = MERGED + (size_t)row * DM + col0;
#pragma unroll
        for (int bj = 0; bj < 2; ++bj)
#pragma unroll
          for (int n = 0; n < 2; ++n) {
            const f32x4 gt = ld_bf4(gp + bj * 128 + n * 16), a = acc[ai][bj][m][n]; f32x4 o;
#pragma unroll
            for (int j = 0; j < 4; ++j) o[j] = sigmoidf_(gt[j]) * a[j];
            GAS f32x4* q = (GAS f32x4*)(mp + bj * 128 + n * 16);
            if (n3 == 0) *q = o;
            else if (n3 == 1) *q = *q + o;
            else st_bf4(op + bj * 128 + n * 16, *q + o);
          }
      }
  }
};

struct TrItem { const float* W; bf16_t* WT; int K, N, swiglu, item; };
DI void tr_load(const TrItem& t, int lane, float (&v)[32]) {
  const int nblk = t.N / 32, kb = t.item / nblk, nb = t.item % nblk, k0 = 64 * kb, n0 = 32 * nb;
#pragma unroll
  for (int i = 0; i < 32; ++i) { const int kk = 2 * i + (lane >> 5); v[i] = gldf(t.W + (size_t)(k0 + kk) * t.N + n0 + (lane & 31)); }
}
DI void tr_finish(const TrItem& t, int lane, const float (&v)[32], LAS float* scr) {
  const int nblk = t.N / 32, kb = t.item / nblk, nb = t.item % nblk, k0 = 64 * kb, n0 = 32 * nb;
#pragma unroll
  for (int i = 0; i < 32; ++i) { const int kk = 2 * i + (lane >> 5); scr[kk * 33 + (lane & 31)] = v[i]; }
  LDS_WAIT();
  const int c = lane & 7;
#pragma unroll
  for (int j = 0; j < 4; ++j) {
    const int n = (lane >> 3) + 8 * j; const LAS float* s = scr + (8 * c) * 33 + n;
    u32x4 o; o.x = pk2(s[0 * 33], s[1 * 33]); o.y = pk2(s[2 * 33], s[3 * 33]); o.z = pk2(s[4 * 33], s[5 * 33]); o.w = pk2(s[6 * 33], s[7 * 33]);
    int dr = n0 + n;
    if (t.swiglu) { const int isb = dr >= DFF, hh = isb ? dr - DFF : dr; dr = (hh >> 7) * 256 + isb * 128 + (hh & 127); }
    *(GAS u32x4*)(t.WT + (size_t)dr * t.K + k0 + 8 * c) = o;
  }
  LDS_WAIT();
}
DI TrItem tr_decode(const Ctx& p, int it) {
  constexpr int I_FI = 16 * 176, I_FO = 44 * 32, I_IN = 16 * 176, I_GLU = 8 * 16, I_BR = 8 * 32, I_OUT = 16 * 32, I_P = 2 * 4;
  constexpr int I_LAYER = 2 * I_FI + 2 * I_FO + I_IN + I_GLU + 3 * I_BR + I_OUT + 4 * I_P;
  const int l = it / I_LAYER; int r = it % I_LAYER;
  bf16_t* wl = (bf16_t*)(p.ws + OFF_W) + (size_t)l * W_LAYER;
  TrItem t;
  if (r < 2 * I_FI) { const int s = r / I_FI; t = TrItem{p.in[10] + (size_t)(l * 2 + s) * 1024 * 5632, wl + W_FI + (size_t)s * 5632 * 1024, 1024, 5632, 1, r % I_FI}; return t; } r -= 2 * I_FI;
  if (r < 2 * I_FO) { const int s = r / I_FO; t = TrItem{p.in[11] + (size_t)(l * 2 + s) * 2816 * 1024, wl + W_FO + (size_t)s * 1024 * 2816, 2816, 1024, 0, r % I_FO}; return t; } r -= 2 * I_FO;
  if (r < I_IN) { t = TrItem{p.in[12] + (size_t)l * 1024 * 5632, wl + W_IN, 1024, 5632, 0, r}; return t; } r -= I_IN;
  if (r < I_GLU) { t = TrItem{p.in[21] + (size_t)l * 512 * 512, wl + W_GLU, 512, 512, 0, r}; return t; } r -= I_GLU;
  if (r < 3 * I_BR) { const int s = r / I_BR; t = TrItem{p.in[29] + (size_t)(l * 3 + s) * 512 * 1024, wl + W_BR + (size_t)s * 1024 * 512, 512, 1024, 0, r % I_BR}; return t; } r -= 3 * I_BR;
  if (r < I_OUT) { t = TrItem{p.in[30] + (size_t)l * 1024 * 1024, wl + W_OUT, 1024, 1024, 0, r}; return t; } r -= I_OUT;
  { const int s = r / I_P; t = TrItem{p.in[27] + (size_t)(l * 4 + s) * 128 * 128, wl + W_P + (size_t)s * 128 * 128, 128, 128, 0, r % I_P}; return t; }
}
constexpr int TR_ITEMS = 4 * (2 * 16 * 176 + 2 * 44 * 32 + 16 * 176 + 8 * 16 + 3 * 8 * 32 + 16 * 32 + 4 * 2 * 4);

DI void prep_phase(const Ctx& p, LAS unsigned char* lds) {
  const int tid = opaque_tid(), lane = tid & 63, wave = tid >> 6;
  unsigned char* ws = p.ws;
  for (int item = blockIdx.x; item < 144; item += gridDim.x) {
    const int l = item / 36, jc = item % 36;
    LAS float* sc = (LAS float*)lds;
    LAS float* red = sc + 9 * 1024;
    for (int i = tid; i < 9 * 1024; i += 512) { const int r = i >> 10, k = i & 1023; const float v = r < 8 ? gldf(p.in[5] + r * 1024 + k) : gldf(p.in[6] + k); sc[i] = v * sigmoidf_(v); }
    __syncthreads();
    const int j0 = jc * 256 + lane * 4;
    const float* w = p.in[8] + (size_t)l * 1024 * 9216 + (size_t)(wave * 128) * 9216 + j0;
    f32x4 acc[9];
#pragma unroll
    for (int r = 0; r < 9; ++r) acc[r] = (f32x4){0.f, 0.f, 0.f, 0.f};
    const LAS float* s0 = sc + wave * 128;
#pragma unroll 8
    for (int k = 0; k < 128; ++k) {
      const f32x4 wv = *(const GAS f32x4*)(w + (size_t)k * 9216);
#pragma unroll
      for (int r = 0; r < 9; ++r) acc[r] += wv * s0[r * 1024 + k];
    }
#pragma unroll
    for (int r = 0; r < 9; ++r) *(LAS f32x4*)(red + (wave * 9 + r) * 256 + lane * 4) = acc[r];
    __syncthreads();
    for (int o = tid; o < 9 * 256; o += 512) {
      const int r = o >> 8, col = o & 255; float s = 0.f;
#pragma unroll
      for (int w8 = 0; w8 < 8; ++w8) s += red[(w8 * 9 + r) * 256 + col];
      gstf((float*)(ws + OFF_MOD) + ((size_t)l * 9 + r) * 9216 + jc * 256 + col, s + gldf(p.in[9] + l * 9216 + jc * 256 + col));
    }
    __syncthreads();
  }
  {
    LAS float* scr = (LAS float*)(lds + wave * 8448);
    const int gw = blockIdx.x * 8 + wave, NGW = gridDim.x * 8;
    if (gw < TR_ITEMS) {
      TrItem cur = tr_decode(p, gw); float va[32], vb[32];
      tr_load(cur, lane, va);
      for (int it = gw; it < TR_ITEMS; it += 2 * NGW) {
        const bool h1 = it + NGW < TR_ITEMS, h2 = it + 2 * NGW < TR_ITEMS;
        TrItem nx = cur;
        if (h1) { nx = tr_decode(p, it + NGW); tr_load(nx, lane, vb); }
        tr_finish(cur, lane, va, scr);
        if (h1) {
          if (h2) { cur = tr_decode(p, it + 2 * NGW); tr_load(cur, lane, va); }
          tr_finish(nx, lane, vb, scr);
        }
      }
    }
  }
  const size_t gt = (size_t)blockIdx.x * 512 + tid, GT = (size_t)gridDim.x * 512;
  for (size_t i = gt; i < 2 * 1048576; i += GT) {
    const int which = i >= 1048576; const size_t e = (i & 1048575) * 8;
    const float* src = (which ? p.in[3] : p.in[2]) + e;
    const f32x4 a = *(const GAS f32x4*)src, b = *(const GAS f32x4*)(src + 4);
    u32x4 o; o.x = pk2(a[0], a[1]); o.y = pk2(a[2], a[3]); o.z = pk2(b[0], b[1]); o.w = pk2(b[2], b[3]);
    *(GAS u32x4*)((bf16_t*)(ws + (which ? OFF_VC : OFF_KC)) + e) = o;
  }
  for (size_t i = gt; i < 16384; i += GT) {
    const int pI = (int)(i & 63), ldg = (int)(i >> 6);
    const float lr = gldf(p.in[13] + i), li = gldf(p.in[14] + i), dt = expf(gldf(p.in[15] + ldg));
    const float mag = expf(lr * dt), abr = mag * cosf(li * dt), abi = mag * sinf(li * dt);
    const float den = lr * lr + li * li, nr = abr - 1.0f, kr = (nr * lr + abi * li) / den, ki = (abi * lr - nr * li) / den;
    float* at = (float*)(ws + OFF_AT) + i * 2; gstf(at, abr); gstf(at + 1, abi);
    bf16_t* bbp = (bf16_t*)(ws + OFF_BB) + (size_t)ldg * 2048;
    const float* bre = p.in[16] + i * 16; const float* bim = p.in[17] + i * 16;
    for (int c = 0; c < 16; c += 2) {
      const float br0 = gldf(bre + c), bi0 = gldf(bim + c), br1 = gldf(bre + c + 1), bi1 = gldf(bim + c + 1);
      *(GAS unsigned*)(bbp + (size_t)pI * 16 + c) = pk2(kr * br0 - ki * bi0, kr * br1 - ki * bi1);
      *(GAS unsigned*)(bbp + (size_t)(64 + pI) * 16 + c) = pk2(kr * bi0 + ki * br0, kr * bi1 + ki * br1);
    }
    bf16_t* cmp = (bf16_t*)(ws + OFF_CM) + (size_t)ldg * 2048;
    for (int c = 0; c < 16; ++c) {
      const float cr = gldf(p.in[18] + ((size_t)ldg * 16 + c) * 64 + pI), ci = gldf(p.in[19] + ((size_t)ldg * 16 + c) * 64 + pI);
      *(GAS unsigned*)(cmp + (size_t)c * 128 + 2 * pI) = pk2(cr, -ci);
    }
  }
  for (size_t i = gt; i < 32768; i += GT) {
    const int pos = (int)(i >> 5), j = (int)(i & 31);
    const float inv = powf(10000.0f, -(float)(j & 15) / 16.0f);
    const float ang = (float)(j < 16 ? (pos >> 6) : (pos & 63)) * inv;
    float* rp = (float*)(ws + OFF_ROPE) + i * 2; gstf(rp, cosf(ang)); gstf(rp + 1, sinf(ang));
  }
  if (gt < 4) {
    const int l = (int)gt; float s1 = 0.f, s2 = 0.f;
    for (int k = 0; k < 64; ++k) { s1 += gldf(p.in[22] + l * 64 + k) * gldf(p.in[23] + l * 64 + k); s2 += gldf(p.in[24] + l * 64 + k) * gldf(p.in[25] + l * 64 + k); }
    const float lam_init = 0.8f - 0.6f * expf(-0.3f * (float)l);
    gstf((float*)(ws + OFF_LAM) + l, expf(s1) - expf(s2) + lam_init);
  }
}

DI void norm_phase(const Ctx& p, int layer, int sub, bool first, bool final_) {
  const int tid = opaque_tid(), lane = tid & 63, wave = tid >> 6;
  float* X = (float*)(p.ws + OFF_X); bf16_t* Nb = (bf16_t*)(p.ws + OFF_N);
  const int gw = blockIdx.x * 8 + wave, NGW = gridDim.x * 8;
  for (int row = gw; row < T_ALL; row += NGW) {
    const float* src = first ? (row < T_CTX ? p.in[0] + (size_t)row * DM : p.in[1] + (size_t)(row - T_CTX) * DM) : X + (size_t)row * DM;
    f32x4 v[4]; float ss = 0.f;
#pragma unroll
    for (int j = 0; j < 4; ++j) { v[j] = ((const GAS f32x4*)src)[lane + 64 * j]; ss += (v[j][0] * v[j][0] + v[j][1] * v[j][1]) + (v[j][2] * v[j][2] + v[j][3] * v[j][3]); }
    const float rstd = 1.0f / sqrtf(wave_sum(ss) * (1.f / DM) + 1e-6f);
    if (final_) {
      const float* g = p.in[31];
#pragma unroll
      for (int j = 0; j < 4; ++j) { const f32x4 gv = ((const GAS f32x4*)g)[lane + 64 * j]; ((GAS f32x4*)(p.out + (size_t)row * DM))[lane + 64 * j] = v[j] * rstd * gv; }
    } else {
      const int mrow = row < T_CTX ? 8 : ((row - T_CTX) >> 10);
      const float* md = (const float*)(p.ws + OFF_MOD) + ((size_t)layer * 9 + mrow) * 9216;
      const float* sh = md + (3 * sub) * 1024; const float* sc = md + (3 * sub + 1) * 1024; const float* g = p.in[7] + (size_t)(layer * 3 + sub) * DM;
#pragma unroll
      for (int j = 0; j < 4; ++j) {
        const f32x4 gv = ((const GAS f32x4*)g)[lane + 64 * j], sv = ((const GAS f32x4*)sc)[lane + 64 * j], hv = ((const GAS f32x4*)sh)[lane + 64 * j];
        const f32x4 y = v[j] * rstd * gv * (sv + 1.f) + hv;
        st_bf4(Nb + (size_t)row * DM + (lane + 64 * j) * 4, y);
        if (first) ((GAS f32x4*)(X + (size_t)row * DM))[lane + 64 * j] = v[j];
      }
    }
  }
}

DI s16x4 tr_read(unsigned lds_addr) { s16x4 r; asm volatile("ds_read_b64_tr_b16 %0, %1\n\ts_waitcnt lgkmcnt(0)" : "=&v"(r) : "v"(lds_addr) : "memory"); return r; }
#define MFMA32(a, b, c) __builtin_amdgcn_mfma_f32_32x32x16_bf16((a), (b), (c), 0, 0, 0)
#define MFMA16(a, b, c) __builtin_amdgcn_mfma_f32_16x16x32_bf16((a), (b), (c), 0, 0, 0)

DI void attn_item(const Ctx& p, int layer, bool lat, int seq, int head, int qblk, LAS unsigned char* lds) {
  const int tid = opaque_tid(), lane = tid & 63, wave = tid >> 6, r16 = lane & 15, g4 = lane >> 4;
  unsigned char* ws = p.ws;
  const bf16_t* Qg = (const bf16_t*)(ws + OFF_Q); const bf16_t* Kg = (const bf16_t*)(ws + OFF_K); const bf16_t* Vg = (const bf16_t*)(ws + OFF_V);
  const int tok0 = lat ? T_CTX + seq * 1024 : seq * 256;
  const int n_own = lat ? 16 : 4, n_tiles = lat ? 24 : 4;
  const bf16_t* Kc = (const bf16_t*)(ws + OFF_KC) + (size_t)(seq * 4 + layer) * 512 * 512;
  const bf16_t* Vc = (const bf16_t*)(ws + OFF_VC) + (size_t)(seq * 4 + layer) * 512 * 512;
  constexpr int RS = 272;
  LAS unsigned char* Kt = lds; LAS unsigned char* Vt = lds + 64 * RS;
  const int qtok = tok0 + qblk * 128 + wave * 16 + r16;
  bf16x8 Qf[2][2];
#pragma unroll
  for (int m = 0; m < 2; ++m)
#pragma unroll
    for (int kk = 0; kk < 2; ++kk) Qf[m][kk] = *(const GAS bf16x8*)(Qg + (size_t)qtok * 512 + head * 128 + m * 64 + g4 * 8 + 32 * kk);
  u32x4 kreg[2], vreg[2];
  auto issue = [&](int kt) {
    const bf16_t* kb; const bf16_t* vb;
    if (kt < n_own) { kb = Kg + (size_t)(tok0 + kt * 64) * 512 + head * 128; vb = Vg + (size_t)(tok0 + kt * 64) * 512 + head * 128; }
    else { kb = Kc + (size_t)((kt - n_own) * 64) * 512 + head * 128; vb = Vc + (size_t)((kt - n_own) * 64) * 512 + head * 128; }
#pragma unroll
    for (int i = 0; i < 2; ++i) { const int ci = tid + 512 * i, row = ci >> 4, part = ci & 15; kreg[i] = *(const GAS u32x4*)(kb + (size_t)row * 512 + part * 8); vreg[i] = *(const GAS u32x4*)(vb + (size_t)row * 512 + part * 8); }
  };
  issue(0);
  f32x4 O[2][8];
#pragma unroll
  for (int m = 0; m < 2; ++m)
#pragma unroll
    for (int d = 0; d < 8; ++d) O[m][d] = (f32x4){0.f, 0.f, 0.f, 0.f};
  float mrun[2] = {-1e30f, -1e30f}, lsum[2] = {0.f, 0.f};
  const unsigned vbase = (unsigned)(size_t)Vt;
  const int tq = r16 >> 2, tp = r16 & 3;
  for (int kt = 0; kt < n_tiles; ++kt) {
    __syncthreads();
#pragma unroll
    for (int i = 0; i < 2; ++i) { const int ci = tid + 512 * i, row = ci >> 4, part = ci & 15; *(LAS u32x4*)(Kt + row * RS + part * 16) = kreg[i]; *(LAS u32x4*)(Vt + row * RS + part * 16) = vreg[i]; }
    __syncthreads();
    if (kt + 1 < n_tiles) issue(kt + 1);
    bf16x8 P[2][2];
#pragma unroll
    for (int m = 0; m < 2; ++m) {
      f32x4 S[4];
#pragma unroll
      for (int kb = 0; kb < 4; ++kb) {
        S[kb] = (f32x4){0.f, 0.f, 0.f, 0.f};
#pragma unroll
        for (int kk = 0; kk < 2; ++kk) { const bf16x8 Kf = *(const LAS bf16x8*)(Kt + (16 * kb + r16) * RS + m * 128 + (g4 * 8 + 32 * kk) * 2); S[kb] = MFMA16(Kf, Qf[m][kk], S[kb]); }
      }
      float mx = S[0][0];
#pragma unroll
      for (int kb = 0; kb < 4; ++kb)
#pragma unroll
        for (int j = 0; j < 4; ++j) mx = fmaxf(mx, S[kb][j]);
      mx = fmaxf(mx, __shfl_xor(mx, 16)); mx = fmaxf(mx, __shfl_xor(mx, 32));
      const float mnew = fmaxf(mrun[m], mx), alpha = __builtin_amdgcn_exp2f(mrun[m] - mnew);
      mrun[m] = mnew;
      float ps = 0.f;
#pragma unroll
      for (int kb = 0; kb < 4; ++kb)
#pragma unroll
        for (int j = 0; j < 4; ++j) { S[kb][j] = __builtin_amdgcn_exp2f(S[kb][j] - mnew); ps += S[kb][j]; }
      lsum[m] = lsum[m] * alpha + ps;
#pragma unroll
      for (int d = 0; d < 8; ++d) O[m][d] *= alpha;
#pragma unroll
      for (int s = 0; s < 2; ++s) {
        u32x4 w; w.x = pk2(S[2 * s][0], S[2 * s][1]); w.y = pk2(S[2 * s][2], S[2 * s][3]); w.z = pk2(S[2 * s + 1][0], S[2 * s + 1][1]); w.w = pk2(S[2 * s + 1][2], S[2 * s + 1][3]);
        P[m][s] = __builtin_bit_cast(bf16x8, w);
      }
    }
#pragma unroll
    for (int s = 0; s < 2; ++s) {
      s16x4 v0, v1, v2, v3, v4, v5, v6, v7, v8, v9, v10, v11, v12, v13, v14, v15;
      const unsigned a0 = vbase + (32 * s + 4 * g4 + tq) * RS + 8 * tp;
      asm volatile(
        "ds_read_b64_tr_b16 %0, %16\n\tds_read_b64_tr_b16 %1, %16 offset:4352\n\t"
        "ds_read_b64_tr_b16 %2, %16 offset:32\n\tds_read_b64_tr_b16 %3, %16 offset:4384\n\t"
        "ds_read_b64_tr_b16 %4, %16 offset:64\n\tds_read_b64_tr_b16 %5, %16 offset:4416\n\t"
        "ds_read_b64_tr_b16 %6, %16 offset:96\n\tds_read_b64_tr_b16 %7, %16 offset:4448\n\t"
        "ds_read_b64_tr_b16 %8, %16 offset:128\n\tds_read_b64_tr_b16 %9, %16 offset:4480\n\t"
        "ds_read_b64_tr_b16 %10, %16 offset:160\n\tds_read_b64_tr_b16 %11, %16 offset:4512\n\t"
        "ds_read_b64_tr_b16 %12, %16 offset:192\n\tds_read_b64_tr_b16 %13, %16 offset:4544\n\t"
        "ds_read_b64_tr_b16 %14, %16 offset:224\n\tds_read_b64_tr_b16 %15, %16 offset:4576\n\t"
        "s_waitcnt lgkmcnt(0)"
        : "=&v"(v0), "=&v"(v1), "=&v"(v2), "=&v"(v3), "=&v"(v4), "=&v"(v5), "=&v"(v6), "=&v"(v7),
          "=&v"(v8), "=&v"(v9), "=&v"(v10), "=&v"(v11), "=&v"(v12), "=&v"(v13), "=&v"(v14), "=&v"(v15)
        : "v"(a0) : "memory");
#define ATT_PV(d, lo, hi) { const bf16x8 Vf = __builtin_shufflevector(lo, hi, 0, 1, 2, 3, 4, 5, 6, 7); O[0][d] = MFMA16(Vf, P[0][s], O[0][d]); O[1][d] = MFMA16(Vf, P[1][s], O[1][d]); }
      ATT_PV(0, v0, v1) ATT_PV(1, v2, v3) ATT_PV(2, v4, v5) ATT_PV(3, v6, v7) ATT_PV(4, v8, v9) ATT_PV(5, v10, v11) ATT_PV(6, v12, v13) ATT_PV(7, v14, v15)
#undef ATT_PV
    }
  }
  float l1 = lsum[0], l2 = lsum[1];
  l1 += __shfl_xor(l1, 16); l1 += __shfl_xor(l1, 32); l2 += __shfl_xor(l2, 16); l2 += __shfl_xor(l2, 32);
  const float lam = gldf((const float*)(ws + OFF_LAM) + layer);
  const float lam_init = 0.8f - 0.6f * expf(-0.3f * (float)layer);
  const float c1 = 1.f / l1, c2 = lam / l2;
  float ss = 0.f;
#pragma unroll
  for (int d = 0; d < 8; ++d) { const f32x4 o = O[0][d] * c1 - O[1][d] * c2; O[0][d] = o; ss += (o[0] * o[0] + o[1] * o[1]) + (o[2] * o[2] + o[3] * o[3]); }
  ss += __shfl_xor(ss, 16); ss += __shfl_xor(ss, 32);
  const float rn = (1.f - lam_init) / sqrtf(ss * (1.f / 128.f) + 1e-6f);
  const float* ag = p.in[26] + layer * 128;
  bf16_t* yb = (bf16_t*)(ws + OFF_YS) + (size_t)T_ALL * 512 + (size_t)qtok * 512 + head * 128;
#pragma unroll
  for (int d = 0; d < 8; ++d) {
    const int dv = 16 * d + 4 * g4;
    const f32x4 gv = *(const GAS f32x4*)(ag + dv);
    st_bf4(yb + dv, O[0][d] * rn * gv);
  }
}

DI void s5_item(const Ctx& p, int layer, int pairIdx, int gq, int ngrp, LAS unsigned char* lds) {
  const int tid = opaque_tid(), lane = tid & 63, wave = __builtin_amdgcn_readfirstlane(tid >> 6), r32 = lane & 31, h = lane >> 5;
  unsigned char* ws = p.ws;
  if (wave >= 2 * ngrp) { __syncthreads(); __syncthreads(); return; }
  const int g = gq * ngrp + (wave >> 1), d = wave & 1;
  const bool lat = pairIdx < 4;
  const int L = lat ? 1024 : 256, nt = L / 16;
  const int seq0 = (lat ? pairIdx : pairIdx - 4) * 2;
  const int tb0 = lat ? T_CTX + seq0 * 1024 : seq0 * 256;
  const int ldg = (layer * 2 + d) * 32 + g;
  const float* at = (const float*)(ws + OFF_AT) + (size_t)ldg * 128;
  const float a0r = gldf(at + r32 * 2), a0i = gldf(at + r32 * 2 + 1), a1r = gldf(at + (r32 + 32) * 2), a1i = gldf(at + (r32 + 32) * 2 + 1);
  float h0r = 0.f, h0i = 0.f, h1r = 0.f, h1i = 0.f;
  if (lat) {
    const float* st = p.in[4] + ((size_t)(((seq0 + h) * 4 + layer) * 2 + d) * 2) * 2048 + g * 64;
    h0r = gldf(st + r32); h1r = gldf(st + r32 + 32); h0i = gldf(st + 2048 + r32); h1i = gldf(st + 2048 + r32 + 32);
  }
  bf16x8 BBf[4], Cmf[4];
  {
    const bf16_t* bb = (const bf16_t*)(ws + OFF_BB) + (size_t)ldg * 2048;
    const bf16_t* cm = (const bf16_t*)(ws + OFF_CM) + (size_t)ldg * 2048;
#pragma unroll
    for (int b = 0; b < 4; ++b) { BBf[b] = *(const GAS bf16x8*)(bb + (size_t)(b * 32 + r32) * 16 + h * 8); Cmf[b] = *(const GAS bf16x8*)(cm + (size_t)(lane & 15) * 128 + (lane >> 4) * 8 + 32 * b); }
  }
  const bf16_t* U = (const bf16_t*)(ws + OFF_UH);
  float* YP = (float*)(ws + OFF_YP);
  bf16_t* YA = (bf16_t*)(ws + OFF_YA);
  const int sA = (r32 >> 2) & 1, iA = 4 * (r32 >> 3) + (r32 & 3);
  const bf16_t* uA = U + (size_t)(tb0 + sA * L + iA) * INW + g * 16 + h * 8;
  constexpr int RS = 272;
  LAS unsigned char* hb = lds + wave * (32 * RS);
  const f32x4 dsk = *(const GAS f32x4*)(p.in[20] + layer * 512 + g * 16 + (lane >> 4) * 4);
  __syncthreads();
  bf16x8 Af = *(const GAS bf16x8*)(uA + (size_t)(d ? nt - 1 : 0) * 16 * INW);
  for (int n = 0; n < nt; ++n) {
    if (n == nt / 2) __syncthreads();
    const int tile = d ? nt - 1 - n : n;
    const int tilen = (n + 1 < nt) ? (d ? tile - 1 : tile + 1) : tile;
    const bf16x8 Afn = *(const GAS bf16x8*)(uA + (size_t)tilen * 16 * INW);
    const bool second = n >= nt / 2;
    f32x4 po[2] = {{0.f, 0.f, 0.f, 0.f}, {0.f, 0.f, 0.f, 0.f}}; u32x2 pu[2] = {{0u, 0u}, {0u, 0u}};
    if (second) {
#pragma unroll
      for (int ss = 0; ss < 2; ++ss) {
        const int tok = tb0 + ss * L + tile * 16 + (lane & 15), ch = g * 16 + (lane >> 4) * 4;
        po[ss] = *(const GAS f32x4*)(YP + ((size_t)(1 - d) * T_ALL + tok) * 512 + ch);
        pu[ss] = *(const GAS u32x2*)(U + (size_t)tok * INW + ch);
      }
    }
    f32x16 x0, x1, x2, x3;
#pragma unroll
    for (int i = 0; i < 16; ++i) { x0[i] = 0.f; x1[i] = 0.f; x2[i] = 0.f; x3[i] = 0.f; }
    x0 = MFMA32(Af, BBf[0], x0); x1 = MFMA32(Af, BBf[1], x1); x2 = MFMA32(Af, BBf[2], x2); x3 = MFMA32(Af, BBf[3], x3);
#define S5_STEP(i) { const float nr0 = a0r * h0r - a0i * h0i + x0[i], ni0 = a0r * h0i + a0i * h0r + x2[i]; h0r = nr0; h0i = ni0; \
                     const float nr1 = a1r * h1r - a1i * h1i + x1[i], ni1 = a1r * h1i + a1i * h1r + x3[i]; h1r = nr1; h1i = ni1; \
                     *(LAS unsigned*)(hb + (h * 16 + (i)) * RS + r32 * 4) = pk2(h0r, h0i); *(LAS unsigned*)(hb + (h * 16 + (i)) * RS + (r32 + 32) * 4) = pk2(h1r, h1i); }
    if (d == 0) {
#pragma unroll
      for (int i = 0; i < 16; ++i) S5_STEP(i)
    } else {
#pragma unroll
      for (int i = 15; i >= 0; --i) S5_STEP(i)
    }
#undef S5_STEP
    LDS_WAIT();
#pragma unroll
    for (int ss = 0; ss < 2; ++ss) {
      f32x4 y = {0.f, 0.f, 0.f, 0.f};
#pragma unroll
      for (int kb = 0; kb < 4; ++kb) { const bf16x8 Hf = *(const LAS bf16x8*)(hb + (ss * 16 + (lane & 15)) * RS + ((lane >> 4) * 8 + 32 * kb) * 2); y = MFMA16(Cmf[kb], Hf, y); }
      const int tok = tb0 + ss * L + tile * 16 + (lane & 15), ch = g * 16 + (lane >> 4) * 4;
      if (!second) {
        *(GAS f32x4*)(YP + ((size_t)d * T_ALL + tok) * 512 + ch) = y;
      } else {
        const f32x4 uu = {bflo(pu[ss].x), bfhi(pu[ss].x), bflo(pu[ss].y), bfhi(pu[ss].y)};
        f32x4 v = y + po[ss] + uu * dsk, r;
#pragma unroll
        for (int j = 0; j < 4; ++j) { const float t = v[j]; r[j] = t * sigmoidf_(1.5957691216057308f * (t + 0.044715f * t * t * t)); }
        st_bf4(YA + (size_t)tok * 512 + ch, r);
      }
    }
    LDS_WAIT();
    Af = Afn;
  }
  if (!lat) {
    float* so = p.out + 12582912 + 8388608 + 8388608 + ((size_t)(((seq0 + h) * 4 + layer) * 2 + d) * 2) * 2048 + g * 64;
    gstf(so + r32, h0r); gstf(so + r32 + 32, h1r); gstf(so + 2048 + r32, h0i); gstf(so + 2048 + r32 + 32, h1i);
  }
}

template <int W>
DI void pool_body(const Ctx& p, int layer, int g, int t0, int lane) {
  const int r32 = lane & 31, h = lane >> 5;
  unsigned char* ws = p.ws;
  const int t = t0 + r32;
  const int sbase = t < T_CTX ? (t & ~255) : T_CTX + ((t - T_CTX) & ~1023), L = t < T_CTX ? 256 : 1024, tl = t - sbase;
  int lo = tl - W / 2, hi = lo + W; lo = lo < 0 ? 0 : lo; hi = hi > L ? L : hi;
  const float inv = 1.f / (float)(hi - lo);
  const bf16_t* Z = (const bf16_t*)(ws + OFF_UH) + 2048 + g * 128 + h * 8;
  bf16x8 Af[8];
#pragma unroll
  for (int kk = 0; kk < 8; ++kk) {
    u32x4 zz[W]; float ff[W];
#pragma unroll
    for (int dt = 0; dt < W; ++dt) {
      const int tp = tl - W / 2 + dt; const bool ok = tp >= 0 && tp < L; const int tc = ok ? tp : tl; ff[dt] = ok ? 1.f : 0.f;
      zz[dt] = *(const GAS u32x4*)(Z + (size_t)(sbase + tc) * INW + 16 * kk);
    }
    float s[8];
#pragma unroll
    for (int j = 0; j < 8; ++j) s[j] = 0.f;
#pragma unroll
    for (int dt = 0; dt < W; ++dt) {
      const u32x4 z = zz[dt]; const float f = ff[dt];
      s[0] += f * bflo(z.x); s[1] += f * bfhi(z.x); s[2] += f * bflo(z.y); s[3] += f * bfhi(z.y); s[4] += f * bflo(z.z); s[5] += f * bfhi(z.z); s[6] += f * bflo(z.w); s[7] += f * bfhi(z.w);
    }
    const u32x4 z = zz[W / 2];
    u32x4 o;
    o.x = pk2(s[0] * inv - bflo(z.x), s[1] * inv - bfhi(z.x)); o.y = pk2(s[2] * inv - bflo(z.y), s[3] * inv - bfhi(z.y));
    o.z = pk2(s[4] * inv - bflo(z.z), s[5] * inv - bfhi(z.z)); o.w = pk2(s[6] * inv - bflo(z.w), s[7] * inv - bfhi(z.w));
    Af[kk] = __builtin_bit_cast(bf16x8, o);
  }
  const bf16_t* Wp = (const bf16_t*)(ws + OFF_W) + (size_t)layer * W_LAYER + W_P + (size_t)g * 16384;
  bf16_t* yc = (bf16_t*)(ws + OFF_YS) + (size_t)2 * T_ALL * 512;
#pragma unroll
  for (int nb = 0; nb < 4; ++nb) {
    f32x16 acc;
#pragma unroll
    for (int i = 0; i < 16; ++i) acc[i] = 0.f;
#pragma unroll
    for (int kk = 0; kk < 8; ++kk) { const bf16x8 Bf = *(const GAS bf16x8*)(Wp + (size_t)(nb * 32 + r32) * 128 + h * 8 + 16 * kk); acc = MFMA32(Af[kk], Bf, acc); }
    const int dcol = g * 128 + nb * 32 + r32;
    const float sc = gldf(p.in[28] + layer * 512 + dcol);
#pragma unroll
    for (int i = 0; i < 16; ++i) { const int row = 8 * (i >> 2) + 4 * h + (i & 3); *(GAS bf16_t*)(yc + (size_t)(t0 + row) * 512 + dcol) = (bf16_t)(pk2(acc[i] * sc, 0.f) & 0xffffu); }
  }
}
DI void pool_item(const Ctx& p, int layer, int item) {
  const int tid = opaque_tid(), lane = tid & 63, wave = __builtin_amdgcn_readfirstlane(tid >> 6);
  const int wi = item * 8 + wave, tt = wi >> 2, g = wi & 3, t0 = tt * 32;
  if (g == 0) pool_body<2>(p, layer, 0, t0, lane);
  else if (g == 1) pool_body<4>(p, layer, 1, t0, lane);
  else if (g == 2) pool_body<8>(p, layer, 2, t0, lane);
  else pool_body<16>(p, layer, 3, t0, lane);
}

DI void mixer_item(const Ctx& p, int layer, int it, LAS unsigned char* lds) {
  if (it < 64) s5_item(p, layer, it >> 4, it & 15, 2, lds);
  else if (it < 320) { const int j = it - 64; attn_item(p, layer, true, j >> 5, (j >> 3) & 3, j & 7, lds); }
  else if (it < 384) { const int j = it - 320; s5_item(p, layer, 4 + (j >> 3), j & 7, 4, lds); }
  else if (it < 512) { const int j = it - 384; attn_item(p, layer, false, j >> 3, (j >> 1) & 3, j & 1, lds); }
  else pool_item(p, layer, it - 512);
}
DI void mixer_phase(const Ctx& p, int layer, LAS unsigned char* lds) {
  constexpr int NIT = 512 + 192;
  const int Gd = gridDim.x, w = blockIdx.x;
  for (int r = 0;; ++r) {
    const int it = r * Gd + ((r & 1) ? Gd - 1 - w : w);
    if (r * Gd >= NIT) break;
    if (it < NIT) mixer_item(p, layer, it, lds);
  }
}

#define XB_TMO      128
#define XB_XCNT(j)  (256  + 64 * (j))
#define XB_XSUB(j)  (1280 + 64 * (j))
#define XB_XGEN(j)  (2304 + 64 * (j))
#define XB_TOP      3328
#define XB_TOPGEN   3392
#define XCD_BAR_WORDS 3456
#define XB_SPIN_CAP (1u << 22)
DI unsigned xb_ld(unsigned* p)              { return __hip_atomic_load(p, __ATOMIC_RELAXED, __HIP_MEMORY_SCOPE_AGENT); }
DI unsigned xb_add(unsigned* p, unsigned v) { return __hip_atomic_fetch_add(p, v, __ATOMIC_RELAXED, __HIP_MEMORY_SCOPE_AGENT); }
DI unsigned xb_xcc_id() { return (unsigned)__builtin_amdgcn_s_getreg((3 << 11) | 20) & 0xFu; }
#define XB_SPIN(cond, bar) do { unsigned _sp = 0; while (cond) { __builtin_amdgcn_s_sleep(1); \
    if ((++_sp & 255u) == 0u) { if (xb_ld(&(bar)[XB_TMO])) break; if (_sp > XB_SPIN_CAP) { atomicAdd(&(bar)[XB_TMO], 1u); break; } } } } while (0)
struct XcdBarrier { unsigned* bar; unsigned x; volatile LAS unsigned* st; };
DI XcdBarrier xcd_barrier_post(unsigned* bar, volatile LAS unsigned* st) {
  XcdBarrier b; b.bar = bar; b.x = xb_xcc_id(); b.st = st;
  if (threadIdx.x == 0) (void)xb_add(&bar[XB_XCNT(b.x)], 1u);
  return b;
}
DI void xcd_barrier_complete(unsigned* bar, unsigned x, unsigned& nloc, unsigned& nx) {
  const unsigned G = gridDim.x * gridDim.y * gridDim.z;
  unsigned sum, cnt, mine, sp = 0u;
  for (;;) {
    sum = 0u; cnt = 0u; mine = 0u;
#pragma unroll
    for (unsigned j = 0; j < 16; ++j) { const unsigned c = xb_ld(&bar[XB_XCNT(j)]); sum += c; cnt += (c > 0u) ? 1u : 0u; mine = (j == x) ? c : mine; }
    if (sum == G) break;
    __builtin_amdgcn_s_sleep(1);
    if ((++sp & 255u) == 0u) { if (xb_ld(&bar[XB_TMO])) break; if (sp > XB_SPIN_CAP) { atomicAdd(&bar[XB_TMO], 1u); break; } }
  }
  nloc = mine > 0u ? mine : 1u; nx = cnt > 0u ? cnt : 1u;
}
DI void xcd_barrier(const XcdBarrier& b) {
  asm volatile("s_waitcnt vmcnt(0)" ::: "memory");
  __syncthreads();
  if (threadIdx.x == 0) {
    unsigned* bar = b.bar;
    __builtin_amdgcn_s_waitcnt(0);
    unsigned nloc = b.st[0], nx = b.st[1];
    if (nloc == 0u) { xcd_barrier_complete(bar, b.x, nloc, nx); b.st[0] = nloc; b.st[1] = nx; }
    const unsigned old = xb_add(&bar[XB_XSUB(b.x)], 1u);
    const unsigned gen = old / nloc;
    if (old + 1u == (gen + 1u) * nloc) {
      __builtin_amdgcn_fence(__ATOMIC_RELEASE, "agent");
      asm volatile("s_waitcnt vmcnt(0)" ::: "memory");
      const unsigned og = xb_add(&bar[XB_TOP], 1u);
      const unsigned tg = og / nx;
      if (og + 1u == (tg + 1u) * nx) xb_add(&bar[XB_TOPGEN], 1u);
      else XB_SPIN(xb_ld(&bar[XB_TOPGEN]) == tg, bar);
      __builtin_amdgcn_fence(__ATOMIC_ACQUIRE, "agent");
      xb_add(&bar[XB_XGEN(b.x)], 1u);
      asm volatile("s_waitcnt vmcnt(0)" ::: "memory");
    } else {
      XB_SPIN(xb_ld(&bar[XB_XGEN(b.x)]) == gen, bar);
      __builtin_amdgcn_fence(__ATOMIC_ACQUIRE, "agent");
      asm volatile("s_waitcnt vmcnt(0)" ::: "memory");
    }
  }
  __syncthreads();
}

__global__ void __launch_bounds__(512, 2) fwd_megakernel(Params p0) {
  extern __shared__ __attribute__((aligned(16))) unsigned char shm[];
  LAS unsigned char* lds = (LAS unsigned char*)shm;
  const int G = gridDim.x, c = blockIdx.x;
  __shared__ uint4 xb_words;
  if (threadIdx.x == 0) xb_words = make_uint4(0u, 0u, 0u, 0u);
  __syncthreads();
  const XcdBarrier xb = xcd_barrier_post((unsigned*)(p0.ws + OFF_BAR), (volatile LAS unsigned*)&xb_words);
  for (int phi = p0.ph_lo; phi < p0.ph_hi; ++phi) {
    int ph = phi; asm volatile("" : "+s"(ph));
    Ctx p; p.in.pp = &p0; p.out = p0.out; p.ws = p0.ws;
    asm volatile("" : "+s"(p.out)); asm volatile("" : "+s"(p.ws));
    unsigned char* ws = p.ws;
    if (ph == 0) prep_phase(p, lds);
    else if (ph == NPH - 1) norm_phase(p, 0, 0, false, true);
    else {
      const int layer = (ph - 1) / 12, s = (ph - 1) % 12;
      const bf16_t* wl = (const bf16_t*)(ws + OFF_W) + (size_t)layer * W_LAYER;
      const float* modl = (const float*)(ws + OFF_MOD) + (size_t)layer * 9 * 9216;
      bf16_t* Nb = (bf16_t*)(ws + OFF_N); bf16_t* UH = (bf16_t*)(ws + OFF_UH); float* X = (float*)(ws + OFF_X);
      if (s == 0) norm_phase(p, layer, 0, layer == 0, false);
      else if (s == 3) norm_phase(p, layer, 1, false, false);
      else if (s == 9) norm_phase(p, layer, 2, false, false);
      else if (s == 1 || s == 10) {
        const int f = s == 10;
        pg8::Gemm g{Nb, wl + W_FI + (size_t)f * 5632 * 1024, T_ALL, 5632, 1024};
        pg8::StaticOrder S; S.init(g.M, g.N, G, c);
        EpiSwiglu E{UH};
        pg8::gemm_phase(lds, g, S, E);
      } else if (s == 2 || s == 11) {
        const int f = s == 11;
        pg8::Gemm g{UH, wl + W_FO + (size_t)f * 1024 * 2816, T_ALL, 1024, 2816};
        pg8::StaticOrder S; S.init(g.M, g.N, G, c);
        EpiResid E{X, modl, f ? 8 : 2, 0.5f};
        pg8::gemm_phase(lds, g, S, E);
      } else if (s == 4) {
        pg8::Gemm g{Nb, wl + W_IN, T_ALL, 5632, 1024};
        pg8::StaticOrder S; S.init(g.M, g.N, G, c);
        EpiWin E{UH, (bf16_t*)(ws + OFF_Q), (bf16_t*)(ws + OFF_K), (bf16_t*)(ws + OFF_V), p.out + 12582912, p.out + 12582912 + 8388608, (const float*)(ws + OFF_ROPE), layer};
        pg8::gemm_phase(lds, g, S, E);
      } else if (s == 5) {
        mixer_phase(p, layer, lds);
      } else if (s == 6) {
        pg8::Gemm g{(const bf16_t*)(ws + OFF_YA), wl + W_GLU, T_ALL, 512, 512};
        pg8::StaticOrder S; S.init(g.M, g.N, G, c);
        EpiGlu E{(const bf16_t*)(ws + OFF_YA), (bf16_t*)(ws + OFF_YS)};
        pg8::gemm_phase(lds, g, S, E);
      } else if (s == 7) {
        pg8::Gemm g{(const bf16_t*)(ws + OFF_YS), wl + W_BR, 3 * T_ALL, 3072, 512};
        pg8::BranchOrder S{G, c};
        EpiBranch E{UH, (float*)(ws + OFF_YP), Nb};
        pg8::gemm_phase(lds, g, S, E);
      } else if (s == 8) {
        pg8::Gemm g{Nb, wl + W_OUT, T_ALL, 1024, 1024};
        pg8::StaticOrder S; S.init(g.M, g.N, G, c);
        EpiResid E{X, modl, 5, 1.0f};
        pg8::gemm_phase(lds, g, S, E);
      }
    }
    if (phi + 1 < p0.ph_hi) { if (phi == p0.ph_lo) cg::this_grid().sync(); else xcd_barrier(xb); }
  }
}

extern "C" void kernel_launch(void* const* d_in, const int* in_sizes, int n_in, void* d_out, int out_size, void* d_ws, size_t ws_size, hipStream_t stream) {
  static int grid = 0;
  if (grid == 0) {
    int dev = 0, cus = 0, per_cu = 0;
    hipGetDevice(&dev);
    hipDeviceGetAttribute(&cus, hipDeviceAttributeMultiprocessorCount, dev);
    if (hipFuncSetAttribute((const void*)fwd_megakernel, hipFuncAttributeMaxDynamicSharedMemorySize, LDS_BYTES) != hipSuccess) fprintf(stderr, "hipFuncSetAttribute failed\n");
    hipOccupancyMaxActiveBlocksPerMultiprocessor(&per_cu, (const void*)fwd_megakernel, 512, LDS_BYTES);
    if (per_cu < 1) { fprintf(stderr, "occupancy query gave %d\n", per_cu); per_cu = 1; }
    (void)hipGetLastError();
    grid = cus * per_cu;
    if (ws_size < WS_END) fprintf(stderr, "workspace too small: %zu\n", ws_size);
  }
  if (hipMemsetAsync((unsigned char*)d_ws + OFF_BAR, 0, 16384, stream) != hipSuccess) fprintf(stderr, "memset failed\n");
  Params p{};
  for (int i = 0; i < 32; ++i) p.in[i] = (const float*)d_in[i];
  p.out = (float*)d_out; p.ws = (unsigned char*)d_ws;
#if COOP
  p.ph_lo = 0; p.ph_hi = NPH;
  void* args[] = {&p};
  hipError_t e = hipLaunchCooperativeKernel((const void*)fwd_megakernel, dim3(grid), dim3(512), args, LDS_BYTES, stream);
  if (e != hipSuccess) fprintf(stderr, "cooperative launch failed: %s (grid %d)\n", hipGetErrorString(e), grid);
#else
  for (int ph = 0; ph < NPH; ++ph) {
    p.ph_lo = ph; p.ph_hi = ph + 1;
    hipLaunchKernelGGL(fwd_megakernel, dim3(grid), dim3(512), LDS_BYTES, stream, p);
  }
#endif
}
```

```cpp
#include <hip/hip_runtime.h>
#include <hip/hip_cooperative_groups.h>
#include <cstdio>
namespace cg = cooperative_groups;

#ifndef COOP
#define COOP 1
#endif

#define LAS __attribute__((address_space(3)))
#define GAS __attribute__((address_space(1)))
typedef unsigned short bf16_t;
typedef short bf16x8 __attribute__((ext_vector_type(8)));
typedef short s16x4 __attribute__((ext_vector_type(4)));
typedef float f32x2 __attribute__((ext_vector_type(2)));
typedef float f32x4 __attribute__((ext_vector_type(4)));
typedef float f32x16 __attribute__((ext_vector_type(16)));
typedef unsigned u32x4 __attribute__((ext_vector_type(4)));
typedef unsigned u32x2 __attribute__((ext_vector_type(2)));
typedef __bf16 nbf16x2 __attribute__((ext_vector_type(2)));
#define DI __device__ __forceinline__

constexpr int T_CTX = 4096, T_ALL = 12288, DM = 1024, DFF = 2816, INW = 5632, NPH = 50;
constexpr size_t OFF_X = 0;
constexpr size_t OFF_N = OFF_X + 50331648;
constexpr size_t OFF_UH = OFF_N + 25165824;
constexpr size_t OFF_Q = OFF_UH + 138412032;
constexpr size_t OFF_K = OFF_Q + 12582912;
constexpr size_t OFF_V = OFF_K + 12582912;
constexpr size_t OFF_KC = OFF_V + 12582912;
constexpr size_t OFF_VC = OFF_KC + 16777216;
constexpr size_t OFF_YP = OFF_VC + 16777216;
constexpr size_t OFF_YA = OFF_YP + 50331648;
constexpr size_t OFF_YS = OFF_YA + 12582912;
constexpr size_t OFF_MOD = OFF_YS + 37748736;
constexpr size_t OFF_BB = OFF_MOD + 1327104;
constexpr size_t OFF_CM = OFF_BB + 1048576;
constexpr size_t OFF_AT = OFF_CM + 1048576;
constexpr size_t OFF_ROPE = OFF_AT + 131072;
constexpr size_t OFF_LAM = OFF_ROPE + 262144;
constexpr size_t OFF_W = OFF_LAM + 256;
constexpr size_t W_FI = 0;
constexpr size_t W_FO = W_FI + 11534336;
constexpr size_t W_IN = W_FO + 5767168;
constexpr size_t W_GLU = W_IN + 5767168;
constexpr size_t W_BR = W_GLU + 262144;
constexpr size_t W_OUT = W_BR + 1572864;
constexpr size_t W_P = W_OUT + 1048576;
constexpr size_t W_LAYER = W_P + 65536;
constexpr size_t OFF_BAR = OFF_W + 4 * W_LAYER * 2;
constexpr size_t WS_END = OFF_BAR + 16384;
constexpr int LDS_BYTES = 131072;

struct Params {
  const float* in[32];
  float* out;
  unsigned char* ws;
  int ph_lo, ph_hi;
};
struct InTab { const Params* pp; __device__ __forceinline__ const float* operator[](int i) const { asm volatile("" : "+s"(i)); return pp->in[i]; } };
struct Ctx { InTab in; float* out; unsigned char* ws; };

DI int opaque_tid() { int t = threadIdx.x; asm volatile("" : "+v"(t)); return t; }
DI unsigned pk2(float lo, float hi) { f32x2 v = {lo, hi}; nbf16x2 b = __builtin_convertvector(v, nbf16x2); return __builtin_bit_cast(unsigned, b); }
DI float gldf(const float* p) { return *(const GAS float*)p; }
DI void gstf(float* p, float v) { *(GAS float*)p = v; }
DI float bf2f(unsigned short b) { return __uint_as_float(((unsigned)b) << 16); }
DI float bflo(unsigned u) { return __uint_as_float(u << 16); }
DI float bfhi(unsigned u) { return __uint_as_float(u & 0xffff0000u); }
DI float sigmoidf_(float x) { return __builtin_amdgcn_rcpf(1.f + __expf(-x)); }
DI float wave_sum(float v) {
#pragma unroll
  for (int o = 1; o < 64; o <<= 1) v += __shfl_xor(v, o);
  return v;
}
#define LDS_WAIT() asm volatile("s_waitcnt lgkmcnt(0)" ::: "memory")

namespace pg8 {
constexpr int BM = 256, BK = 64, HALF = 128, HTB = HALF * BK * 2, NXCD = 8, WGM = 8;
DI int lds_byte(int r, int c) { const int st = (r >> 4) * 2 + (c >> 5), rr = r & 15, cc = c & 31, ob = rr * 64 + cc * 2; return st * 1024 + (ob ^ (((ob >> 9) & 1) << 5)); }
DI void stage_rc(int b, int& R, int& C) { const int st = b / 1024, sb = b % 1024, swz = sb ^ (((sb >> 9) & 1) << 5); R = (st >> 1) * 16 + swz / 64; C = (st & 1) * 32 + (swz % 64) / 2; }
struct Unit { int pm, pn; };
struct Gemm { const bf16_t* A; const bf16_t* Bt; int M, N, K; };
struct StaticOrder {
  int nM, nN, nwg, G, c;
  DI void init(int M, int N, int G_, int c_) { nM = M / BM; nN = N / BM; nwg = nM * nN; G = G_; c = c_; }
  DI bool next(int i, Unit& u) const {
    const long L = (long)i * G + c; if (L >= nwg) return false;
    int wgid = (int)L; { const int q = nwg / NXCD, r = nwg % NXCD, xcd = wgid % NXCD, off = wgid / NXCD; wgid = (xcd < r ? xcd * (q + 1) : r * (q + 1) + (xcd - r) * q) + off; }
    const int nig = WGM * nN, gid = wgid / nig, fm = gid * WGM, gsz = (nM - fm) < WGM ? (nM - fm) : WGM;
    u.pm = fm + ((wgid % nig) % gsz); u.pn = (wgid % nig) / gsz; return true;
  }
};
struct BranchOrder {
  int G, c;
  DI bool next(int i, Unit& u) const { const int tile = (i / 3) * G + c; if (tile >= 192) return false; const int n = i % 3; u.pm = n * 48 + (tile >> 2); u.pn = n * 4 + (tile & 3); return true; }
};

template <class Epi, class Sched>
DI void gemm_phase(LAS unsigned char* lds, const Gemm g, const Sched& S, const Epi& E) {
  const int tid = opaque_tid(), wid = __builtin_amdgcn_readfirstlane(tid >> 6), lane = tid & 63, wr = wid >> 2, wc = wid & 3, fr = lane & 15, fq = lane >> 4;
  const int K = g.K, nt = K / BK;
  unsigned voffA[2], voffB[2];
#pragma unroll
  for (int i = 0; i < 2; ++i) { int R, C; stage_rc(tid * 16 + i * 8192, R, C); voffA[i] = (unsigned)(R * K + C) * 2u; voffB[i] = voffA[i]; }
  const size_t kstep = (size_t)(BK * 2);
  const size_t hstep = (size_t)HALF * K * 2;
  const size_t tstep = 2 * hstep;
  const unsigned ldsw = (unsigned)wid * 1024u;
  const int aoff = lds_byte(wr * 64 + fr, fq * 8), boff = lds_byte(wc * 32 + fr, fq * 8);
#define PG8_SA(b, h) (((b) * 2 + (h)) * HTB)
#define PG8_SB(b, h) ((4 + (b) * 2 + (h)) * HTB)
#define PG8_STAGE(bufoff, gbase, voff) do { _Pragma("unroll") for (int _i = 0; _i < 2; ++_i) \
    __builtin_amdgcn_global_load_lds((const unsigned*)((const char*)(gbase) + (voff)[_i]), (LAS unsigned*)(lds + (bufoff) + ldsw + _i * 8192), 16, 0, 0); } while (0)
#define PG8_LDA(dst, b, h) do { _Pragma("unroll") for (int m = 0; m < 4; ++m) _Pragma("unroll") for (int k = 0; k < 2; ++k) dst[m][k] = *(const LAS bf16x8*)(lds + PG8_SA(b, h) + aoff + m * 2048 + k * 1024); } while (0)
#define PG8_LDB(dst, b, h) do { _Pragma("unroll") for (int n = 0; n < 2; ++n) _Pragma("unroll") for (int k = 0; k < 2; ++k) dst[n][k] = *(const LAS bf16x8*)(lds + PG8_SB(b, h) + boff + n * 2048 + k * 1024); } while (0)
#define PG8_MMA(ai, bj, At, Bt) do { __builtin_amdgcn_s_setprio(1); _Pragma("unroll") for (int m = 0; m < 4; ++m) _Pragma("unroll") for (int n = 0; n < 2; ++n) _Pragma("unroll") for (int k = 0; k < 2; ++k) \
    acc[ai][bj][m][n] = __builtin_amdgcn_mfma_f32_16x16x32_bf16(Bt[n][k], At[m][k], acc[ai][bj][m][n], 0, 0, 0); __builtin_amdgcn_s_setprio(0); } while (0)
#define PG8_WAIT_V(n) asm volatile("s_waitcnt vmcnt(" #n ")" ::: "memory")
#define PG8_WAIT_L(n) asm volatile("s_waitcnt lgkmcnt(" #n ")" ::: "memory")
#define PG8_BAR __builtin_amdgcn_s_barrier()
#define PG8_SCHED __builtin_amdgcn_sched_barrier(0)
  Unit cur, nxt; int ui = 0;
  if (!S.next(0, cur)) return;
  f32x4 acc[2][2][4][2];
#pragma unroll
  for (int a = 0; a < 2; ++a)
#pragma unroll
    for (int b = 0; b < 2; ++b)
#pragma unroll
      for (int m = 0; m < 4; ++m)
#pragma unroll
        for (int n = 0; n < 2; ++n) acc[a][b][m][n] = (f32x4){0.f, 0.f, 0.f, 0.f};
  bf16x8 At[4][2], B0[2][2], B1[2][2];
  const char* cA = (const char*)g.A + (size_t)cur.pm * tstep; const char* cB = (const char*)g.Bt + (size_t)cur.pn * tstep;
  PG8_STAGE(PG8_SB(0, 0), cB, voffB); PG8_STAGE(PG8_SA(0, 0), cA, voffA); PG8_STAGE(PG8_SB(0, 1), cB + hstep, voffB); PG8_STAGE(PG8_SA(0, 1), cA + hstep, voffA);
  if (wr == 1) PG8_BAR;
  PG8_WAIT_V(4); PG8_BAR;
  PG8_STAGE(PG8_SB(1, 0), cB + kstep, voffB); PG8_STAGE(PG8_SA(1, 0), cA + kstep, voffA); PG8_STAGE(PG8_SB(1, 1), cB + hstep + kstep, voffB);
  PG8_WAIT_V(6); PG8_BAR;
  for (;;) {
    const bool has_next = S.next(ui + 1, nxt);
    const char* nA = has_next ? (const char*)g.A + (size_t)nxt.pm * tstep : cA; const char* nB = has_next ? (const char*)g.Bt + (size_t)nxt.pn * tstep : cB;
    for (int t = 0; t < nt; t += 2) {
      const bool last = (t == nt - 2);
      const char* a1 = cA + (size_t)(t + 1) * kstep;
      const char* a2 = last ? nA : cA + (size_t)(t + 2) * kstep; const char* b2 = last ? nB : cB + (size_t)(t + 2) * kstep;
      const char* a3 = a2 + kstep; const char* b3 = b2 + kstep;
      PG8_LDB(B0, 0, 0); PG8_SCHED; PG8_LDA(At, 0, 0); PG8_STAGE(PG8_SA(1, 1), a1 + hstep, voffA);
      PG8_WAIT_L(8); PG8_BAR; PG8_WAIT_L(0); PG8_MMA(0, 0, At, B0); PG8_BAR; PG8_SCHED;
      PG8_LDB(B1, 0, 1); PG8_STAGE(PG8_SB(0, 0), b2, voffB);
      PG8_BAR; PG8_WAIT_L(0); PG8_MMA(0, 1, At, B1); PG8_BAR;
      PG8_LDA(At, 0, 1); PG8_STAGE(PG8_SA(0, 0), a2, voffA);
      PG8_BAR; PG8_WAIT_L(0); PG8_MMA(1, 0, At, B0); PG8_BAR; PG8_SCHED;
      PG8_STAGE(PG8_SB(0, 1), b2 + hstep, voffB);
      PG8_WAIT_V(6); PG8_BAR; PG8_MMA(1, 1, At, B1); PG8_BAR;
      PG8_LDB(B0, 1, 0); PG8_SCHED; PG8_LDA(At, 1, 0); PG8_STAGE(PG8_SA(0, 1), a2 + hstep, voffA);
      PG8_WAIT_L(8); PG8_BAR; PG8_WAIT_L(0); PG8_MMA(0, 0, At, B0); PG8_BAR; PG8_SCHED;
      PG8_LDB(B1, 1, 1); PG8_STAGE(PG8_SB(1, 0), b3, voffB);
      PG8_BAR; PG8_WAIT_L(0); PG8_MMA(0, 1, At, B1); PG8_BAR;
      PG8_LDA(At, 1, 1); PG8_STAGE(PG8_SA(1, 0), a3, voffA);
      PG8_BAR; PG8_WAIT_L(0); PG8_MMA(1, 0, At, B0); PG8_BAR; PG8_SCHED;
      PG8_STAGE(PG8_SB(1, 1), b3 + hstep, voffB);
      PG8_WAIT_V(6); PG8_BAR; PG8_MMA(1, 1, At, B1); PG8_BAR;
    }
    E(acc, cur, wr, wc, fr, fq);
    if (!has_next) break;
#pragma unroll
    for (int a = 0; a < 2; ++a)
#pragma unroll
      for (int b = 0; b < 2; ++b)
#pragma unroll
        for (int m = 0; m < 4; ++m)
#pragma unroll
          for (int n = 0; n < 2; ++n) acc[a][b][m][n] = (f32x4){0.f, 0.f, 0.f, 0.f};
    cur = nxt; cA = nA; cB = nB; ++ui;
  }
  PG8_WAIT_V(0);
  if (wr == 0) PG8_BAR;
  PG8_BAR;
#undef PG8_SA
#undef PG8_SB
#undef PG8_STAGE
#undef PG8_LDA
#undef PG8_LDB
#undef PG8_MMA
#undef PG8_WAIT_V
#undef PG8_WAIT_L
#undef PG8_BAR
#undef PG8_SCHED
}
}
using pg8::Unit;

typedef f32x4 AccT[2][2][4][2];
DI void st_bf4(bf16_t* p, f32x4 v) { u32x2 w; w.x = pk2(v[0], v[1]); w.y = pk2(v[2], v[3]); *(GAS u32x2*)p = w; }
DI f32x4 ld_bf4(const bf16_t* p) { const u32x2 w = *(const GAS u32x2*)p; return (f32x4){bflo(w.x), bfhi(w.x), bflo(w.y), bfhi(w.y)}; }

struct EpiSwiglu {
  bf16_t* H;
  DI void operator()(const AccT& acc, const Unit& u, int wr, int wc, int fr, int fq) const {
    const int row0 = u.pm * 256 + wr * 64 + fr, col0 = u.pn * 128 + wc * 32 + 4 * fq;
#pragma unroll
    for (int ai = 0; ai < 2; ++ai)
#pragma unroll
      for (int m = 0; m < 4; ++m) {
        bf16_t* rowp = H + (size_t)(row0 + ai * 128 + m * 16) * DFF + col0;
#pragma unroll
        for (int n = 0; n < 2; ++n) {
          const f32x4 a = acc[ai][0][m][n], b = acc[ai][1][m][n]; f32x4 h;
#pragma unroll
          for (int j = 0; j < 4; ++j) h[j] = a[j] * sigmoidf_(a[j]) * b[j];
          st_bf4(rowp + n * 16, h);
        }
      }
  }
};
struct EpiResid {
  float* X; const float* modl; int gate_idx; float coef;
  DI void operator()(const AccT& acc, const Unit& u, int wr, int wc, int fr, int fq) const {
    const int mrow = u.pm < 16 ? 8 : ((u.pm - 16) >> 2);
    const int row0 = u.pm * 256 + wr * 64 + fr, col0 = u.pn * 256 + wc * 32 + 4 * fq;
    const float* gp = modl + (size_t)mrow * 9216 + gate_idx * 1024 + col0;
    f32x4 gv[2][2];
#pragma unroll
    for (int bj = 0; bj < 2; ++bj)
#pragma unroll
      for (int n = 0; n < 2; ++n) gv[bj][n] = *(const GAS f32x4*)(gp + bj * 128 + n * 16) * coef;
#pragma unroll
    for (int ai = 0; ai < 2; ++ai) {
      f32x4 xv[4][2][2];
#pragma unroll
      for (int m = 0; m < 4; ++m)
#pragma unroll
        for (int bj = 0; bj < 2; ++bj)
#pragma unroll
          for (int n = 0; n < 2; ++n) xv[m][bj][n] = *(const GAS f32x4*)(X + (size_t)(row0 + ai * 128 + m * 16) * DM + col0 + bj * 128 + n * 16);
#pragma unroll
      for (int m = 0; m < 4; ++m)
#pragma unroll
        for (int bj = 0; bj < 2; ++bj)
#pragma unroll
          for (int n = 0; n < 2; ++n) *(GAS f32x4*)(X + (size_t)(row0 + ai * 128 + m * 16) * DM + col0 + bj * 128 + n * 16) = xv[m][bj][n] + gv[bj][n] * acc[ai][bj][m][n];
    }
  }
};
struct EpiWin {
  bf16_t* U; bf16_t* Q; bf16_t* Kb; bf16_t* Vb; float* outk; float* outv; const float* rope; int layer;
  DI void operator()(const AccT& acc, const Unit& u, int wr, int wc, int fr, int fq) const {
    const int pn = u.pn, row0 = u.pm * 256 + wr * 64 + fr;
    const bool lat = u.pm >= 16;
    if (pn < 2 || pn >= 8) {
      const int col0 = pn * 256 + wc * 32 + 4 * fq;
#pragma unroll
      for (int ai = 0; ai < 2; ++ai)
#pragma unroll
        for (int m = 0; m < 4; ++m) {
          bf16_t* rowp = U + (size_t)(row0 + ai * 128 + m * 16) * INW + col0;
#pragma unroll
          for (int bj = 0; bj < 2; ++bj)
#pragma unroll
            for (int n = 0; n < 2; ++n) st_bf4(rowp + bj * 128 + n * 16, acc[ai][bj][m][n]);
        }
    } else if (pn < 6) {
      const bool isq = pn < 4;
      const int cq0 = (pn & 1) * 256 + wc * 32 + 4 * fq;
      const float scale = isq ? 0.125f * 1.4426950408889634f : 1.f;
      bf16_t* dstb = isq ? Q : Kb;
#pragma unroll
      for (int ai = 0; ai < 2; ++ai)
#pragma unroll
        for (int m = 0; m < 4; ++m) {
          const int row = row0 + ai * 128 + m * 16;
          f32x4 cs = {1.f, 1.f, 1.f, 1.f}, sn = {0.f, 0.f, 0.f, 0.f};
          if (lat) {
            const int pos = (row - T_CTX) & 1023;
            const float* rp = rope + (size_t)pos * 64 + ((wc & 1) * 16 + 4 * fq) * 2;
            const f32x4 r0 = *(const GAS f32x4*)rp, r1 = *(const GAS f32x4*)(rp + 4);
            cs = (f32x4){r0[0], r0[2], r1[0], r1[2]}; sn = (f32x4){r0[1], r0[3], r1[1], r1[3]};
          }
#pragma unroll
          for (int bj = 0; bj < 2; ++bj) {
            const f32x4 y1 = acc[ai][bj][m][0], y2 = acc[ai][bj][m][1];
            const f32x4 o1 = y1 * cs - y2 * sn, o2 = y2 * cs + y1 * sn;
            bf16_t* d = dstb + (size_t)row * 512 + cq0 + bj * 128;
            st_bf4(d, o1 * scale); st_bf4(d + 16, o2 * scale);
            if (!isq && !lat) {
              float* o = outk + ((size_t)((row >> 8) * 4 + layer) * 256 + (row & 255)) * 512 + cq0 + bj * 128;
              *(GAS f32x4*)o = o1; *(GAS f32x4*)(o + 16) = o2;
            }
          }
        }
    } else {
      const int cv0 = (pn & 1) * 256 + wc * 32 + 4 * fq;
#pragma unroll
      for (int ai = 0; ai < 2; ++ai)
#pragma unroll
        for (int m = 0; m < 4; ++m) {
          const int row = row0 + ai * 128 + m * 16;
#pragma unroll
          for (int bj = 0; bj < 2; ++bj)
#pragma unroll
            for (int n = 0; n < 2; ++n) {
              st_bf4(Vb + (size_t)row * 512 + cv0 + bj * 128 + n * 16, acc[ai][bj][m][n]);
              if (!lat) *(GAS f32x4*)(outv + ((size_t)((row >> 8) * 4 + layer) * 256 + (row & 255)) * 512 + cv0 + bj * 128 + n * 16) = acc[ai][bj][m][n];
            }
        }
    }
  }
};
struct EpiGlu {
  const bf16_t* ya; bf16_t* ys0;
  DI void operator()(const AccT& acc, const Unit& u, int wr, int wc, int fr, int fq) const {
    const int row0 = u.pm * 256 + wr * 64 + fr, col0 = u.pn * 256 + wc * 32 + 4 * fq;
#pragma unroll
    for (int ai = 0; ai < 2; ++ai) {
      u32x2 yv[4][2][2];
#pragma unroll
      for (int m = 0; m < 4; ++m)
#pragma unroll
        for (int bj = 0; bj < 2; ++bj)
#pragma unroll
          for (int n = 0; n < 2; ++n) yv[m][bj][n] = *(const GAS u32x2*)(ya + (size_t)(row0 + ai * 128 + m * 16) * 512 + col0 + bj * 128 + n * 16);
#pragma unroll
      for (int m = 0; m < 4; ++m)
#pragma unroll
        for (int bj = 0; bj < 2; ++bj)
#pragma unroll
          for (int n = 0; n < 2; ++n) {
            const u32x2 w = yv[m][bj][n]; const f32x4 y = {bflo(w.x), bfhi(w.x), bflo(w.y), bfhi(w.y)}, a = acc[ai][bj][m][n]; f32x4 o;
#pragma unroll
            for (int j = 0; j < 4; ++j) o[j] = y[j] * sigmoidf_(a[j]);
            st_bf4(ys0 + (size_t)(row0 + ai * 128 + m * 16) * 512 + col0 + bj * 128 + n * 16, o);
          }
    }
  }
};
struct EpiBranch {
  const bf16_t* U; float* MRG; bf16_t* MERGED;
  DI void operator()(const AccT& acc, const Unit& u, int wr, int wc, int fr, int fq) const {
    const int n3 = u.pm / 48, pm = u.pm - n3 * 48, pn = u.pn & 3;
    const int row0 = pm * 256 + wr * 64 + fr, col0 = pn * 256 + wc * 32 + 4 * fq;
#pragma unroll
    for (int ai = 0; ai < 2; ++ai)
#pragma unroll
      for (int mh = 0; mh < 2; ++mh) {
        u32x2 gt[2][2][2]; f32x4 mv[2][2][2];
#pragma unroll
        for (int m2 = 0; m2 < 2; ++m2)
#pragma unroll
          for (int bj = 0; bj < 2; ++bj)
#pragma unroll
            for (int n = 0; n < 2; ++n) {
              const int row = row0 + ai * 128 + (mh * 2 + m2) * 16;
              gt[m2][bj][n] = *(const GAS u32x2*)(U + (size_t)row * INW + 2560 + n3 * 1024 + col0 + bj * 128 + n * 16);
              mv[m2][bj][n] = n3 ? *(const GAS f32x4*)(MRG + (size_t)row * DM + col0 + bj * 128 + n * 16) : (f32x4){0.f, 0.f, 0.f, 0.f};
            }
#pragma unroll
        for (int m2 = 0; m2 < 2; ++m2)
#pragma unroll
          for (int bj = 0; bj < 2; ++bj)
#pragma unroll
            for (int n = 0; n < 2; ++n) {
              const int row = row0 + ai * 128 + (mh * 2 + m2) * 16;
              const u32x2 w = gt[m2][bj][n]; const f32x4 gg = {bflo(w.x), bfhi(w.x), bflo(w.y), bfhi(w.y)}, a = acc[ai][bj][mh * 2 + m2][n]; f32x4 o;
#pragma unroll
              for (int j = 0; j < 4; ++j) o[j] = mv[m2][bj][n][j] + sigmoidf_(gg[j]) * a[j];
              if (n3 < 2) *(GAS f32x4*)(MRG + (size_t)row * DM + col0 + bj * 128 + n * 16) = o;
              else st_bf4(MERGED + (size_t)row * DM + col0 + bj * 128 + n * 16, o);
            }
      }
  }
};

struct TrItem { const float* W; bf16_t* WT; int K, N, swiglu, item; };
DI void tr_load(const TrItem& t, int lane, float (&v)[32]) {
  const int nblk = t.N / 32, kb = t.item / nblk, nb = t.item % nblk, k0 = 64 * kb, n0 = 32 * nb;
#pragma unroll
  for (int i = 0; i < 32; ++i) { const int kk = 2 * i + (lane >> 5); v[i] = gldf(t.W + (size_t)(k0 + kk) * t.N + n0 + (lane & 31)); }
}
DI void tr_finish(const TrItem& t, int lane, const float (&v)[32], LAS float* scr) {
  const int nblk = t.N / 32, kb = t.item / nblk, nb = t.item % nblk, k0 = 64 * kb, n0 = 32 * nb;
#pragma unroll
  for (int i = 0; i < 32; ++i) { const int kk = 2 * i + (lane >> 5); scr[kk * 33 + (lane & 31)] = v[i]; }
  LDS_WAIT();
  const int c = lane & 7;
#pragma unroll
  for (int j = 0; j < 4; ++j) {
    const int n = (lane >> 3) + 8 * j; const LAS float* s = scr + (8 * c) * 33 + n;
    u32x4 o; o.x = pk2(s[0 * 33], s[1 * 33]); o.y = pk2(s[2 * 33], s[3 * 33]); o.z = pk2(s[4 * 33], s[5 * 33]); o.w = pk2(s[6 * 33], s[7 * 33]);
    int dr = n0 + n;
    if (t.swiglu) { const int isb = dr >= DFF, hh = isb ? dr - DFF : dr; dr = (hh >> 7) * 256 + isb * 128 + (hh & 127); }
    *(GAS u32x4*)(t.WT + (size_t)dr * t.K + k0 + 8 * c) = o;
  }
  LDS_WAIT();
}
DI TrItem tr_decode(const Ctx& p, int it) {
  constexpr int I_FI = 16 * 176, I_FO = 44 * 32, I_IN = 16 * 176, I_GLU = 8 * 16, I_BR = 8 * 32, I_OUT = 16 * 32, I_P = 2 * 4;
  constexpr int I_LAYER = 2 * I_FI + 2 * I_FO + I_IN + I_GLU + 3 * I_BR + I_OUT + 4 * I_P;
  const int l = it / I_LAYER; int r = it % I_LAYER;
  bf16_t* wl = (bf16_t*)(p.ws + OFF_W) + (size_t)l * W_LAYER;
  TrItem t;
  if (r < 2 * I_FI) { const int s = r / I_FI; t = TrItem{p.in[10] + (size_t)(l * 2 + s) * 1024 * 5632, wl + W_FI + (size_t)s * 5632 * 1024, 1024, 5632, 1, r % I_FI}; return t; } r -= 2 * I_FI;
  if (r < 2 * I_FO) { const int s = r / I_FO; t = TrItem{p.in[11] + (size_t)(l * 2 + s) * 2816 * 1024, wl + W_FO + (size_t)s * 1024 * 2816, 2816, 1024, 0, r % I_FO}; return t; } r -= 2 * I_FO;
  if (r < I_IN) { t = TrItem{p.in[12] + (size_t)l * 1024 * 5632, wl + W_IN, 1024, 5632, 0, r}; return t; } r -= I_IN;
  if (r < I_GLU) { t = TrItem{p.in[21] + (size_t)l * 512 * 512, wl + W_GLU, 512, 512, 0, r}; return t; } r -= I_GLU;
  if (r < 3 * I_BR) { const int s = r / I_BR; t = TrItem{p.in[29] + (size_t)(l * 3 + s) * 512 * 1024, wl + W_BR + (size_t)s * 1024 * 512, 512, 1024, 0, r % I_BR}; return t; } r -= 3 * I_BR;
  if (r < I_OUT) { t = TrItem{p.in[30] + (size_t)l * 1024 * 1024, wl + W_OUT, 1024, 1024, 0, r}; return t; } r -= I_OUT;
  { const int s = r / I_P; t = TrItem{p.in[27] + (size_t)(l * 4 + s) * 128 * 128, wl + W_P + (size_t)s * 128 * 128, 128, 128, 0, r % I_P}; return t; }
}
constexpr int TR_ITEMS = 4 * (2 * 16 * 176 + 2 * 44 * 32 + 16 * 176 + 8 * 16 + 3 * 8 * 32 + 16 * 32 + 4 * 2 * 4);

DI void prep_phase(const Ctx& p, LAS unsigned char* lds) {
  const int tid = opaque_tid(), lane = tid & 63, wave = tid >> 6;
  unsigned char* ws = p.ws;
  for (int item = blockIdx.x; item < 144; item += gridDim.x) {
    const int l = item / 36, jc = item % 36;
    LAS float* sc = (LAS float*)lds;
    LAS float* red = sc + 9 * 1024;
    for (int i = tid; i < 9 * 1024; i += 512) { const int r = i >> 10, k = i & 1023; const float v = r < 8 ? gldf(p.in[5] + r * 1024 + k) : gldf(p.in[6] + k); sc[i] = v * sigmoidf_(v); }
    __syncthreads();
    const int j0 = jc * 256 + lane * 4;
    const float* w = p.in[8] + (size_t)l * 1024 * 9216 + (size_t)(wave * 128) * 9216 + j0;
    f32x4 acc[9];
#pragma unroll
    for (int r = 0; r < 9; ++r) acc[r] = (f32x4){0.f, 0.f, 0.f, 0.f};
    const LAS float* s0 = sc + wave * 128;
#pragma unroll 8
    for (int k = 0; k < 128; ++k) {
      const f32x4 wv = *(const GAS f32x4*)(w + (size_t)k * 9216);
#pragma unroll
      for (int r = 0; r < 9; ++r) acc[r] += wv * s0[r * 1024 + k];
    }
#pragma unroll
    for (int r = 0; r < 9; ++r) *(LAS f32x4*)(red + (wave * 9 + r) * 256 + lane * 4) = acc[r];
    __syncthreads();
    for (int o = tid; o < 9 * 256; o += 512) {
      const int r = o >> 8, col = o & 255; float s = 0.f;
#pragma unroll
      for (int w8 = 0; w8 < 8; ++w8) s += red[(w8 * 9 + r) * 256 + col];
      gstf((float*)(ws + OFF_MOD) + ((size_t)l * 9 + r) * 9216 + jc * 256 + col, s + gldf(p.in[9] + l * 9216 + jc * 256 + col));
    }
    __syncthreads();
  }
  {
    LAS float* scr = (LAS float*)(lds + wave * 8448);
    const int gw = blockIdx.x * 8 + wave, NGW = gridDim.x * 8;
    if (gw < TR_ITEMS) {
      TrItem cur = tr_decode(p, gw); float va[32], vb[32];
      tr_load(cur, lane, va);
      for (int it = gw; it < TR_ITEMS; it += 2 * NGW) {
        const bool h1 = it + NGW < TR_ITEMS, h2 = it + 2 * NGW < TR_ITEMS;
        TrItem nx = cur;
        if (h1) { nx = tr_decode(p, it + NGW); tr_load(nx, lane, vb); }
        tr_finish(cur, lane, va, scr);
        if (h1) {
          if (h2) { cur = tr_decode(p, it + 2 * NGW); tr_load(cur, lane, va); }
          tr_finish(nx, lane, vb, scr);
        }
      }
    }
  }
  const size_t gt = (size_t)blockIdx.x * 512 + tid, GT = (size_t)gridDim.x * 512;
  for (size_t i = gt; i < 2 * 1048576; i += GT) {
    const int which = i >= 1048576; const size_t e = (i & 1048575) * 8;
    const float* src = (which ? p.in[3] : p.in[2]) + e;
    const f32x4 a = *(const GAS f32x4*)src, b = *(const GAS f32x4*)(src + 4);
    u32x4 o; o.x = pk2(a[0], a[1]); o.y = pk2(a[2], a[3]); o.z = pk2(b[0], b[1]); o.w = pk2(b[2], b[3]);
    *(GAS u32x4*)((bf16_t*)(ws + (which ? OFF_VC : OFF_KC)) + e) = o;
  }
  for (size_t i = gt; i < 16384; i += GT) {
    const int pI = (int)(i & 63), ldg = (int)(i >> 6);
    const float lr = gldf(p.in[13] + i), li = gldf(p.in[14] + i), dt = expf(gldf(p.in[15] + ldg));
    const float mag = expf(lr * dt), abr = mag * cosf(li * dt), abi = mag * sinf(li * dt);
    const float den = lr * lr + li * li, nr = abr - 1.0f, kr = (nr * lr + abi * li) / den, ki = (abi * lr - nr * li) / den;
    float* at = (float*)(ws + OFF_AT) + i * 2; gstf(at, abr); gstf(at + 1, abi);
    bf16_t* bbp = (bf16_t*)(ws + OFF_BB) + (size_t)ldg * 2048;
    const float* bre = p.in[16] + i * 16; const float* bim = p.in[17] + i * 16;
    for (int c = 0; c < 16; c += 2) {
      const float br0 = gldf(bre + c), bi0 = gldf(bim + c), br1 = gldf(bre + c + 1), bi1 = gldf(bim + c + 1);
      *(GAS unsigned*)(bbp + (size_t)pI * 16 + c) = pk2(kr * br0 - ki * bi0, kr * br1 - ki * bi1);
      *(GAS unsigned*)(bbp + (size_t)(64 + pI) * 16 + c) = pk2(kr * bi0 + ki * br0, kr * bi1 + ki * br1);
    }
    bf16_t* cmp = (bf16_t*)(ws + OFF_CM) + (size_t)ldg * 2048;
    for (int c = 0; c < 16; ++c) {
      const float cr = gldf(p.in[18] + ((size_t)ldg * 16 + c) * 64 + pI), ci = gldf(p.in[19] + ((size_t)ldg * 16 + c) * 64 + pI);
      *(GAS unsigned*)(cmp + (size_t)c * 128 + 2 * pI) = pk2(cr, -ci);
    }
  }
  for (size_t i = gt; i < 32768; i += GT) {
    const int pos = (int)(i >> 5), j = (int)(i & 31);
    const float inv = powf(10000.0f, -(float)(j & 15) / 16.0f);
    const float ang = (float)(j < 16 ? (pos >> 6) : (pos & 63)) * inv;
    float* rp = (float*)(ws + OFF_ROPE) + i * 2; gstf(rp, cosf(ang)); gstf(rp + 1, sinf(ang));
  }
  if (gt < 4) {
    const int l = (int)gt; float s1 = 0.f, s2 = 0.f;
    for (int k = 0; k < 64; ++k) { s1 += gldf(p.in[22] + l * 64 + k) * gldf(p.in[23] + l * 64 + k); s2 += gldf(p.in[24] + l * 64 + k) * gldf(p.in[25] + l * 64 + k); }
    const float lam_init = 0.8f - 0.6f * expf(-0.3f * (float)l);
    gstf((float*)(ws + OFF_LAM) + l, expf(s1) - expf(s2) + lam_init);
  }
}

DI void norm_phase(const Ctx& p, int layer, int sub, bool first, bool final_) {
  const int tid = opaque_tid(), lane = tid & 63, wave = tid >> 6;
  float* X = (float*)(p.ws + OFF_X); bf16_t* Nb = (bf16_t*)(p.ws + OFF_N);
  const int gw = blockIdx.x * 8 + wave, NGW = gridDim.x * 8;
  for (int row = gw; row < T_ALL; row += NGW) {
    const float* src = first ? (row < T_CTX ? p.in[0] + (size_t)row * DM : p.in[1] + (size_t)(row - T_CTX) * DM) : X + (size_t)row * DM;
    f32x4 v[4]; float ss = 0.f;
#pragma unroll
    for (int j = 0; j < 4; ++j) { v[j] = ((const GAS f32x4*)src)[lane + 64 * j]; ss += (v[j][0] * v[j][0] + v[j][1] * v[j][1]) + (v[j][2] * v[j][2] + v[j][3] * v[j][3]); }
    const float rstd = 1.0f / sqrtf(wave_sum(ss) * (1.f / DM) + 1e-6f);
    if (final_) {
      const float* g = p.in[31];
#pragma unroll
      for (int j = 0; j < 4; ++j) { const f32x4 gv = ((const GAS f32x4*)g)[lane + 64 * j]; ((GAS f32x4*)(p.out + (size_t)row * DM))[lane + 64 * j] = v[j] * rstd * gv; }
    } else {
      const int mrow = row < T_CTX ? 8 : ((row - T_CTX) >> 10);
      const float* md = (const float*)(p.ws + OFF_MOD) + ((size_t)layer * 9 + mrow) * 9216;
      const float* sh = md + (3 * sub) * 1024; const float* sc = md + (3 * sub + 1) * 1024; const float* g = p.in[7] + (size_t)(layer * 3 + sub) * DM;
#pragma unroll
      for (int j = 0; j < 4; ++j) {
        const f32x4 gv = ((const GAS f32x4*)g)[lane + 64 * j], sv = ((const GAS f32x4*)sc)[lane + 64 * j], hv = ((const GAS f32x4*)sh)[lane + 64 * j];
        const f32x4 y = v[j] * rstd * gv * (sv + 1.f) + hv;
        st_bf4(Nb + (size_t)row * DM + (lane + 64 * j) * 4, y);
        if (first) ((GAS f32x4*)(X + (size_t)row * DM))[lane + 64 * j] = v[j];
      }
    }
  }
}

DI s16x4 tr_read(unsigned lds_addr) { s16x4 r; asm volatile("ds_read_b64_tr_b16 %0, %1\n\ts_waitcnt lgkmcnt(0)" : "=&v"(r) : "v"(lds_addr) : "memory"); return r; }
#define MFMA32(a, b, c) __builtin_amdgcn_mfma_f32_32x32x16_bf16((a), (b), (c), 0, 0, 0)
#define MFMA16(a, b, c) __builtin_amdgcn_mfma_f32_16x16x32_bf16((a), (b), (c), 0, 0, 0)

DI void attn_item(const Ctx& p, int layer, bool lat, int seq, int head, int qblk, LAS unsigned char* lds) {
  const int tid = opaque_tid(), lane = tid & 63, wave = tid >> 6, r16 = lane & 15, g4 = lane >> 4;
  unsigned char* ws = p.ws;
  const bf16_t* Qg = (const bf16_t*)(ws + OFF_Q); const bf16_t* Kg = (const bf16_t*)(ws + OFF_K); const bf16_t* Vg = (const bf16_t*)(ws + OFF_V);
  const int tok0 = lat ? T_CTX + seq * 1024 : seq * 256;
  const int n_own = lat ? 16 : 4, n_tiles = lat ? 24 : 4;
  const bf16_t* Kc = (const bf16_t*)(ws + OFF_KC) + (size_t)(seq * 4 + layer) * 512 * 512;
  const bf16_t* Vc = (const bf16_t*)(ws + OFF_VC) + (size_t)(seq * 4 + layer) * 512 * 512;
  constexpr int RS = 272;
  LAS unsigned char* Kt = lds; LAS unsigned char* Vt = lds + 64 * RS;
  const int qtok = tok0 + qblk * 128 + wave * 16 + r16;
  bf16x8 Qf[2][2];
#pragma unroll
  for (int m = 0; m < 2; ++m)
#pragma unroll
    for (int kk = 0; kk < 2; ++kk) Qf[m][kk] = *(const GAS bf16x8*)(Qg + (size_t)qtok * 512 + head * 128 + m * 64 + g4 * 8 + 32 * kk);
  u32x4 kreg[2], vreg[2];
  auto issue = [&](int kt) {
    const bf16_t* kb; const bf16_t* vb;
    if (kt < n_own) { kb = Kg + (size_t)(tok0 + kt * 64) * 512 + head * 128; vb = Vg + (size_t)(tok0 + kt * 64) * 512 + head * 128; }
    else { kb = Kc + (size_t)((kt - n_own) * 64) * 512 + head * 128; vb = Vc + (size_t)((kt - n_own) * 64) * 512 + head * 128; }
#pragma unroll
    for (int i = 0; i < 2; ++i) { const int ci = tid + 512 * i, row = ci >> 4, part = ci & 15; kreg[i] = *(const GAS u32x4*)(kb + (size_t)row * 512 + part * 8); vreg[i] = *(const GAS u32x4*)(vb + (size_t)row * 512 + part * 8); }
  };
  issue(0);
  f32x4 O[2][8];
#pragma unroll
  for (int m = 0; m < 2; ++m)
#pragma unroll
    for (int d = 0; d < 8; ++d) O[m][d] = (f32x4){0.f, 0.f, 0.f, 0.f};
  float mrun[2] = {-1e30f, -1e30f}, lsum[2] = {0.f, 0.f};
  const unsigned vbase = (unsigned)(size_t)Vt;
  const int tq = r16 >> 2, tp = r16 & 3;
  for (int kt = 0; kt < n_tiles; ++kt) {
    __syncthreads();
#pragma unroll
    for (int i = 0; i < 2; ++i) { const int ci = tid + 512 * i, row = ci >> 4, part = ci & 15; *(LAS u32x4*)(Kt + row * RS + part * 16) = kreg[i]; *(LAS u32x4*)(Vt + row * RS + part * 16) = vreg[i]; }
    __syncthreads();
    if (kt + 1 < n_tiles) issue(kt + 1);
    bf16x8 P[2][2];
#pragma unroll
    for (int m = 0; m < 2; ++m) {
      f32x4 S[4];
#pragma unroll
      for (int kb = 0; kb < 4; ++kb) {
        S[kb] = (f32x4){0.f, 0.f, 0.f, 0.f};
#pragma unroll
        for (int kk = 0; kk < 2; ++kk) { const bf16x8 Kf = *(const LAS bf16x8*)(Kt + (16 * kb + r16) * RS + m * 128 + (g4 * 8 + 32 * kk) * 2); S[kb] = MFMA16(Kf, Qf[m][kk], S[kb]); }
      }
      float mx = S[0][0];
#pragma unroll
      for (int kb = 0; kb < 4; ++kb)
#pragma unroll
        for (int j = 0; j < 4; ++j) mx = fmaxf(mx, S[kb][j]);
      mx = fmaxf(mx, __shfl_xor(mx, 16)); mx = fmaxf(mx, __shfl_xor(mx, 32));
      const float mnew = fmaxf(mrun[m], mx), alpha = __builtin_amdgcn_exp2f(mrun[m] - mnew);
      mrun[m] = mnew;
      float ps = 0.f;
#pragma unroll
      for (int kb = 0; kb < 4; ++kb)
#pragma unroll
        for (int j = 0; j < 4; ++j) { S[kb][j] = __builtin_amdgcn_exp2f(S[kb][j] - mnew); ps += S[kb][j]; }
      lsum[m] = lsum[m] * alpha + ps;
#pragma unroll
      for (int d = 0; d < 8; ++d) O[m][d] *= alpha;
#pragma unroll
      for (int s = 0; s < 2; ++s) {
        u32x4 w; w.x = pk2(S[2 * s][0], S[2 * s][1]); w.y = pk2(S[2 * s][2], S[2 * s][3]); w.z = pk2(S[2 * s + 1][0], S[2 * s + 1][1]); w.w = pk2(S[2 * s + 1][2], S[2 * s + 1][3]);
        P[m][s] = __builtin_bit_cast(bf16x8, w);
      }
    }
#pragma unroll
    for (int s = 0; s < 2; ++s) {
      s16x4 v0, v1, v2, v3, v4, v5, v6, v7, v8, v9, v10, v11, v12, v13, v14, v15;
      const unsigned a0 = vbase + (32 * s + 4 * g4 + tq) * RS + 8 * tp;
      asm volatile(
        "ds_read_b64_tr_b16 %0, %16\n\tds_read_b64_tr_b16 %1, %16 offset:4352\n\t"
        "ds_read_b64_tr_b16 %2, %16 offset:32\n\tds_read_b64_tr_b16 %3, %16 offset:4384\n\t"
        "ds_read_b64_tr_b16 %4, %16 offset:64\n\tds_read_b64_tr_b16 %5, %16 offset:4416\n\t"
        "ds_read_b64_tr_b16 %6, %16 offset:96\n\tds_read_b64_tr_b16 %7, %16 offset:4448\n\t"
        "ds_read_b64_tr_b16 %8, %16 offset:128\n\tds_read_b64_tr_b16 %9, %16 offset:4480\n\t"
        "ds_read_b64_tr_b16 %10, %16 offset:160\n\tds_read_b64_tr_b16 %11, %16 offset:4512\n\t"
        "ds_read_b64_tr_b16 %12, %16 offset:192\n\tds_read_b64_tr_b16 %13, %16 offset:4544\n\t"
        "ds_read_b64_tr_b16 %14, %16 offset:224\n\tds_read_b64_tr_b16 %15, %16 offset:4576\n\t"
        "s_waitcnt lgkmcnt(0)"
        : "=&v"(v0), "=&v"(v1), "=&v"(v2), "=&v"(v3), "=&v"(v4), "=&v"(v5), "=&v"(v6), "=&v"(v7),
          "=&v"(v8), "=&v"(v9), "=&v"(v10), "=&v"(v11), "=&v"(v12), "=&v"(v13), "=&v"(v14), "=&v"(v15)
        : "v"(a0) : "memory");
#define ATT_PV(d, lo, hi) { const bf16x8 Vf = __builtin_shufflevector(lo, hi, 0, 1, 2, 3, 4, 5, 6, 7); O[0][d] = MFMA16(Vf, P[0][s], O[0][d]); O[1][d] = MFMA16(Vf, P[1][s], O[1][d]); }
      ATT_PV(0, v0, v1) ATT_PV(1, v2, v3) ATT_PV(2, v4, v5) ATT_PV(3, v6, v7) ATT_PV(4, v8, v9) ATT_PV(5, v10, v11) ATT_PV(6, v12, v13) ATT_PV(7, v14, v15)
#undef ATT_PV
    }
  }
  float l1 = lsum[0], l2 = lsum[1];
  l1 += __shfl_xor(l1, 16); l1 += __shfl_xor(l1, 32); l2 += __shfl_xor(l2, 16); l2 += __shfl_xor(l2, 32);
  const float lam = gldf((const float*)(ws + OFF_LAM) + layer);
  const float lam_init = 0.8f - 0.6f * expf(-0.3f * (float)layer);
  const float c1 = 1.f / l1, c2 = lam / l2;
  float ss = 0.f;
#pragma unroll
  for (int d = 0; d < 8; ++d) { const f32x4 o = O[0][d] * c1 - O[1][d] * c2; O[0][d] = o; ss += (o[0] * o[0] + o[1] * o[1]) + (o[2] * o[2] + o[3] * o[3]); }
  ss += __shfl_xor(ss, 16); ss += __shfl_xor(ss, 32);
  const float rn = (1.f - lam_init) / sqrtf(ss * (1.f / 128.f) + 1e-6f);
  const float* ag = p.in[26] + layer * 128;
  bf16_t* yb = (bf16_t*)(ws + OFF_YS) + (size_t)T_ALL * 512 + (size_t)qtok * 512 + head * 128;
#pragma unroll
  for (int d = 0; d < 8; ++d) {
    const int dv = 16 * d + 4 * g4;
    const f32x4 gv = *(const GAS f32x4*)(ag + dv);
    st_bf4(yb + dv, O[0][d] * rn * gv);
  }
}

DI void s5_item(const Ctx& p, int layer, bool lat, int pairIdx, int gsel, LAS unsigned char* lds) {
  const int tid = opaque_tid(), lane = tid & 63, wave = __builtin_amdgcn_readfirstlane(tid >> 6), r32 = lane & 31, h = lane >> 5;
  unsigned char* ws = p.ws;
  const int d = wave & 1, g = lat ? gsel : gsel * 4 + (wave >> 1), chunk = lat ? (wave >> 1) : 0;
  const int L = lat ? 1024 : 256;
  constexpr int nt = 16;
  const int seq0 = pairIdx * 2;
  const int tb0 = (lat ? T_CTX + seq0 * 1024 : seq0 * 256) + chunk * 256;
  const int ldg = (layer * 2 + d) * 32 + g;
  const float* at = (const float*)(ws + OFF_AT) + (size_t)ldg * 128;
  const float a0r = gldf(at + r32 * 2), a0i = gldf(at + r32 * 2 + 1), a1r = gldf(at + (r32 + 32) * 2), a1i = gldf(at + (r32 + 32) * 2 + 1);
  float h0r = 0.f, h0i = 0.f, h1r = 0.f, h1i = 0.f;
  if (lat) {
    const float* st = p.in[4] + ((size_t)(((seq0 + h) * 4 + layer) * 2 + d) * 2) * 2048 + g * 64;
    h0r = gldf(st + r32); h1r = gldf(st + r32 + 32); h0i = gldf(st + 2048 + r32); h1i = gldf(st + 2048 + r32 + 32);
  }
  bf16x8 BBf[4], Cmf[4];
  {
    const bf16_t* bb = (const bf16_t*)(ws + OFF_BB) + (size_t)ldg * 2048;
    const bf16_t* cm = (const bf16_t*)(ws + OFF_CM) + (size_t)ldg * 2048;
#pragma unroll
    for (int b = 0; b < 4; ++b) { BBf[b] = *(const GAS bf16x8*)(bb + (size_t)(b * 32 + r32) * 16 + h * 8); Cmf[b] = *(const GAS bf16x8*)(cm + (size_t)(lane & 15) * 128 + (lane >> 4) * 8 + 32 * b); }
  }
  const bf16_t* U = (const bf16_t*)(ws + OFF_UH);
  float* YP = (float*)(ws + OFF_YP);
  bf16_t* YA = (bf16_t*)(ws + OFF_YA);
  const int sA = (r32 >> 2) & 1, iA = 4 * (r32 >> 3) + (r32 & 3);
  const bf16_t* uA = U + (size_t)(tb0 + sA * L + iA) * INW + g * 16 + h * 8;
  constexpr int RS = 272;
  LAS unsigned char* hb = lds + wave * (32 * RS);
  const f32x4 dsk = *(const GAS f32x4*)(p.in[20] + layer * 512 + g * 16 + (lane >> 4) * 4);
  __syncthreads();
  if (lat) {
    float e0r = 0.f, e0i = 0.f, e1r = 0.f, e1i = 0.f;
    const bool need = d == 0 ? chunk < 3 : chunk > 0;
    if (need) {
      bf16x8 Af1 = *(const GAS bf16x8*)(uA + (size_t)(d ? nt - 1 : 0) * 16 * INW);
      for (int n = 0; n < nt; ++n) {
        const int tile = d ? nt - 1 - n : n;
        const int tilen = (n + 1 < nt) ? (d ? tile - 1 : tile + 1) : tile;
        const bf16x8 Afn = *(const GAS bf16x8*)(uA + (size_t)tilen * 16 * INW);
        f32x16 x0, x1, x2, x3;
#pragma unroll
        for (int i = 0; i < 16; ++i) { x0[i] = 0.f; x1[i] = 0.f; x2[i] = 0.f; x3[i] = 0.f; }
        x0 = MFMA32(Af1, BBf[0], x0); x1 = MFMA32(Af1, BBf[1], x1); x2 = MFMA32(Af1, BBf[2], x2); x3 = MFMA32(Af1, BBf[3], x3);
#define S5_STEP1(i) { const float nr0 = a0r * e0r - a0i * e0i + x0[i], ni0 = a0r * e0i + a0i * e0r + x2[i]; e0r = nr0; e0i = ni0; \
                      const float nr1 = a1r * e1r - a1i * e1i + x1[i], ni1 = a1r * e1i + a1i * e1r + x3[i]; e1r = nr1; e1i = ni1; }
        if (d == 0) {
#pragma unroll
          for (int i = 0; i < 16; ++i) S5_STEP1(i)
        } else {
#pragma unroll
          for (int i = 15; i >= 0; --i) S5_STEP1(i)
        }
#undef S5_STEP1
        Af1 = Afn;
      }
    }
    LAS float* Eb = (LAS float*)(lds + 8 * 32 * RS);
    Eb[(wave * 4 + 0) * 64 + lane] = e0r; Eb[(wave * 4 + 1) * 64 + lane] = e0i; Eb[(wave * 4 + 2) * 64 + lane] = e1r; Eb[(wave * 4 + 3) * 64 + lane] = e1i;
    __syncthreads();
    float p0r = a0r, p0i = a0i, p1r = a1r, p1i = a1i;
#pragma unroll
    for (int q = 0; q < 8; ++q) { const float t0 = p0r * p0r - p0i * p0i, u0 = 2.f * p0r * p0i; p0r = t0; p0i = u0; const float t1 = p1r * p1r - p1i * p1i, u1 = 2.f * p1r * p1i; p1r = t1; p1i = u1; }
    const int nprev = d == 0 ? chunk : 3 - chunk;
    for (int q = 0; q < nprev; ++q) {
      const int j = d == 0 ? q : 3 - q, wj = j * 2 + d;
      const float f0r = Eb[(wj * 4 + 0) * 64 + lane], f0i = Eb[(wj * 4 + 1) * 64 + lane], f1r = Eb[(wj * 4 + 2) * 64 + lane], f1i = Eb[(wj * 4 + 3) * 64 + lane];
      const float n0r = p0r * h0r - p0i * h0i + f0r, n0i = p0r * h0i + p0i * h0r + f0i; h0r = n0r; h0i = n0i;
      const float n1r = p1r * h1r - p1i * h1i + f1r, n1i = p1r * h1i + p1i * h1r + f1i; h1r = n1r; h1i = n1i;
    }
  }
  bf16x8 Af = *(const GAS bf16x8*)(uA + (size_t)(d ? nt - 1 : 0) * 16 * INW);
  for (int n = 0; n < nt; ++n) {
    if (n == nt / 2) __syncthreads();
    const int tile = d ? nt - 1 - n : n;
    const int tilen = (n + 1 < nt) ? (d ? tile - 1 : tile + 1) : tile;
    const bf16x8 Afn = *(const GAS bf16x8*)(uA + (size_t)tilen * 16 * INW);
    const bool second = n >= nt / 2;
    f32x4 po[2] = {{0.f, 0.f, 0.f, 0.f}, {0.f, 0.f, 0.f, 0.f}}; u32x2 pu[2] = {{0u, 0u}, {0u, 0u}};
    if (second) {
#pragma unroll
      for (int ss = 0; ss < 2; ++ss) {
        const int tok = tb0 + ss * L + tile * 16 + (lane & 15), ch = g * 16 + (lane >> 4) * 4;
        po[ss] = *(const GAS f32x4*)(YP + ((size_t)(1 - d) * T_ALL + tok) * 512 + ch);
        pu[ss] = *(const GAS u32x2*)(U + (size_t)tok * INW + ch);
      }
    }
    f32x16 x0, x1, x2, x3;
#pragma unroll
    for (int i = 0; i < 16; ++i) { x0[i] = 0.f; x1[i] = 0.f; x2[i] = 0.f; x3[i] = 0.f; }
    x0 = MFMA32(Af, BBf[0], x0); x1 = MFMA32(Af, BBf[1], x1); x2 = MFMA32(Af, BBf[2], x2); x3 = MFMA32(Af, BBf[3], x3);
#define S5_STEP(i) { const float nr0 = a0r * h0r - a0i * h0i + x0[i], ni0 = a0r * h0i + a0i * h0r + x2[i]; h0r = nr0; h0i = ni0; \
                     const float nr1 = a1r * h1r - a1i * h1i + x1[i], ni1 = a1r * h1i + a1i * h1r + x3[i]; h1r = nr1; h1i = ni1; \
                     *(LAS unsigned*)(hb + (h * 16 + (i)) * RS + r32 * 4) = pk2(h0r, h0i); *(LAS unsigned*)(hb + (h * 16 + (i)) * RS + (r32 + 32) * 4) = pk2(h1r, h1i); }
    if (d == 0) {
#pragma unroll
      for (int i = 0; i < 16; ++i) S5_STEP(i)
    } else {
#pragma unroll
      for (int i = 15; i >= 0; --i) S5_STEP(i)
    }
#undef S5_STEP
    LDS_WAIT();
#pragma unroll
    for (int ss = 0; ss < 2; ++ss) {
      f32x4 y = {0.f, 0.f, 0.f, 0.f};
#pragma unroll
      for (int kb = 0; kb < 4; ++kb) { const bf16x8 Hf = *(const LAS bf16x8*)(hb + (ss * 16 + (lane & 15)) * RS + ((lane >> 4) * 8 + 32 * kb) * 2); y = MFMA16(Cmf[kb], Hf, y); }
      const int tok = tb0 + ss * L + tile * 16 + (lane & 15), ch = g * 16 + (lane >> 4) * 4;
      if (!second) {
        *(GAS f32x4*)(YP + ((size_t)d * T_ALL + tok) * 512 + ch) = y;
      } else {
        const f32x4 uu = {bflo(pu[ss].x), bfhi(pu[ss].x), bflo(pu[ss].y), bfhi(pu[ss].y)};
        f32x4 v = y + po[ss] + uu * dsk, r;
#pragma unroll
        for (int j = 0; j < 4; ++j) { const float t = v[j]; r[j] = t * sigmoidf_(1.5957691216057308f * (t + 0.044715f * t * t * t)); }
        st_bf4(YA + (size_t)tok * 512 + ch, r);
      }
    }
    LDS_WAIT();
    Af = Afn;
  }
  if (!lat) {
    float* so = p.out + 12582912 + 8388608 + 8388608 + ((size_t)(((seq0 + h) * 4 + layer) * 2 + d) * 2) * 2048 + g * 64;
    gstf(so + r32, h0r); gstf(so + r32 + 32, h1r); gstf(so + 2048 + r32, h0i); gstf(so + 2048 + r32 + 32, h1i);
  }
}

template <int W>
DI void pool_body(const Ctx& p, int layer, int g, int t0, int lane) {
  const int r32 = lane & 31, h = lane >> 5;
  unsigned char* ws = p.ws;
  const int t = t0 + r32;
  const int sbase = t < T_CTX ? (t & ~255) : T_CTX + ((t - T_CTX) & ~1023), L = t < T_CTX ? 256 : 1024, tl = t - sbase;
  int lo = tl - W / 2, hi = lo + W; lo = lo < 0 ? 0 : lo; hi = hi > L ? L : hi;
  const float inv = 1.f / (float)(hi - lo);
  const bf16_t* Z = (const bf16_t*)(ws + OFF_UH) + 2048 + g * 128 + h * 8;
  bf16x8 Af[8];
#pragma unroll
  for (int kk = 0; kk < 8; ++kk) {
    u32x4 zz[W]; float ff[W];
#pragma unroll
    for (int dt = 0; dt < W; ++dt) {
      const int tp = tl - W / 2 + dt; const bool ok = tp >= 0 && tp < L; const int tc = ok ? tp : tl; ff[dt] = ok ? 1.f : 0.f;
      zz[dt] = *(const GAS u32x4*)(Z + (size_t)(sbase + tc) * INW + 16 * kk);
    }
    float s[8];
#pragma unroll
    for (int j = 0; j < 8; ++j) s[j] = 0.f;
#pragma unroll
    for (int dt = 0; dt < W; ++dt) {
      const u32x4 z = zz[dt]; const float f = ff[dt];
      s[0] += f * bflo(z.x); s[1] += f * bfhi(z.x); s[2] += f * bflo(z.y); s[3] += f * bfhi(z.y); s[4] += f * bflo(z.z); s[5] += f * bfhi(z.z); s[6] += f * bflo(z.w); s[7] += f * bfhi(z.w);
    }
    const u32x4 z = zz[W / 2];
    u32x4 o;
    o.x = pk2(s[0] * inv - bflo(z.x), s[1] * inv - bfhi(z.x)); o.y = pk2(s[2] * inv - bflo(z.y), s[3] * inv - bfhi(z.y));
    o.z = pk2(s[4] * inv - bflo(z.z), s[5] * inv - bfhi(z.z)); o.w = pk2(s[6] * inv - bflo(z.w), s[7] * inv - bfhi(z.w));
    Af[kk] = __builtin_bit_cast(bf16x8, o);
  }
  const bf16_t* Wp = (const bf16_t*)(ws + OFF_W) + (size_t)layer * W_LAYER + W_P + (size_t)g * 16384;
  bf16_t* yc = (bf16_t*)(ws + OFF_YS) + (size_t)2 * T_ALL * 512;
#pragma unroll
  for (int nb = 0; nb < 4; ++nb) {
    f32x16 acc;
#pragma unroll
    for (int i = 0; i < 16; ++i) acc[i] = 0.f;
#pragma unroll
    for (int kk = 0; kk < 8; ++kk) { const bf16x8 Bf = *(const GAS bf16x8*)(Wp + (size_t)(nb * 32 + r32) * 128 + h * 8 + 16 * kk); acc = MFMA32(Af[kk], Bf, acc); }
    const int dcol = g * 128 + nb * 32 + r32;
    const float sc = gldf(p.in[28] + layer * 512 + dcol);
#pragma unroll
    for (int i = 0; i < 16; ++i) { const int row = 8 * (i >> 2) + 4 * h + (i & 3); *(GAS bf16_t*)(yc + (size_t)(t0 + row) * 512 + dcol) = (bf16_t)(pk2(acc[i] * sc, 0.f) & 0xffffu); }
  }
}
DI void pool_item(const Ctx& p, int layer, int item) {
  const int tid = opaque_tid(), lane = tid & 63, wave = __builtin_amdgcn_readfirstlane(tid >> 6);
  const int wi = item * 8 + wave, tt = wi >> 2, g = wi & 3, t0 = tt * 32;
  if (g == 0) pool_body<2>(p, layer, 0, t0, lane);
  else if (g == 1) pool_body<4>(p, layer, 1, t0, lane);
  else if (g == 2) pool_body<8>(p, layer, 2, t0, lane);
  else pool_body<16>(p, layer, 3, t0, lane);
}

DI void mixer_item(const Ctx& p, int layer, int it, LAS unsigned char* lds) {
  if (it < 128) s5_item(p, layer, true, it >> 5, it & 31, lds);
  else if (it < 192) { const int j = it - 128; s5_item(p, layer, false, j >> 3, j & 7, lds); }
  else if (it < 448) { const int j = it - 192; attn_item(p, layer, true, j >> 5, (j >> 3) & 3, j & 7, lds); }
  else if (it < 576) { const int j = it - 448; attn_item(p, layer, false, j >> 3, (j >> 1) & 3, j & 1, lds); }
  else pool_item(p, layer, it - 576);
}
DI void mixer_phase(const Ctx& p, int layer, LAS unsigned char* lds) {
  constexpr int NIT = 576 + 192;
  const int Gd = gridDim.x, w = blockIdx.x;
  for (int r = 0;; ++r) {
    const int it = r * Gd + ((r & 1) ? Gd - 1 - w : w);
    if (r * Gd >= NIT) break;
    if (it < NIT) mixer_item(p, layer, it, lds);
  }
}

#define XB_TMO      128
#define XB_XCNT(j)  (256  + 64 * (j))
#define XB_XSUB(j)  (1280 + 64 * (j))
#define XB_XGEN(j)  (2304 + 64 * (j))
#define XB_TOP      3328
#define XB_TOPGEN   3392
#define XCD_BAR_WORDS 3456
#define XB_SPIN_CAP (1u << 22)
DI unsigned xb_ld(unsigned* p)              { return __hip_atomic_load(p, __ATOMIC_RELAXED, __HIP_MEMORY_SCOPE_AGENT); }
DI unsigned xb_add(unsigned* p, unsigned v) { return __hip_atomic_fetch_add(p, v, __ATOMIC_RELAXED, __HIP_MEMORY_SCOPE_AGENT); }
DI unsigned xb_xcc_id() { return (unsigned)__builtin_amdgcn_s_getreg((3 << 11) | 20) & 0xFu; }
#define XB_SPIN(cond, bar) do { unsigned _sp = 0; while (cond) { __builtin_amdgcn_s_sleep(1); \
    if ((++_sp & 255u) == 0u) { if (xb_ld(&(bar)[XB_TMO])) break; if (_sp > XB_SPIN_CAP) { atomicAdd(&(bar)[XB_TMO], 1u); break; } } } } while (0)
struct XcdBarrier { unsigned* bar; unsigned x; volatile LAS unsigned* st; };
DI XcdBarrier xcd_barrier_post(unsigned* bar, volatile LAS unsigned* st) {
  XcdBarrier b; b.bar = bar; b.x = xb_xcc_id(); b.st = st;
  if (threadIdx.x == 0) (void)xb_add(&bar[XB_XCNT(b.x)], 1u);
  return b;
}
DI void xcd_barrier_complete(unsigned* bar, unsigned x, unsigned& nloc, unsigned& nx) {
  const unsigned G = gridDim.x * gridDim.y * gridDim.z;
  unsigned sum, cnt, mine, sp = 0u;
  for (;;) {
    sum = 0u; cnt = 0u; mine = 0u;
#pragma unroll
    for (unsigned j = 0; j < 16; ++j) { const unsigned c = xb_ld(&bar[XB_XCNT(j)]); sum += c; cnt += (c > 0u) ? 1u : 0u; mine = (j == x) ? c : mine; }
    if (sum == G) break;
    __builtin_amdgcn_s_sleep(1);
    if ((++sp & 255u) == 0u) { if (xb_ld(&bar[XB_TMO])) break; if (sp > XB_SPIN_CAP) { atomicAdd(&bar[XB_TMO], 1u); break; } }
  }
  nloc = mine > 0u ? mine : 1u; nx = cnt > 0u ? cnt : 1u;
}
DI void xcd_barrier(const XcdBarrier& b) {
  asm volatile("s_waitcnt vmcnt(0)" ::: "memory");
  __syncthreads();
  if (threadIdx.x == 0) {
    unsigned* bar = b.bar;
    __builtin_amdgcn_s_waitcnt(0);
    unsigned nloc = b.st[0], nx = b.st[1];
    if (nloc == 0u) { xcd_barrier_complete(bar, b.x, nloc, nx); b.st[0] = nloc; b.st[1] = nx; }
    const unsigned old = xb_add(&bar[XB_XSUB(b.x)], 1u);
    const unsigned gen = old / nloc;
    if (old + 1u == (gen + 1u) * nloc) {
      __builtin_amdgcn_fence(__ATOMIC_RELEASE, "agent");
      asm volatile("s_waitcnt vmcnt(0)" ::: "memory");
      const unsigned og = xb_add(&bar[XB_TOP], 1u);
      const unsigned tg = og / nx;
      if (og + 1u == (tg + 1u) * nx) xb_add(&bar[XB_TOPGEN], 1u);
      else XB_SPIN(xb_ld(&bar[XB_TOPGEN]) == tg, bar);
      __builtin_amdgcn_fence(__ATOMIC_ACQUIRE, "agent");
      xb_add(&bar[XB_XGEN(b.x)], 1u);
      asm volatile("s_waitcnt vmcnt(0)" ::: "memory");
    } else {
      XB_SPIN(xb_ld(&bar[XB_XGEN(b.x)]) == gen, bar);
      __builtin_amdgcn_fence(__ATOMIC_ACQUIRE, "agent");
      asm volatile("s_waitcnt vmcnt(0)" ::: "memory");
    }
  }
  __syncthreads();
}

__global__ void __launch_bounds__(512, 2) fwd_megakernel(Params p0) {
  extern __shared__ __attribute__((aligned(16))) unsigned char shm[];
  LAS unsigned char* lds = (LAS unsigned char*)shm;
  const int G = gridDim.x, c = blockIdx.x;
  __shared__ uint4 xb_words;
  if (threadIdx.x == 0) xb_words = make_uint4(0u, 0u, 0u, 0u);
  __syncthreads();
  const XcdBarrier xb = xcd_barrier_post((unsigned*)(p0.ws + OFF_BAR), (volatile LAS unsigned*)&xb_words);
  for (int phi = p0.ph_lo; phi < p0.ph_hi; ++phi) {
    int ph = phi; asm volatile("" : "+s"(ph));
    Ctx p; p.in.pp = &p0; p.out = p0.out; p.ws = p0.ws;
    asm volatile("" : "+s"(p.out)); asm volatile("" : "+s"(p.ws));
    unsigned char* ws = p.ws;
    if (ph == 0) prep_phase(p, lds);
    else if (ph == NPH - 1) norm_phase(p, 0, 0, false, true);
    else {
      const int layer = (ph - 1) / 12, s = (ph - 1) % 12;
      const bf16_t* wl = (const bf16_t*)(ws + OFF_W) + (size_t)layer * W_LAYER;
      const float* modl = (const float*)(ws + OFF_MOD) + (size_t)layer * 9 * 9216;
      bf16_t* Nb = (bf16_t*)(ws + OFF_N); bf16_t* UH = (bf16_t*)(ws + OFF_UH); float* X = (float*)(ws + OFF_X);
      if (s == 0) norm_phase(p, layer, 0, layer == 0, false);
      else if (s == 3) norm_phase(p, layer, 1, false, false);
      else if (s == 9) norm_phase(p, layer, 2, false, false);
      else if (s == 1 || s == 10) {
        const int f = s == 10;
        pg8::Gemm g{Nb, wl + W_FI + (size_t)f * 5632 * 1024, T_ALL, 5632, 1024};
        pg8::StaticOrder S; S.init(g.M, g.N, G, c);
        EpiSwiglu E{UH};
        pg8::gemm_phase(lds, g, S, E);
      } else if (s == 2 || s == 11) {
        const int f = s == 11;
        pg8::Gemm g{UH, wl + W_FO + (size_t)f * 1024 * 2816, T_ALL, 1024, 2816};
        pg8::StaticOrder S; S.init(g.M, g.N, G, c);
        EpiResid E{X, modl, f ? 8 : 2, 0.5f};
        pg8::gemm_phase(lds, g, S, E);
      } else if (s == 4) {
        pg8::Gemm g{Nb, wl + W_IN, T_ALL, 5632, 1024};
        pg8::StaticOrder S; S.init(g.M, g.N, G, c);
        EpiWin E{UH, (bf16_t*)(ws + OFF_Q), (bf16_t*)(ws + OFF_K), (bf16_t*)(ws + OFF_V), p.out + 12582912, p.out + 12582912 + 8388608, (const float*)(ws + OFF_ROPE), layer};
        pg8::gemm_phase(lds, g, S, E);
      } else if (s == 5) {
        mixer_phase(p, layer, lds);
      } else if (s == 6) {
        pg8::Gemm g{(const bf16_t*)(ws + OFF_YA), wl + W_GLU, T_ALL, 512, 512};
        pg8::StaticOrder S; S.init(g.M, g.N, G, c);
        EpiGlu E{(const bf16_t*)(ws + OFF_YA), (bf16_t*)(ws + OFF_YS)};
        pg8::gemm_phase(lds, g, S, E);
      } else if (s == 7) {
        pg8::Gemm g{(const bf16_t*)(ws + OFF_YS), wl + W_BR, 3 * T_ALL, 3072, 512};
        pg8::BranchOrder S{G, c};
        EpiBranch E{UH, (float*)(ws + OFF_YP), Nb};
        pg8::gemm_phase(lds, g, S, E);
      } else if (s == 8) {
        pg8::Gemm g{Nb, wl + W_OUT, T_ALL, 1024, 1024};
        pg8::StaticOrder S; S.init(g.M, g.N, G, c);
        EpiResid E{X, modl, 5, 1.0f};
        pg8::gemm_phase(lds, g, S, E);
      }
    }
    if (phi + 1 < p0.ph_hi) { if (phi == p0.ph_lo) cg::this_grid().sync(); else xcd_barrier(xb); }
  }
}

extern "C" void kernel_launch(void* const* d_in, const int* in_sizes, int n_in, void* d_out, int out_size, void* d_ws, size_t ws_size, hipStream_t stream) {
  static int grid = 0;
  if (grid == 0) {
    int dev = 0, cus = 0, per_cu = 0;
    hipGetDevice(&dev);
    hipDeviceGetAttribute(&cus, hipDeviceAttributeMultiprocessorCount, dev);
    if (hipFuncSetAttribute((const void*)fwd_megakernel, hipFuncAttributeMaxDynamicSharedMemorySize, LDS_BYTES) != hipSuccess) fprintf(stderr, "hipFuncSetAttribute failed\n");
    hipOccupancyMaxActiveBlocksPerMultiprocessor(&per_cu, (const void*)fwd_megakernel, 512, LDS_BYTES);
    if (per_cu < 1) { fprintf(stderr, "occupancy query gave %d\n", per_cu); per_cu = 1; }
    (void)hipGetLastError();
    grid = cus * per_cu;
    if (ws_size < WS_END) fprintf(stderr, "workspace too small: %zu\n", ws_size);
  }
  if (hipMemsetAsync((unsigned char*)d_ws + OFF_BAR, 0, 16384, stream) != hipSuccess) fprintf(stderr, "memset failed\n");
  Params p{};
  for (int i = 0; i < 32; ++i) p.in[i] = (const float*)d_in[i];
  p.out = (float*)d_out; p.ws = (unsigned char*)d_ws;
#if COOP
  p.ph_lo = 0; p.ph_hi = NPH;
  void* args[] = {&p};
  hipError_t e = hipLaunchCooperativeKernel((const void*)fwd_megakernel, dim3(grid), dim3(512), args, LDS_BYTES, stream);
  if (e != hipSuccess) fprintf(stderr, "cooperative launch failed: %s (grid %d)\n", hipGetErrorString(e), grid);
#else
  for (int ph = 0; ph < NPH; ++ph) {
    p.ph_lo = ph; p.ph_hi = ph + 1;
    hipLaunchKernelGGL(fwd_megakernel, dim3(grid), dim3(512), LDS_BYTES, stream, p);
  }
#endif
}
```

```cpp
#include <hip/hip_runtime.h>
#include <hip/hip_cooperative_groups.h>
#include <cstdio>
namespace cg = cooperative_groups;

#ifndef COOP
#define COOP 1
#endif

#define LAS __attribute__((address_space(3)))
#define GAS __attribute__((address_space(1)))
typedef unsigned short bf16_t;
typedef short bf16x8 __attribute__((ext_vector_type(8)));
typedef short s16x4 __attribute__((ext_vector_type(4)));
typedef float f32x2 __attribute__((ext_vector_type(2)));
typedef float f32x4 __attribute__((ext_vector_type(4)));
typedef float f32x16 __attribute__((ext_vector_type(16)));
typedef unsigned u32x4 __attribute__((ext_vector_type(4)));
typedef unsigned u32x2 __attribute__((ext_vector_type(2)));
typedef __bf16 nbf16x2 __attribute__((ext_vector_type(2)));
#define DI __device__ __forceinline__

constexpr int T_CTX = 4096, T_ALL = 12288, DM = 1024, DFF = 2816, INW = 5632, NPH = 50;
constexpr size_t OFF_X = 0;
constexpr size_t OFF_N = OFF_X + 50331648;
constexpr size_t OFF_UH = OFF_N + 25165824;
constexpr size_t OFF_Q = OFF_UH + 138412032;
constexpr size_t OFF_K = OFF_Q + 12582912;
constexpr size_t OFF_V = OFF_K + 12582912;
constexpr size_t OFF_KC = OFF_V + 12582912;
constexpr size_t OFF_VC = OFF_KC + 16777216;
constexpr size_t OFF_YP = OFF_VC + 16777216;
constexpr size_t OFF_YA = OFF_YP + 50331648;
constexpr size_t OFF_YS = OFF_YA + 12582912;
constexpr size_t OFF_MOD = OFF_YS + 37748736;
constexpr size_t OFF_BB = OFF_MOD + 1327104;
constexpr size_t OFF_CM = OFF_BB + 1048576;
constexpr size_t OFF_AT = OFF_CM + 1048576;
constexpr size_t OFF_ROPE = OFF_AT + 131072;
constexpr size_t OFF_LAM = OFF_ROPE + 262144;
constexpr size_t OFF_W = OFF_LAM + 256;
constexpr size_t W_FI = 0;
constexpr size_t W_FO = W_FI + 11534336;
constexpr size_t W_IN = W_FO + 5767168;
constexpr size_t W_GLU = W_IN + 5767168;
constexpr size_t W_BR = W_GLU + 262144;
constexpr size_t W_OUT = W_BR + 1572864;
constexpr size_t W_P = W_OUT + 1048576;
constexpr size_t W_LAYER = W_P + 65536;
constexpr size_t OFF_BAR = OFF_W + 4 * W_LAYER * 2;
constexpr size_t WS_END = OFF_BAR + 16384;
constexpr int LDS_BYTES = 131072;

struct Params {
  const float* in[32];
  float* out;
  unsigned char* ws;
  int ph_lo, ph_hi;
};
struct InTab { const Params* pp; __device__ __forceinline__ const float* operator[](int i) const { asm volatile("" : "+s"(i)); return pp->in[i]; } };
struct Ctx { InTab in; float* out; unsigned char* ws; };

DI int opaque_tid() { int t = threadIdx.x; asm volatile("" : "+v"(t)); return t; }
DI unsigned pk2(float lo, float hi) { f32x2 v = {lo, hi}; nbf16x2 b = __builtin_convertvector(v, nbf16x2); return __builtin_bit_cast(unsigned, b); }
DI float gldf(const float* p) { return *(const GAS float*)p; }
DI void gstf(float* p, float v) { *(GAS float*)p = v; }
DI float bf2f(unsigned short b) { return __uint_as_float(((unsigned)b) << 16); }
DI float bflo(unsigned u) { return __uint_as_float(u << 16); }
DI float bfhi(unsigned u) { return __uint_as_float(u & 0xffff0000u); }
DI float sigmoidf_(float x) { return __builtin_amdgcn_rcpf(1.f + __expf(-x)); }
DI float wave_sum(float v) {
#pragma unroll
  for (int o = 1; o < 64; o <<= 1) v += __shfl_xor(v, o);
  return v;
}
#define LDS_WAIT() asm volatile("s_waitcnt lgkmcnt(0)" ::: "memory")

namespace pg8 {
constexpr int BM = 256, BK = 64, HALF = 128, HTB = HALF * BK * 2, NXCD = 8, WGM = 8;
DI int lds_byte(int r, int c) { const int st = (r >> 4) * 2 + (c >> 5), rr = r & 15, cc = c & 31, ob = rr * 64 + cc * 2; return st * 1024 + (ob ^ (((ob >> 9) & 1) << 5)); }
DI void stage_rc(int b, int& R, int& C) { const int st = b / 1024, sb = b % 1024, swz = sb ^ (((sb >> 9) & 1) << 5); R = (st >> 1) * 16 + swz / 64; C = (st & 1) * 32 + (swz % 64) / 2; }
struct Unit { int pm, pn; };
struct Gemm { const bf16_t* A; const bf16_t* Bt; int M, N, K; };
struct StaticOrder {
  int nM, nN, nwg, G, c;
  DI void init(int M, int N, int G_, int c_) { nM = M / BM; nN = N / BM; nwg = nM * nN; G = G_; c = c_; }
  DI bool next(int i, Unit& u) const {
    const long L = (long)i * G + c; if (L >= nwg) return false;
    int wgid = (int)L; { const int q = nwg / NXCD, r = nwg % NXCD, xcd = wgid % NXCD, off = wgid / NXCD; wgid = (xcd < r ? xcd * (q + 1) : r * (q + 1) + (xcd - r) * q) + off; }
    const int nig = WGM * nN, gid = wgid / nig, fm = gid * WGM, gsz = (nM - fm) < WGM ? (nM - fm) : WGM;
    u.pm = fm + ((wgid % nig) % gsz); u.pn = (wgid % nig) / gsz; return true;
  }
};
struct BranchOrder {
  int G, c;
  DI bool next(int i, Unit& u) const { const int tile = (i / 3) * G + c; if (tile >= 192) return false; const int n = i % 3; u.pm = n * 48 + (tile >> 2); u.pn = n * 4 + (tile & 3); return true; }
};

template <class Epi, class Sched>
DI void gemm_phase(LAS unsigned char* lds, const Gemm g, const Sched& S, const Epi& E) {
  const int tid = opaque_tid(), wid = __builtin_amdgcn_readfirstlane(tid >> 6), lane = tid & 63, wr = wid >> 2, wc = wid & 3, fr = lane & 15, fq = lane >> 4;
  const int K = g.K, nt = K / BK;
  unsigned voffA[2], voffB[2];
#pragma unroll
  for (int i = 0; i < 2; ++i) { int R, C; stage_rc(tid * 16 + i * 8192, R, C); voffA[i] = (unsigned)(R * K + C) * 2u; voffB[i] = voffA[i]; }
  const size_t kstep = (size_t)(BK * 2);
  const size_t hstep = (size_t)HALF * K * 2;
  const size_t tstep = 2 * hstep;
  const unsigned ldsw = (unsigned)wid * 1024u;
  const int aoff = lds_byte(wr * 64 + fr, fq * 8), boff = lds_byte(wc * 32 + fr, fq * 8);
#define PG8_SA(b, h) (((b) * 2 + (h)) * HTB)
#define PG8_SB(b, h) ((4 + (b) * 2 + (h)) * HTB)
#define PG8_STAGE(bufoff, gbase, voff) do { _Pragma("unroll") for (int _i = 0; _i < 2; ++_i) \
    __builtin_amdgcn_global_load_lds((const unsigned*)((const char*)(gbase) + (voff)[_i]), (LAS unsigned*)(lds + (bufoff) + ldsw + _i * 8192), 16, 0, 0); } while (0)
#define PG8_LDA(dst, b, h) do { _Pragma("unroll") for (int m = 0; m < 4; ++m) _Pragma("unroll") for (int k = 0; k < 2; ++k) dst[m][k] = *(const LAS bf16x8*)(lds + PG8_SA(b, h) + aoff + m * 2048 + k * 1024); } while (0)
#define PG8_LDB(dst, b, h) do { _Pragma("unroll") for (int n = 0; n < 2; ++n) _Pragma("unroll") for (int k = 0; k < 2; ++k) dst[n][k] = *(const LAS bf16x8*)(lds + PG8_SB(b, h) + boff + n * 2048 + k * 1024); } while (0)
#define PG8_MMA(ai, bj, At, Bt) do { __builtin_amdgcn_s_setprio(1); _Pragma("unroll") for (int m = 0; m < 4; ++m) _Pragma("unroll") for (int n = 0; n < 2; ++n) _Pragma("unroll") for (int k = 0; k < 2; ++k) \
    acc[ai][bj][m][n] = __builtin_amdgcn_mfma_f32_16x16x32_bf16(Bt[n][k], At[m][k], acc[ai][bj][m][n], 0, 0, 0); __builtin_amdgcn_s_setprio(0); } while (0)
#define PG8_WAIT_V(n) asm volatile("s_waitcnt vmcnt(" #n ")" ::: "memory")
#define PG8_WAIT_L(n) asm volatile("s_waitcnt lgkmcnt(" #n ")" ::: "memory")
#define PG8_BAR __builtin_amdgcn_s_barrier()
#define PG8_SCHED __builtin_amdgcn_sched_barrier(0)
  Unit cur, nxt; int ui = 0;
  if (!S.next(0, cur)) return;
  f32x4 acc[2][2][4][2];
#pragma unroll
  for (int a = 0; a < 2; ++a)
#pragma unroll
    for (int b = 0; b < 2; ++b)
#pragma unroll
      for (int m = 0; m < 4; ++m)
#pragma unroll
        for (int n = 0; n < 2; ++n) acc[a][b][m][n] = (f32x4){0.f, 0.f, 0.f, 0.f};
  bf16x8 At[4][2], B0[2][2], B1[2][2];
  const char* cA = (const char*)g.A + (size_t)cur.pm * tstep; const char* cB = (const char*)g.Bt + (size_t)cur.pn * tstep;
  PG8_STAGE(PG8_SB(0, 0), cB, voffB); PG8_STAGE(PG8_SA(0, 0), cA, voffA); PG8_STAGE(PG8_SB(0, 1), cB + hstep, voffB); PG8_STAGE(PG8_SA(0, 1), cA + hstep, voffA);
  if (wr == 1) PG8_BAR;
  PG8_WAIT_V(4); PG8_BAR;
  PG8_STAGE(PG8_SB(1, 0), cB + kstep, voffB); PG8_STAGE(PG8_SA(1, 0), cA + kstep, voffA); PG8_STAGE(PG8_SB(1, 1), cB + hstep + kstep, voffB);
  PG8_WAIT_V(6); PG8_BAR;
  for (;;) {
    const bool has_next = S.next(ui + 1, nxt);
    const char* nA = has_next ? (const char*)g.A + (size_t)nxt.pm * tstep : cA; const char* nB = has_next ? (const char*)g.Bt + (size_t)nxt.pn * tstep : cB;
    for (int t = 0; t < nt; t += 2) {
      const bool last = (t == nt - 2);
      const char* a1 = cA + (size_t)(t + 1) * kstep;
      const char* a2 = last ? nA : cA + (size_t)(t + 2) * kstep; const char* b2 = last ? nB : cB + (size_t)(t + 2) * kstep;
      const char* a3 = a2 + kstep; const char* b3 = b2 + kstep;
      PG8_LDB(B0, 0, 0); PG8_SCHED; PG8_LDA(At, 0, 0); PG8_STAGE(PG8_SA(1, 1), a1 + hstep, voffA);
      PG8_WAIT_L(8); PG8_BAR; PG8_WAIT_L(0); PG8_MMA(0, 0, At, B0); PG8_BAR; PG8_SCHED;
      PG8_LDB(B1, 0, 1); PG8_STAGE(PG8_SB(0, 0), b2, voffB);
      PG8_BAR; PG8_WAIT_L(0); PG8_MMA(0, 1, At, B1); PG8_BAR;
      PG8_LDA(At, 0, 1); PG8_STAGE(PG8_SA(0, 0), a2, voffA);
      PG8_BAR; PG8_WAIT_L(0); PG8_MMA(1, 0, At, B0); PG8_BAR; PG8_SCHED;
      PG8_STAGE(PG8_SB(0, 1), b2 + hstep, voffB);
      PG8_WAIT_V(6); PG8_BAR; PG8_MMA(1, 1, At, B1); PG8_BAR;
      PG8_LDB(B0, 1, 0); PG8_SCHED; PG8_LDA(At, 1, 0); PG8_STAGE(PG8_SA(0, 1), a2 + hstep, voffA);
      PG8_WAIT_L(8); PG8_BAR; PG8_WAIT_L(0); PG8_MMA(0, 0, At, B0); PG8_BAR; PG8_SCHED;
      PG8_LDB(B1, 1, 1); PG8_STAGE(PG8_SB(1, 0), b3, voffB);
      PG8_BAR; PG8_WAIT_L(0); PG8_MMA(0, 1, At, B1); PG8_BAR;
      PG8_LDA(At, 1, 1); PG8_STAGE(PG8_SA(1, 0), a3, voffA);
      PG8_BAR; PG8_WAIT_L(0); PG8_MMA(1, 0, At, B0); PG8_BAR; PG8_SCHED;
      PG8_STAGE(PG8_SB(1, 1), b3 + hstep, voffB);
      PG8_WAIT_V(6); PG8_BAR; PG8_MMA(1, 1, At, B1); PG8_BAR;
    }
    E(acc, cur, wr, wc, fr, fq);
    if (!has_next) break;
#pragma unroll
    for (int a = 0; a < 2; ++a)
#pragma unroll
      for (int b = 0; b < 2; ++b)
#pragma unroll
        for (int m = 0; m < 4; ++m)
#pragma unroll
          for (int n = 0; n < 2; ++n) acc[a][b][m][n] = (f32x4){0.f, 0.f, 0.f, 0.f};
    cur = nxt; cA = nA; cB = nB; ++ui;
  }
  PG8_WAIT_V(0);
  if (wr == 0) PG8_BAR;
  PG8_BAR;
#undef PG8_SA
#undef PG8_SB
#undef PG8_STAGE
#undef PG8_LDA
#undef PG8_LDB
#undef PG8_MMA
#undef PG8_WAIT_V
#undef PG8_WAIT_L
#undef PG8_BAR
#undef PG8_SCHED
}
}
using pg8::Unit;

typedef f32x4 AccT[2][2][4][2];
DI void st_bf4(bf16_t* p, f32x4 v) { u32x2 w; w.x = pk2(v[0], v[1]); w.y = pk2(v[2], v[3]); *(GAS u32x2*)p = w; }
DI f32x4 ld_bf4(const bf16_t* p) { const u32x2 w = *(const GAS u32x2*)p; return (f32x4){bflo(w.x), bfhi(w.x), bflo(w.y), bfhi(w.y)}; }

struct EpiSwiglu {
  bf16_t* H;
  DI void operator()(const AccT& acc, const Unit& u, int wr, int wc, int fr, int fq) const {
    const int row0 = u.pm * 256 + wr * 64 + fr, col0 = u.pn * 128 + wc * 32 + 4 * fq;
#pragma unroll
    for (int ai = 0; ai < 2; ++ai)
#pragma unroll
      for (int m = 0; m < 4; ++m) {
        bf16_t* rowp = H + (size_t)(row0 + ai * 128 + m * 16) * DFF + col0;
#pragma unroll
        for (int n = 0; n < 2; ++n) {
          const f32x4 a = acc[ai][0][m][n], b = acc[ai][1][m][n]; f32x4 h;
#pragma unroll
          for (int j = 0; j < 4; ++j) h[j] = a[j] * sigmoidf_(a[j]) * b[j];
          st_bf4(rowp + n * 16, h);
        }
      }
  }
};
struct EpiResid {
  float* X; const float* modl; int gate_idx; float coef;
  DI void operator()(const AccT& acc, const Unit& u, int wr, int wc, int fr, int fq) const {
    const int mrow = u.pm < 16 ? 8 : ((u.pm - 16) >> 2);
    const int row0 = u.pm * 256 + wr * 64 + fr, col0 = u.pn * 256 + wc * 32 + 4 * fq;
    const float* gp = modl + (size_t)mrow * 9216 + gate_idx * 1024 + col0;
    f32x4 gv[2][2];
#pragma unroll
    for (int bj = 0; bj < 2; ++bj)
#pragma unroll
      for (int n = 0; n < 2; ++n) gv[bj][n] = *(const GAS f32x4*)(gp + bj * 128 + n * 16) * coef;
#pragma unroll
    for (int ai = 0; ai < 2; ++ai) {
      f32x4 xv[4][2][2];
#pragma unroll
      for (int m = 0; m < 4; ++m)
#pragma unroll
        for (int bj = 0; bj < 2; ++bj)
#pragma unroll
          for (int n = 0; n < 2; ++n) xv[m][bj][n] = *(const GAS f32x4*)(X + (size_t)(row0 + ai * 128 + m * 16) * DM + col0 + bj * 128 + n * 16);
#pragma unroll
      for (int m = 0; m < 4; ++m)
#pragma unroll
        for (int bj = 0; bj < 2; ++bj)
#pragma unroll
          for (int n = 0; n < 2; ++n) *(GAS f32x4*)(X + (size_t)(row0 + ai * 128 + m * 16) * DM + col0 + bj * 128 + n * 16) = xv[m][bj][n] + gv[bj][n] * acc[ai][bj][m][n];
    }
  }
};
struct EpiWin {
  bf16_t* U; bf16_t* Q; bf16_t* Kb; bf16_t* Vb; float* outk; float* outv; const float* rope; int layer;
  DI void operator()(const AccT& acc, const Unit& u, int wr, int wc, int fr, int fq) const {
    const int pn = u.pn, row0 = u.pm * 256 + wr * 64 + fr;
    const bool lat = u.pm >= 16;
    if (pn < 2 || pn >= 8) {
      const int col0 = pn * 256 + wc * 32 + 4 * fq;
#pragma unroll
      for (int ai = 0; ai < 2; ++ai)
#pragma unroll
        for (int m = 0; m < 4; ++m) {
          bf16_t* rowp = U + (size_t)(row0 + ai * 128 + m * 16) * INW + col0;
#pragma unroll
          for (int bj = 0; bj < 2; ++bj)
#pragma unroll
            for (int n = 0; n < 2; ++n) st_bf4(rowp + bj * 128 + n * 16, acc[ai][bj][m][n]);
        }
    } else if (pn < 6) {
      const bool isq = pn < 4;
      const int cq0 = (pn & 1) * 256 + wc * 32 + 4 * fq;
      const float scale = isq ? 0.125f * 1.4426950408889634f : 1.f;
      bf16_t* dstb = isq ? Q : Kb;
#pragma unroll
      for (int ai = 0; ai < 2; ++ai) {
        f32x4 csv[4], snv[4];
#pragma unroll
        for (int m = 0; m < 4; ++m) {
          csv[m] = (f32x4){1.f, 1.f, 1.f, 1.f}; snv[m] = (f32x4){0.f, 0.f, 0.f, 0.f};
          if (lat) {
            const int pos = (row0 + ai * 128 + m * 16 - T_CTX) & 1023;
            const float* rp = rope + (size_t)pos * 64 + ((wc & 1) * 16 + 4 * fq) * 2;
            const f32x4 r0 = *(const GAS f32x4*)rp, r1 = *(const GAS f32x4*)(rp + 4);
            csv[m] = (f32x4){r0[0], r0[2], r1[0], r1[2]}; snv[m] = (f32x4){r0[1], r0[3], r1[1], r1[3]};
          }
        }
#pragma unroll
        for (int m = 0; m < 4; ++m) {
          const int row = row0 + ai * 128 + m * 16;
          const f32x4 cs = csv[m], sn = snv[m];
#pragma unroll
          for (int bj = 0; bj < 2; ++bj) {
            const f32x4 y1 = acc[ai][bj][m][0], y2 = acc[ai][bj][m][1];
            const f32x4 o1 = y1 * cs - y2 * sn, o2 = y2 * cs + y1 * sn;
            bf16_t* d = dstb + (size_t)row * 512 + cq0 + bj * 128;
            st_bf4(d, o1 * scale); st_bf4(d + 16, o2 * scale);
            if (!isq && !lat) {
              float* o = outk + ((size_t)((row >> 8) * 4 + layer) * 256 + (row & 255)) * 512 + cq0 + bj * 128;
              *(GAS f32x4*)o = o1; *(GAS f32x4*)(o + 16) = o2;
            }
          }
        }
      }
    } else {
      const int cv0 = (pn & 1) * 256 + wc * 32 + 4 * fq;
#pragma unroll
      for (int ai = 0; ai < 2; ++ai)
#pragma unroll
        for (int m = 0; m < 4; ++m) {
          const int row = row0 + ai * 128 + m * 16;
#pragma unroll
          for (int bj = 0; bj < 2; ++bj)
#pragma unroll
            for (int n = 0; n < 2; ++n) {
              st_bf4(Vb + (size_t)row * 512 + cv0 + bj * 128 + n * 16, acc[ai][bj][m][n]);
              if (!lat) *(GAS f32x4*)(outv + ((size_t)((row >> 8) * 4 + layer) * 256 + (row & 255)) * 512 + cv0 + bj * 128 + n * 16) = acc[ai][bj][m][n];
            }
        }
    }
  }
};
struct EpiGlu {
  const bf16_t* ya; bf16_t* ys0;
  DI void operator()(const AccT& acc, const Unit& u, int wr, int wc, int fr, int fq) const {
    const int row0 = u.pm * 256 + wr * 64 + fr, col0 = u.pn * 256 + wc * 32 + 4 * fq;
#pragma unroll
    for (int ai = 0; ai < 2; ++ai) {
      u32x2 yv[4][2][2];
#pragma unroll
      for (int m = 0; m < 4; ++m)
#pragma unroll
        for (int bj = 0; bj < 2; ++bj)
#pragma unroll
          for (int n = 0; n < 2; ++n) yv[m][bj][n] = *(const GAS u32x2*)(ya + (size_t)(row0 + ai * 128 + m * 16) * 512 + col0 + bj * 128 + n * 16);
#pragma unroll
      for (int m = 0; m < 4; ++m)
#pragma unroll
        for (int bj = 0; bj < 2; ++bj)
#pragma unroll
          for (int n = 0; n < 2; ++n) {
            const u32x2 w = yv[m][bj][n]; const f32x4 y = {bflo(w.x), bfhi(w.x), bflo(w.y), bfhi(w.y)}, a = acc[ai][bj][m][n]; f32x4 o;
#pragma unroll
            for (int j = 0; j < 4; ++j) o[j] = y[j] * sigmoidf_(a[j]);
            st_bf4(ys0 + (size_t)(row0 + ai * 128 + m * 16) * 512 + col0 + bj * 128 + n * 16, o);
          }
    }
  }
};
struct EpiBranch {
  const bf16_t* U; float* MRG; bf16_t* MERGED;
  DI void operator()(const AccT& acc, const Unit& u, int wr, int wc, int fr, int fq) const {
    const int n3 = u.pm / 48, pm = u.pm - n3 * 48, pn = u.pn & 3;
    const int row0 = pm * 256 + wr * 64 + fr, col0 = pn * 256 + wc * 32 + 4 * fq;
#pragma unroll
    for (int ai = 0; ai < 2; ++ai)
#pragma unroll
      for (int mh = 0; mh < 2; ++mh) {
        u32x2 gt[2][2][2]; f32x4 mv[2][2][2];
#pragma unroll
        for (int m2 = 0; m2 < 2; ++m2)
#pragma unroll
          for (int bj = 0; bj < 2; ++bj)
#pragma unroll
            for (int n = 0; n < 2; ++n) {
              const int row = row0 + ai * 128 + (mh * 2 + m2) * 16;
              gt[m2][bj][n] = *(const GAS u32x2*)(U + (size_t)row * INW + 2560 + n3 * 1024 + col0 + bj * 128 + n * 16);
              mv[m2][bj][n] = n3 ? *(const GAS f32x4*)(MRG + (size_t)row * DM + col0 + bj * 128 + n * 16) : (f32x4){0.f, 0.f, 0.f, 0.f};
            }
#pragma unroll
        for (int m2 = 0; m2 < 2; ++m2)
#pragma unroll
          for (int bj = 0; bj < 2; ++bj)
#pragma unroll
            for (int n = 0; n < 2; ++n) {
              const int row = row0 + ai * 128 + (mh * 2 + m2) * 16;
              const u32x2 w = gt[m2][bj][n]; const f32x4 gg = {bflo(w.x), bfhi(w.x), bflo(w.y), bfhi(w.y)}, a = acc[ai][bj][mh * 2 + m2][n]; f32x4 o;
#pragma unroll
              for (int j = 0; j < 4; ++j) o[j] = mv[m2][bj][n][j] + sigmoidf_(gg[j]) * a[j];
              if (n3 < 2) *(GAS f32x4*)(MRG + (size_t)row * DM + col0 + bj * 128 + n * 16) = o;
              else st_bf4(MERGED + (size_t)row * DM + col0 + bj * 128 + n * 16, o);
            }
      }
  }
};

struct TrItem { const float* W; bf16_t* WT; int K, N, swiglu, item; };
DI void tr_load(const TrItem& t, int lane, float (&v)[32]) {
  const int nblk = t.N / 32, kb = t.item / nblk, nb = t.item % nblk, k0 = 64 * kb, n0 = 32 * nb;
#pragma unroll
  for (int i = 0; i < 32; ++i) { const int kk = 2 * i + (lane >> 5); v[i] = gldf(t.W + (size_t)(k0 + kk) * t.N + n0 + (lane & 31)); }
}
DI void tr_finish(const TrItem& t, int lane, const float (&v)[32], LAS float* scr) {
  const int nblk = t.N / 32, kb = t.item / nblk, nb = t.item % nblk, k0 = 64 * kb, n0 = 32 * nb;
#pragma unroll
  for (int i = 0; i < 32; ++i) { const int kk = 2 * i + (lane >> 5); scr[kk * 33 + (lane & 31)] = v[i]; }
  LDS_WAIT();
  const int c = lane & 7;
#pragma unroll
  for (int j = 0; j < 4; ++j) {
    const int n = (lane >> 3) + 8 * j; const LAS float* s = scr + (8 * c) * 33 + n;
    u32x4 o; o.x = pk2(s[0 * 33], s[1 * 33]); o.y = pk2(s[2 * 33], s[3 * 33]); o.z = pk2(s[4 * 33], s[5 * 33]); o.w = pk2(s[6 * 33], s[7 * 33]);
    int dr = n0 + n;
    if (t.swiglu) { const int isb = dr >= DFF, hh = isb ? dr - DFF : dr; dr = (hh >> 7) * 256 + isb * 128 + (hh & 127); }
    *(GAS u32x4*)(t.WT + (size_t)dr * t.K + k0 + 8 * c) = o;
  }
  LDS_WAIT();
}
DI TrItem tr_decode(const Ctx& p, int it) {
  constexpr int I_FI = 16 * 176, I_FO = 44 * 32, I_IN = 16 * 176, I_GLU = 8 * 16, I_BR = 8 * 32, I_OUT = 16 * 32, I_P = 2 * 4;
  constexpr int I_LAYER = 2 * I_FI + 2 * I_FO + I_IN + I_GLU + 3 * I_BR + I_OUT + 4 * I_P;
  const int l = it / I_LAYER; int r = it % I_LAYER;
  bf16_t* wl = (bf16_t*)(p.ws + OFF_W) + (size_t)l * W_LAYER;
  TrItem t;
  if (r < 2 * I_FI) { const int s = r / I_FI; t = TrItem{p.in[10] + (size_t)(l * 2 + s) * 1024 * 5632, wl + W_FI + (size_t)s * 5632 * 1024, 1024, 5632, 1, r % I_FI}; return t; } r -= 2 * I_FI;
  if (r < 2 * I_FO) { const int s = r / I_FO; t = TrItem{p.in[11] + (size_t)(l * 2 + s) * 2816 * 1024, wl + W_FO + (size_t)s * 1024 * 2816, 2816, 1024, 0, r % I_FO}; return t; } r -= 2 * I_FO;
  if (r < I_IN) { t = TrItem{p.in[12] + (size_t)l * 1024 * 5632, wl + W_IN, 1024, 5632, 0, r}; return t; } r -= I_IN;
  if (r < I_GLU) { t = TrItem{p.in[21] + (size_t)l * 512 * 512, wl + W_GLU, 512, 512, 0, r}; return t; } r -= I_GLU;
  if (r < 3 * I_BR) { const int s = r / I_BR; t = TrItem{p.in[29] + (size_t)(l * 3 + s) * 512 * 1024, wl + W_BR + (size_t)s * 1024 * 512, 512, 1024, 0, r % I_BR}; return t; } r -= 3 * I_BR;
  if (r < I_OUT) { t = TrItem{p.in[30] + (size_t)l * 1024 * 1024, wl + W_OUT, 1024, 1024, 0, r}; return t; } r -= I_OUT;
  { const int s = r / I_P; t = TrItem{p.in[27] + (size_t)(l * 4 + s) * 128 * 128, wl + W_P + (size_t)s * 128 * 128, 128, 128, 0, r % I_P}; return t; }
}
constexpr int TR_ITEMS = 4 * (2 * 16 * 176 + 2 * 44 * 32 + 16 * 176 + 8 * 16 + 3 * 8 * 32 + 16 * 32 + 4 * 2 * 4);

DI void prep_phase(const Ctx& p, LAS unsigned char* lds) {
  const int tid = opaque_tid(), lane = tid & 63, wave = tid >> 6;
  unsigned char* ws = p.ws;
  for (int item = blockIdx.x; item < 144; item += gridDim.x) {
    const int l = item / 36, jc = item % 36;
    LAS float* sc = (LAS float*)lds;
    LAS float* red = sc + 9 * 1024;
    for (int i = tid; i < 9 * 1024; i += 512) { const int r = i >> 10, k = i & 1023; const float v = r < 8 ? gldf(p.in[5] + r * 1024 + k) : gldf(p.in[6] + k); sc[i] = v * sigmoidf_(v); }
    __syncthreads();
    const int j0 = jc * 256 + lane * 4;
    const float* w = p.in[8] + (size_t)l * 1024 * 9216 + (size_t)(wave * 128) * 9216 + j0;
    f32x4 acc[9];
#pragma unroll
    for (int r = 0; r < 9; ++r) acc[r] = (f32x4){0.f, 0.f, 0.f, 0.f};
    const LAS float* s0 = sc + wave * 128;
#pragma unroll 8
    for (int k = 0; k < 128; ++k) {
      const f32x4 wv = *(const GAS f32x4*)(w + (size_t)k * 9216);
#pragma unroll
      for (int r = 0; r < 9; ++r) acc[r] += wv * s0[r * 1024 + k];
    }
#pragma unroll
    for (int r = 0; r < 9; ++r) *(LAS f32x4*)(red + (wave * 9 + r) * 256 + lane * 4) = acc[r];
    __syncthreads();
    for (int o = tid; o < 9 * 256; o += 512) {
      const int r = o >> 8, col = o & 255; float s = 0.f;
#pragma unroll
      for (int w8 = 0; w8 < 8; ++w8) s += red[(w8 * 9 + r) * 256 + col];
      gstf((float*)(ws + OFF_MOD) + ((size_t)l * 9 + r) * 9216 + jc * 256 + col, s + gldf(p.in[9] + l * 9216 + jc * 256 + col));
    }
    __syncthreads();
  }
  {
    LAS float* scr = (LAS float*)(lds + wave * 8448);
    const int gw = blockIdx.x * 8 + wave, NGW = gridDim.x * 8;
    if (gw < TR_ITEMS) {
      TrItem cur = tr_decode(p, gw); float va[32], vb[32];
      tr_load(cur, lane, va);
      for (int it = gw; it < TR_ITEMS; it += 2 * NGW) {
        const bool h1 = it + NGW < TR_ITEMS, h2 = it + 2 * NGW < TR_ITEMS;
        TrItem nx = cur;
        if (h1) { nx = tr_decode(p, it + NGW); tr_load(nx, lane, vb); }
        tr_finish(cur, lane, va, scr);
        if (h1) {
          if (h2) { cur = tr_decode(p, it + 2 * NGW); tr_load(cur, lane, va); }
          tr_finish(nx, lane, vb, scr);
        }
      }
    }
  }
  const size_t gt = (size_t)blockIdx.x * 512 + tid, GT = (size_t)gridDim.x * 512;
  for (size_t i0 = gt; i0 < 2 * 1048576; i0 += 4 * GT) {
    f32x4 a[4], b[4];
#pragma unroll
    for (int q = 0; q < 4; ++q) {
      const size_t i = i0 + q * GT; if (i >= 2 * 1048576) { a[q] = (f32x4){0.f, 0.f, 0.f, 0.f}; b[q] = a[q]; continue; }
      const int which = i >= 1048576; const size_t e = (i & 1048575) * 8;
      const float* src = (which ? p.in[3] : p.in[2]) + e;
      a[q] = *(const GAS f32x4*)src; b[q] = *(const GAS f32x4*)(src + 4);
    }
#pragma unroll
    for (int q = 0; q < 4; ++q) {
      const size_t i = i0 + q * GT; if (i >= 2 * 1048576) continue;
      const int which = i >= 1048576; const size_t e = (i & 1048575) * 8;
      u32x4 o; o.x = pk2(a[q][0], a[q][1]); o.y = pk2(a[q][2], a[q][3]); o.z = pk2(b[q][0], b[q][1]); o.w = pk2(b[q][2], b[q][3]);
      *(GAS u32x4*)((bf16_t*)(ws + (which ? OFF_VC : OFF_KC)) + e) = o;
    }
  }
  for (size_t i = gt; i < 16384; i += GT) {
    const int pI = (int)(i & 63), ldg = (int)(i >> 6);
    const float lr = gldf(p.in[13] + i), li = gldf(p.in[14] + i), dt = expf(gldf(p.in[15] + ldg));
    const float mag = expf(lr * dt), abr = mag * cosf(li * dt), abi = mag * sinf(li * dt);
    const float den = lr * lr + li * li, nr = abr - 1.0f, kr = (nr * lr + abi * li) / den, ki = (abi * lr - nr * li) / den;
    float* at = (float*)(ws + OFF_AT) + i * 2; gstf(at, abr); gstf(at + 1, abi);
    bf16_t* bbp = (bf16_t*)(ws + OFF_BB) + (size_t)ldg * 2048;
    const float* bre = p.in[16] + i * 16; const float* bim = p.in[17] + i * 16;
    for (int c = 0; c < 16; c += 2) {
      const float br0 = gldf(bre + c), bi0 = gldf(bim + c), br1 = gldf(bre + c + 1), bi1 = gldf(bim + c + 1);
      *(GAS unsigned*)(bbp + (size_t)pI * 16 + c) = pk2(kr * br0 - ki * bi0, kr * br1 - ki * bi1);
      *(GAS unsigned*)(bbp + (size_t)(64 + pI) * 16 + c) = pk2(kr * bi0 + ki * br0, kr * bi1 + ki * br1);
    }
    bf16_t* cmp = (bf16_t*)(ws + OFF_CM) + (size_t)ldg * 2048;
    for (int c = 0; c < 16; ++c) {
      const float cr = gldf(p.in[18] + ((size_t)ldg * 16 + c) * 64 + pI), ci = gldf(p.in[19] + ((size_t)ldg * 16 + c) * 64 + pI);
      *(GAS unsigned*)(cmp + (size_t)c * 128 + 2 * pI) = pk2(cr, -ci);
    }
  }
  for (size_t i = gt; i < 32768; i += GT) {
    const int pos = (int)(i >> 5), j = (int)(i & 31);
    const float inv = powf(10000.0f, -(float)(j & 15) / 16.0f);
    const float ang = (float)(j < 16 ? (pos >> 6) : (pos & 63)) * inv;
    float* rp = (float*)(ws + OFF_ROPE) + i * 2; gstf(rp, cosf(ang)); gstf(rp + 1, sinf(ang));
  }
  if (gt < 4) {
    const int l = (int)gt; float s1 = 0.f, s2 = 0.f;
    for (int k = 0; k < 64; ++k) { s1 += gldf(p.in[22] + l * 64 + k) * gldf(p.in[23] + l * 64 + k); s2 += gldf(p.in[24] + l * 64 + k) * gldf(p.in[25] + l * 64 + k); }
    const float lam_init = 0.8f - 0.6f * expf(-0.3f * (float)l);
    gstf((float*)(ws + OFF_LAM) + l, expf(s1) - expf(s2) + lam_init);
  }
}

DI void norm_phase(const Ctx& p, int layer, int sub, bool first, bool final_) {
  const int tid = opaque_tid(), lane = tid & 63, wave = tid >> 6;
  float* X = (float*)(p.ws + OFF_X); bf16_t* Nb = (bf16_t*)(p.ws + OFF_N);
  const int gw = blockIdx.x * 8 + wave, NGW = gridDim.x * 8;
  f32x4 vn[4];
  {
    const int row = gw < T_ALL ? gw : 0;
    const float* src = first ? (row < T_CTX ? p.in[0] + (size_t)row * DM : p.in[1] + (size_t)(row - T_CTX) * DM) : X + (size_t)row * DM;
#pragma unroll
    for (int j = 0; j < 4; ++j) vn[j] = ((const GAS f32x4*)src)[lane + 64 * j];
  }
  for (int row = gw; row < T_ALL; row += NGW) {
    f32x4 v[4]; float ss = 0.f;
#pragma unroll
    for (int j = 0; j < 4; ++j) { v[j] = vn[j]; ss += (v[j][0] * v[j][0] + v[j][1] * v[j][1]) + (v[j][2] * v[j][2] + v[j][3] * v[j][3]); }
    {
      const int rown = row + NGW < T_ALL ? row + NGW : row;
      const float* src = first ? (rown < T_CTX ? p.in[0] + (size_t)rown * DM : p.in[1] + (size_t)(rown - T_CTX) * DM) : X + (size_t)rown * DM;
#pragma unroll
      for (int j = 0; j < 4; ++j) vn[j] = ((const GAS f32x4*)src)[lane + 64 * j];
    }
    const float rstd = 1.0f / sqrtf(wave_sum(ss) * (1.f / DM) + 1e-6f);
    if (final_) {
      const float* g = p.in[31];
#pragma unroll
      for (int j = 0; j < 4; ++j) { const f32x4 gv = ((const GAS f32x4*)g)[lane + 64 * j]; ((GAS f32x4*)(p.out + (size_t)row * DM))[lane + 64 * j] = v[j] * rstd * gv; }
    } else {
      const int mrow = row < T_CTX ? 8 : ((row - T_CTX) >> 10);
      const float* md = (const float*)(p.ws + OFF_MOD) + ((size_t)layer * 9 + mrow) * 9216;
      const float* sh = md + (3 * sub) * 1024; const float* sc = md + (3 * sub + 1) * 1024; const float* g = p.in[7] + (size_t)(layer * 3 + sub) * DM;
#pragma unroll
      for (int j = 0; j < 4; ++j) {
        const f32x4 gv = ((const GAS f32x4*)g)[lane + 64 * j], sv = ((const GAS f32x4*)sc)[lane + 64 * j], hv = ((const GAS f32x4*)sh)[lane + 64 * j];
        const f32x4 y = v[j] * rstd * gv * (sv + 1.f) + hv;
        st_bf4(Nb + (size_t)row * DM + (lane + 64 * j) * 4, y);
        if (first) ((GAS f32x4*)(X + (size_t)row * DM))[lane + 64 * j] = v[j];
      }
    }
  }
}

DI s16x4 tr_read(unsigned lds_addr) { s16x4 r; asm volatile("ds_read_b64_tr_b16 %0, %1\n\ts_waitcnt lgkmcnt(0)" : "=&v"(r) : "v"(lds_addr) : "memory"); return r; }
#define MFMA32(a, b, c) __builtin_amdgcn_mfma_f32_32x32x16_bf16((a), (b), (c), 0, 0, 0)
#define MFMA16(a, b, c) __builtin_amdgcn_mfma_f32_16x16x32_bf16((a), (b), (c), 0, 0, 0)

DI void attn_item(const Ctx& p, int layer, bool lat, int seq, int head, int qblk, LAS unsigned char* lds) {
  const int tid = opaque_tid(), lane = tid & 63, wave = tid >> 6, r16 = lane & 15, g4 = lane >> 4;
  unsigned char* ws = p.ws;
  const bf16_t* Qg = (const bf16_t*)(ws + OFF_Q); const bf16_t* Kg = (const bf16_t*)(ws + OFF_K); const bf16_t* Vg = (const bf16_t*)(ws + OFF_V);
  const int tok0 = lat ? T_CTX + seq * 1024 : seq * 256;
  const int n_own = lat ? 16 : 4, n_tiles = lat ? 24 : 4;
  const bf16_t* Kc = (const bf16_t*)(ws + OFF_KC) + (size_t)(seq * 4 + layer) * 512 * 512;
  const bf16_t* Vc = (const bf16_t*)(ws + OFF_VC) + (size_t)(seq * 4 + layer) * 512 * 512;
  constexpr int RS = 272;
  LAS unsigned char* Kt = lds; LAS unsigned char* Vt = lds + 64 * RS;
  const int qtok = tok0 + qblk * 128 + wave * 16 + r16;
  bf16x8 Qf[2][2];
#pragma unroll
  for (int m = 0; m < 2; ++m)
#pragma unroll
    for (int kk = 0; kk < 2; ++kk) Qf[m][kk] = *(const GAS bf16x8*)(Qg + (size_t)qtok * 512 + head * 128 + m * 64 + g4 * 8 + 32 * kk);
  u32x4 kreg[2], vreg[2];
  auto issue = [&](int kt) {
    const bf16_t* kb; const bf16_t* vb;
    if (kt < n_own) { kb = Kg + (size_t)(tok0 + kt * 64) * 512 + head * 128; vb = Vg + (size_t)(tok0 + kt * 64) * 512 + head * 128; }
    else { kb = Kc + (size_t)((kt - n_own) * 64) * 512 + head * 128; vb = Vc + (size_t)((kt - n_own) * 64) * 512 + head * 128; }
#pragma unroll
    for (int i = 0; i < 2; ++i) { const int ci = tid + 512 * i, row = ci >> 4, part = ci & 15; kreg[i] = *(const GAS u32x4*)(kb + (size_t)row * 512 + part * 8); vreg[i] = *(const GAS u32x4*)(vb + (size_t)row * 512 + part * 8); }
  };
  issue(0);
  f32x4 O[2][8];
#pragma unroll
  for (int m = 0; m < 2; ++m)
#pragma unroll
    for (int d = 0; d < 8; ++d) O[m][d] = (f32x4){0.f, 0.f, 0.f, 0.f};
  float mrun[2] = {-1e30f, -1e30f}, lsum[2] = {0.f, 0.f};
  const unsigned vbase = (unsigned)(size_t)Vt;
  const int tq = r16 >> 2, tp = r16 & 3;
  for (int kt = 0; kt < n_tiles; ++kt) {
    __syncthreads();
#pragma unroll
    for (int i = 0; i < 2; ++i) { const int ci = tid + 512 * i, row = ci >> 4, part = ci & 15; *(LAS u32x4*)(Kt + row * RS + part * 16) = kreg[i]; *(LAS u32x4*)(Vt + row * RS + part * 16) = vreg[i]; }
    __syncthreads();
    if (kt + 1 < n_tiles) issue(kt + 1);
    bf16x8 P[2][2];
#pragma unroll
    for (int m = 0; m < 2; ++m) {
      f32x4 S[4];
#pragma unroll
      for (int kb = 0; kb < 4; ++kb) {
        S[kb] = (f32x4){0.f, 0.f, 0.f, 0.f};
#pragma unroll
        for (int kk = 0; kk < 2; ++kk) { const bf16x8 Kf = *(const LAS bf16x8*)(Kt + (16 * kb + r16) * RS + m * 128 + (g4 * 8 + 32 * kk) * 2); S[kb] = MFMA16(Kf, Qf[m][kk], S[kb]); }
      }
      float mx = S[0][0];
#pragma unroll
      for (int kb = 0; kb < 4; ++kb)
#pragma unroll
        for (int j = 0; j < 4; ++j) mx = fmaxf(mx, S[kb][j]);
      mx = fmaxf(mx, __shfl_xor(mx, 16)); mx = fmaxf(mx, __shfl_xor(mx, 32));
      const float mnew = fmaxf(mrun[m], mx), alpha = __builtin_amdgcn_exp2f(mrun[m] - mnew);
      mrun[m] = mnew;
      float ps = 0.f;
#pragma unroll
      for (int kb = 0; kb < 4; ++kb)
#pragma unroll
        for (int j = 0; j < 4; ++j) { S[kb][j] = __builtin_amdgcn_exp2f(S[kb][j] - mnew); ps += S[kb][j]; }
      lsum[m] = lsum[m] * alpha + ps;
#pragma unroll
      for (int d = 0; d < 8; ++d) O[m][d] *= alpha;
#pragma unroll
      for (int s = 0; s < 2; ++s) {
        u32x4 w; w.x = pk2(S[2 * s][0], S[2 * s][1]); w.y = pk2(S[2 * s][2], S[2 * s][3]); w.z = pk2(S[2 * s + 1][0], S[2 * s + 1][1]); w.w = pk2(S[2 * s + 1][2], S[2 * s + 1][3]);
        P[m][s] = __builtin_bit_cast(bf16x8, w);
      }
    }
#pragma unroll
    for (int s = 0; s < 2; ++s) {
      s16x4 v0, v1, v2, v3, v4, v5, v6, v7, v8, v9, v10, v11, v12, v13, v14, v15;
      const unsigned a0 = vbase + (32 * s + 4 * g4 + tq) * RS + 8 * tp;
      asm volatile(
        "ds_read_b64_tr_b16 %0, %16\n\tds_read_b64_tr_b16 %1, %16 offset:4352\n\t"
        "ds_read_b64_tr_b16 %2, %16 offset:32\n\tds_read_b64_tr_b16 %3, %16 offset:4384\n\t"
        "ds_read_b64_tr_b16 %4, %16 offset:64\n\tds_read_b64_tr_b16 %5, %16 offset:4416\n\t"
        "ds_read_b64_tr_b16 %6, %16 offset:96\n\tds_read_b64_tr_b16 %7, %16 offset:4448\n\t"
        "ds_read_b64_tr_b16 %8, %16 offset:128\n\tds_read_b64_tr_b16 %9, %16 offset:4480\n\t"
        "ds_read_b64_tr_b16 %10, %16 offset:160\n\tds_read_b64_tr_b16 %11, %16 offset:4512\n\t"
        "ds_read_b64_tr_b16 %12, %16 offset:192\n\tds_read_b64_tr_b16 %13, %16 offset:4544\n\t"
        "ds_read_b64_tr_b16 %14, %16 offset:224\n\tds_read_b64_tr_b16 %15, %16 offset:4576\n\t"
        "s_waitcnt lgkmcnt(0)"
        : "=&v"(v0), "=&v"(v1), "=&v"(v2), "=&v"(v3), "=&v"(v4), "=&v"(v5), "=&v"(v6), "=&v"(v7),
          "=&v"(v8), "=&v"(v9), "=&v"(v10), "=&v"(v11), "=&v"(v12), "=&v"(v13), "=&v"(v14), "=&v"(v15)
        : "v"(a0) : "memory");
#define ATT_PV(d, lo, hi) { const bf16x8 Vf = __builtin_shufflevector(lo, hi, 0, 1, 2, 3, 4, 5, 6, 7); O[0][d] = MFMA16(Vf, P[0][s], O[0][d]); O[1][d] = MFMA16(Vf, P[1][s], O[1][d]); }
      ATT_PV(0, v0, v1) ATT_PV(1, v2, v3) ATT_PV(2, v4, v5) ATT_PV(3, v6, v7) ATT_PV(4, v8, v9) ATT_PV(5, v10, v11) ATT_PV(6, v12, v13) ATT_PV(7, v14, v15)
#undef ATT_PV
    }
  }
  float l1 = lsum[0], l2 = lsum[1];
  l1 += __shfl_xor(l1, 16); l1 += __shfl_xor(l1, 32); l2 += __shfl_xor(l2, 16); l2 += __shfl_xor(l2, 32);
  const float lam = gldf((const float*)(ws + OFF_LAM) + layer);
  const float lam_init = 0.8f - 0.6f * expf(-0.3f * (float)layer);
  const float c1 = 1.f / l1, c2 = lam / l2;
  float ss = 0.f;
#pragma unroll
  for (int d = 0; d < 8; ++d) { const f32x4 o = O[0][d] * c1 - O[1][d] * c2; O[0][d] = o; ss += (o[0] * o[0] + o[1] * o[1]) + (o[2] * o[2] + o[3] * o[3]); }
  ss += __shfl_xor(ss, 16); ss += __shfl_xor(ss, 32);
  const float rn = (1.f - lam_init) / sqrtf(ss * (1.f / 128.f) + 1e-6f);
  const float* ag = p.in[26] + layer * 128;
  bf16_t* yb = (bf16_t*)(ws + OFF_YS) + (size_t)T_ALL * 512 + (size_t)qtok * 512 + head * 128;
#pragma unroll
  for (int d = 0; d < 8; ++d) {
    const int dv = 16 * d + 4 * g4;
    const f32x4 gv = *(const GAS f32x4*)(ag + dv);
    st_bf4(yb + dv, O[0][d] * rn * gv);
  }
}

DI void s5_item(const Ctx& p, int layer, bool lat, int pairIdx, int gsel, LAS unsigned char* lds) {
  const int tid = opaque_tid(), lane = tid & 63, wave = __builtin_amdgcn_readfirstlane(tid >> 6), r32 = lane & 31, h = lane >> 5;
  unsigned char* ws = p.ws;
  const int d = wave & 1, g = lat ? gsel : gsel * 4 + (wave >> 1), chunk = lat ? (wave >> 1) : 0;
  const int L = lat ? 1024 : 256;
  constexpr int nt = 16;
  const int seq0 = pairIdx * 2;
  const int tb0 = (lat ? T_CTX + seq0 * 1024 : seq0 * 256) + chunk * 256;
  const int ldg = (layer * 2 + d) * 32 + g;
  const float* at = (const float*)(ws + OFF_AT) + (size_t)ldg * 128;
  const float a0r = gldf(at + r32 * 2), a0i = gldf(at + r32 * 2 + 1), a1r = gldf(at + (r32 + 32) * 2), a1i = gldf(at + (r32 + 32) * 2 + 1);
  float h0r = 0.f, h0i = 0.f, h1r = 0.f, h1i = 0.f;
  if (lat) {
    const float* st = p.in[4] + ((size_t)(((seq0 + h) * 4 + layer) * 2 + d) * 2) * 2048 + g * 64;
    h0r = gldf(st + r32); h1r = gldf(st + r32 + 32); h0i = gldf(st + 2048 + r32); h1i = gldf(st + 2048 + r32 + 32);
  }
  bf16x8 BBf[4], Cmf[4];
  {
    const bf16_t* bb = (const bf16_t*)(ws + OFF_BB) + (size_t)ldg * 2048;
    const bf16_t* cm = (const bf16_t*)(ws + OFF_CM) + (size_t)ldg * 2048;
#pragma unroll
    for (int b = 0; b < 4; ++b) { BBf[b] = *(const GAS bf16x8*)(bb + (size_t)(b * 32 + r32) * 16 + h * 8); Cmf[b] = *(const GAS bf16x8*)(cm + (size_t)(lane & 15) * 128 + (lane >> 4) * 8 + 32 * b); }
  }
  const bf16_t* U = (const bf16_t*)(ws + OFF_UH);
  float* YP = (float*)(ws + OFF_YP);
  bf16_t* YA = (bf16_t*)(ws + OFF_YA);
  const int sA = (r32 >> 2) & 1, iA = 4 * (r32 >> 3) + (r32 & 3);
  const bf16_t* uA = U + (size_t)(tb0 + sA * L + iA) * INW + g * 16 + h * 8;
  constexpr int RS = 272;
  LAS unsigned char* hb = lds + wave * (32 * RS);
  const f32x4 dsk = *(const GAS f32x4*)(p.in[20] + layer * 512 + g * 16 + (lane >> 4) * 4);
  __syncthreads();
  if (lat) {
    float e0r = 0.f, e0i = 0.f, e1r = 0.f, e1i = 0.f;
    const bool need = d == 0 ? chunk < 3 : chunk > 0;
    if (need) {
      bf16x8 Af1 = *(const GAS bf16x8*)(uA + (size_t)(d ? nt - 1 : 0) * 16 * INW);
      for (int n = 0; n < nt; ++n) {
        const int tile = d ? nt - 1 - n : n;
        const int tilen = (n + 1 < nt) ? (d ? tile - 1 : tile + 1) : tile;
        const bf16x8 Afn = *(const GAS bf16x8*)(uA + (size_t)tilen * 16 * INW);
        f32x16 x0, x1, x2, x3;
#pragma unroll
        for (int i = 0; i < 16; ++i) { x0[i] = 0.f; x1[i] = 0.f; x2[i] = 0.f; x3[i] = 0.f; }
        x0 = MFMA32(Af1, BBf[0], x0); x1 = MFMA32(Af1, BBf[1], x1); x2 = MFMA32(Af1, BBf[2], x2); x3 = MFMA32(Af1, BBf[3], x3);
#define S5_STEP1(i) { const float nr0 = a0r * e0r - a0i * e0i + x0[i], ni0 = a0r * e0i + a0i * e0r + x2[i]; e0r = nr0; e0i = ni0; \
                      const float nr1 = a1r * e1r - a1i * e1i + x1[i], ni1 = a1r * e1i + a1i * e1r + x3[i]; e1r = nr1; e1i = ni1; }
        if (d == 0) {
#pragma unroll
          for (int i = 0; i < 16; ++i) S5_STEP1(i)
        } else {
#pragma unroll
          for (int i = 15; i >= 0; --i) S5_STEP1(i)
        }
#undef S5_STEP1
        Af1 = Afn;
      }
    }
    LAS float* Eb = (LAS float*)(lds + 8 * 32 * RS);
    Eb[(wave * 4 + 0) * 64 + lane] = e0r; Eb[(wave * 4 + 1) * 64 + lane] = e0i; Eb[(wave * 4 + 2) * 64 + lane] = e1r; Eb[(wave * 4 + 3) * 64 + lane] = e1i;
    __syncthreads();
    float p0r = a0r, p0i = a0i, p1r = a1r, p1i = a1i;
#pragma unroll
    for (int q = 0; q < 8; ++q) { const float t0 = p0r * p0r - p0i * p0i, u0 = 2.f * p0r * p0i; p0r = t0; p0i = u0; const float t1 = p1r * p1r - p1i * p1i, u1 = 2.f * p1r * p1i; p1r = t1; p1i = u1; }
    const int nprev = d == 0 ? chunk : 3 - chunk;
    for (int q = 0; q < nprev; ++q) {
      const int j = d == 0 ? q : 3 - q, wj = j * 2 + d;
      const float f0r = Eb[(wj * 4 + 0) * 64 + lane], f0i = Eb[(wj * 4 + 1) * 64 + lane], f1r = Eb[(wj * 4 + 2) * 64 + lane], f1i = Eb[(wj * 4 + 3) * 64 + lane];
      const float n0r = p0r * h0r - p0i * h0i + f0r, n0i = p0r * h0i + p0i * h0r + f0i; h0r = n0r; h0i = n0i;
      const float n1r = p1r * h1r - p1i * h1i + f1r, n1i = p1r * h1i + p1i * h1r + f1i; h1r = n1r; h1i = n1i;
    }
  }
  bf16x8 Af = *(const GAS bf16x8*)(uA + (size_t)(d ? nt - 1 : 0) * 16 * INW);
  for (int n = 0; n < nt; ++n) {
    if (n == nt / 2) __syncthreads();
    const int tile = d ? nt - 1 - n : n;
    const int tilen = (n + 1 < nt) ? (d ? tile - 1 : tile + 1) : tile;
    const bf16x8 Afn = *(const GAS bf16x8*)(uA + (size_t)tilen * 16 * INW);
    const bool second = n >= nt / 2;
    f32x4 po[2] = {{0.f, 0.f, 0.f, 0.f}, {0.f, 0.f, 0.f, 0.f}}; u32x2 pu[2] = {{0u, 0u}, {0u, 0u}};
    if (second) {
#pragma unroll
      for (int ss = 0; ss < 2; ++ss) {
        const int tok = tb0 + ss * L + tile * 16 + (lane & 15), ch = g * 16 + (lane >> 4) * 4;
        po[ss] = *(const GAS f32x4*)(YP + ((size_t)(1 - d) * T_ALL + tok) * 512 + ch);
        pu[ss] = *(const GAS u32x2*)(U + (size_t)tok * INW + ch);
      }
    }
    f32x16 x0, x1, x2, x3;
#pragma unroll
    for (int i = 0; i < 16; ++i) { x0[i] = 0.f; x1[i] = 0.f; x2[i] = 0.f; x3[i] = 0.f; }
    x0 = MFMA32(Af, BBf[0], x0); x1 = MFMA32(Af, BBf[1], x1); x2 = MFMA32(Af, BBf[2], x2); x3 = MFMA32(Af, BBf[3], x3);
#define S5_STEP(i) { const float nr0 = a0r * h0r - a0i * h0i + x0[i], ni0 = a0r * h0i + a0i * h0r + x2[i]; h0r = nr0; h0i = ni0; \
                     const float nr1 = a1r * h1r - a1i * h1i + x1[i], ni1 = a1r * h1i + a1i * h1r + x3[i]; h1r = nr1; h1i = ni1; \
                     *(LAS unsigned*)(hb + (h * 16 + (i)) * RS + r32 * 4) = pk2(h0r, h0i); *(LAS unsigned*)(hb + (h * 16 + (i)) * RS + (r32 + 32) * 4) = pk2(h1r, h1i); }
    if (d == 0) {
#pragma unroll
      for (int i = 0; i < 16; ++i) S5_STEP(i)
    } else {
#pragma unroll
      for (int i = 15; i >= 0; --i) S5_STEP(i)
    }
#undef S5_STEP
    LDS_WAIT();
#pragma unroll
    for (int ss = 0; ss < 2; ++ss) {
      f32x4 y = {0.f, 0.f, 0.f, 0.f};
#pragma unroll
      for (int kb = 0; kb < 4; ++kb) { const bf16x8 Hf = *(const LAS bf16x8*)(hb + (ss * 16 + (lane & 15)) * RS + ((lane >> 4) * 8 + 32 * kb) * 2); y = MFMA16(Cmf[kb], Hf, y); }
      const int tok = tb0 + ss * L + tile * 16 + (lane & 15), ch = g * 16 + (lane >> 4) * 4;
      if (!second) {
        *(GAS f32x4*)(YP + ((size_t)d * T_ALL + tok) * 512 + ch) = y;
      } else {
        const f32x4 uu = {bflo(pu[ss].x), bfhi(pu[ss].x), bflo(pu[ss].y), bfhi(pu[ss].y)};
        f32x4 v = y + po[ss] + uu * dsk, r;
#pragma unroll
        for (int j = 0; j < 4; ++j) { const float t = v[j]; r[j] = t * sigmoidf_(1.5957691216057308f * (t + 0.044715f * t * t * t)); }
        st_bf4(YA + (size_t)tok * 512 + ch, r);
      }
    }
    LDS_WAIT();
    Af = Afn;
  }
  if (!lat) {
    float* so = p.out + 12582912 + 8388608 + 8388608 + ((size_t)(((seq0 + h) * 4 + layer) * 2 + d) * 2) * 2048 + g * 64;
    gstf(so + r32, h0r); gstf(so + r32 + 32, h1r); gstf(so + 2048 + r32, h0i); gstf(so + 2048 + r32 + 32, h1i);
  }
}

template <int W>
DI void pool_body(const Ctx& p, int layer, int g, int t0, int lane) {
  const int r32 = lane & 31, h = lane >> 5;
  unsigned char* ws = p.ws;
  const int t = t0 + r32;
  const int sbase = t < T_CTX ? (t & ~255) : T_CTX + ((t - T_CTX) & ~1023), L = t < T_CTX ? 256 : 1024, tl = t - sbase;
  int lo = tl - W / 2, hi = lo + W; lo = lo < 0 ? 0 : lo; hi = hi > L ? L : hi;
  const float inv = 1.f / (float)(hi - lo);
  const bf16_t* Z = (const bf16_t*)(ws + OFF_UH) + 2048 + g * 128 + h * 8;
  bf16x8 Af[8];
#pragma unroll
  for (int kk = 0; kk < 8; ++kk) {
    u32x4 zz[W]; float ff[W];
#pragma unroll
    for (int dt = 0; dt < W; ++dt) {
      const int tp = tl - W / 2 + dt; const bool ok = tp >= 0 && tp < L; const int tc = ok ? tp : tl; ff[dt] = ok ? 1.f : 0.f;
      zz[dt] = *(const GAS u32x4*)(Z + (size_t)(sbase + tc) * INW + 16 * kk);
    }
    float s[8];
#pragma unroll
    for (int j = 0; j < 8; ++j) s[j] = 0.f;
#pragma unroll
    for (int dt = 0; dt < W; ++dt) {
      const u32x4 z = zz[dt]; const float f = ff[dt];
      s[0] += f * bflo(z.x); s[1] += f * bfhi(z.x); s[2] += f * bflo(z.y); s[3] += f * bfhi(z.y); s[4] += f * bflo(z.z); s[5] += f * bfhi(z.z); s[6] += f * bflo(z.w); s[7] += f * bfhi(z.w);
    }
    const u32x4 z = zz[W / 2];
    u32x4 o;
    o.x = pk2(s[0] * inv - bflo(z.x), s[1] * inv - bfhi(z.x)); o.y = pk2(s[2] * inv - bflo(z.y), s[3] * inv - bfhi(z.y));
    o.z = pk2(s[4] * inv - bflo(z.z), s[5] * inv - bfhi(z.z)); o.w = pk2(s[6] * inv - bflo(z.w), s[7] * inv - bfhi(z.w));
    Af[kk] = __builtin_bit_cast(bf16x8, o);
  }
  const bf16_t* Wp = (const bf16_t*)(ws + OFF_W) + (size_t)layer * W_LAYER + W_P + (size_t)g * 16384;
  bf16_t* yc = (bf16_t*)(ws + OFF_YS) + (size_t)2 * T_ALL * 512;
#pragma unroll
  for (int nb = 0; nb < 4; ++nb) {
    f32x16 acc;
#pragma unroll
    for (int i = 0; i < 16; ++i) acc[i] = 0.f;
#pragma unroll
    for (int kk = 0; kk < 8; ++kk) { const bf16x8 Bf = *(const GAS bf16x8*)(Wp + (size_t)(nb * 32 + r32) * 128 + h * 8 + 16 * kk); acc = MFMA32(Af[kk], Bf, acc); }
    const int dcol = g * 128 + nb * 32 + r32;
    const float sc = gldf(p.in[28] + layer * 512 + dcol);
#pragma unroll
    for (int i = 0; i < 16; ++i) { const int row = 8 * (i >> 2) + 4 * h + (i & 3); *(GAS bf16_t*)(yc + (size_t)(t0 + row) * 512 + dcol) = (bf16_t)(pk2(acc[i] * sc, 0.f) & 0xffffu); }
  }
}
DI void pool_item(const Ctx& p, int layer, int item) {
  const int tid = opaque_tid(), lane = tid & 63, wave = __builtin_amdgcn_readfirstlane(tid >> 6);
  const int wi = item * 8 + wave, tt = wi >> 2, g = wi & 3, t0 = tt * 32;
  if (g == 0) pool_body<2>(p, layer, 0, t0, lane);
  else if (g == 1) pool_body<4>(p, layer, 1, t0, lane);
  else if (g == 2) pool_body<8>(p, layer, 2, t0, lane);
  else pool_body<16>(p, layer, 3, t0, lane);
}

DI void mixer_item(const Ctx& p, int layer, int it, LAS unsigned char* lds) {
  if (it < 128) s5_item(p, layer, true, it >> 5, it & 31, lds);
  else if (it < 192) { const int j = it - 128; s5_item(p, layer, false, j >> 3, j & 7, lds); }
  else if (it < 448) { const int j = it - 192; attn_item(p, layer, true, j >> 5, (j >> 3) & 3, j & 7, lds); }
  else if (it < 576) { const int j = it - 448; attn_item(p, layer, false, j >> 3, (j >> 1) & 3, j & 1, lds); }
  else pool_item(p, layer, it - 576);
}
DI void mixer_phase(const Ctx& p, int layer, LAS unsigned char* lds) {
  constexpr int NIT = 576 + 192;
  const int Gd = gridDim.x, w = blockIdx.x;
  for (int r = 0;; ++r) {
    const int it = r * Gd + ((r & 1) ? Gd - 1 - w : w);
    if (r * Gd >= NIT) break;
    if (it < NIT) mixer_item(p, layer, it, lds);
  }
}

#define XB_TMO      128
#define XB_XCNT(j)  (256  + 64 * (j))
#define XB_XSUB(j)  (1280 + 64 * (j))
#define XB_XGEN(j)  (2304 + 64 * (j))
#define XB_TOP      3328
#define XB_TOPGEN   3392
#define XCD_BAR_WORDS 3456
#define XB_SPIN_CAP (1u << 22)
DI unsigned xb_ld(unsigned* p)              { return __hip_atomic_load(p, __ATOMIC_RELAXED, __HIP_MEMORY_SCOPE_AGENT); }
DI unsigned xb_add(unsigned* p, unsigned v) { return __hip_atomic_fetch_add(p, v, __ATOMIC_RELAXED, __HIP_MEMORY_SCOPE_AGENT); }
DI unsigned xb_xcc_id() { return (unsigned)__builtin_amdgcn_s_getreg((3 << 11) | 20) & 0xFu; }
#define XB_SPIN(cond, bar) do { unsigned _sp = 0; while (cond) { __builtin_amdgcn_s_sleep(1); \
    if ((++_sp & 255u) == 0u) { if (xb_ld(&(bar)[XB_TMO])) break; if (_sp > XB_SPIN_CAP) { atomicAdd(&(bar)[XB_TMO], 1u); break; } } } } while (0)
struct XcdBarrier { unsigned* bar; unsigned x; volatile LAS unsigned* st; };
DI XcdBarrier xcd_barrier_post(unsigned* bar, volatile LAS unsigned* st) {
  XcdBarrier b; b.bar = bar; b.x = xb_xcc_id(); b.st = st;
  if (threadIdx.x == 0) (void)xb_add(&bar[XB_XCNT(b.x)], 1u);
  return b;
}
DI void xcd_barrier_complete(unsigned* bar, unsigned x, unsigned& nloc, unsigned& nx) {
  const unsigned G = gridDim.x * gridDim.y * gridDim.z;
  unsigned sum, cnt, mine, sp = 0u;
  for (;;) {
    sum = 0u; cnt = 0u; mine = 0u;
#pragma unroll
    for (unsigned j = 0; j < 16; ++j) { const unsigned c = xb_ld(&bar[XB_XCNT(j)]); sum += c; cnt += (c > 0u) ? 1u : 0u; mine = (j == x) ? c : mine; }
    if (sum == G) break;
    __builtin_amdgcn_s_sleep(1);
    if ((++sp & 255u) == 0u) { if (xb_ld(&bar[XB_TMO])) break; if (sp > XB_SPIN_CAP) { atomicAdd(&bar[XB_TMO], 1u); break; } }
  }
  nloc = mine > 0u ? mine : 1u; nx = cnt > 0u ? cnt : 1u;
}
DI void xcd_barrier(const XcdBarrier& b) {
  asm volatile("s_waitcnt vmcnt(0)" ::: "memory");
  __syncthreads();
  if (threadIdx.x == 0) {
    unsigned* bar = b.bar;
    __builtin_amdgcn_s_waitcnt(0);
    unsigned nloc = b.st[0], nx = b.st[1];
    if (nloc == 0u) { xcd_barrier_complete(bar, b.x, nloc, nx); b.st[0] = nloc; b.st[1] = nx; }
    const unsigned old = xb_add(&bar[XB_XSUB(b.x)], 1u);
    const unsigned gen = old / nloc;
    if (old + 1u == (gen + 1u) * nloc) {
      __builtin_amdgcn_fence(__ATOMIC_RELEASE, "agent");
      asm volatile("s_waitcnt vmcnt(0)" ::: "memory");
      const unsigned og = xb_add(&bar[XB_TOP], 1u);
      const unsigned tg = og / nx;
      if (og + 1u == (tg + 1u) * nx) xb_add(&bar[XB_TOPGEN], 1u);
      else XB_SPIN(xb_ld(&bar[XB_TOPGEN]) == tg, bar);
      __builtin_amdgcn_fence(__ATOMIC_ACQUIRE, "agent");
      xb_add(&bar[XB_XGEN(b.x)], 1u);
      asm volatile("s_waitcnt vmcnt(0)" ::: "memory");
    } else {
      XB_SPIN(xb_ld(&bar[XB_XGEN(b.x)]) == gen, bar);
      __builtin_amdgcn_fence(__ATOMIC_ACQUIRE, "agent");
      asm volatile("s_waitcnt vmcnt(0)" ::: "memory");
    }
  }
  __syncthreads();
}

__global__ void __launch_bounds__(512, 2) fwd_megakernel(Params p0) {
  extern __shared__ __attribute__((aligned(16))) unsigned char shm[];
  LAS unsigned char* lds = (LAS unsigned char*)shm;
  const int G = gridDim.x, c = blockIdx.x;
  __shared__ uint4 xb_words;
  if (threadIdx.x == 0) xb_words = make_uint4(0u, 0u, 0u, 0u);
  __syncthreads();
  const XcdBarrier xb = xcd_barrier_post((unsigned*)(p0.ws + OFF_BAR), (volatile LAS unsigned*)&xb_words);
  for (int phi = p0.ph_lo; phi < p0.ph_hi; ++phi) {
    int ph = phi; asm volatile("" : "+s"(ph));
    Ctx p; p.in.pp = &p0; p.out = p0.out; p.ws = p0.ws;
    asm volatile("" : "+s"(p.out)); asm volatile("" : "+s"(p.ws));
    unsigned char* ws = p.ws;
    if (ph == 0) prep_phase(p, lds);
    else if (ph == NPH - 1) norm_phase(p, 0, 0, false, true);
    else {
      const int layer = (ph - 1) / 12, s = (ph - 1) % 12;
      const bf16_t* wl = (const bf16_t*)(ws + OFF_W) + (size_t)layer * W_LAYER;
      const float* modl = (const float*)(ws + OFF_MOD) + (size_t)layer * 9 * 9216;
      bf16_t* Nb = (bf16_t*)(ws + OFF_N); bf16_t* UH = (bf16_t*)(ws + OFF_UH); float* X = (float*)(ws + OFF_X);
      if (s == 0) norm_phase(p, layer, 0, layer == 0, false);
      else if (s == 3) norm_phase(p, layer, 1, false, false);
      else if (s == 9) norm_phase(p, layer, 2, false, false);
      else if (s == 1 || s == 10) {
        const int f = s == 10;
        pg8::Gemm g{Nb, wl + W_FI + (size_t)f * 5632 * 1024, T_ALL, 5632, 1024};
        pg8::StaticOrder S; S.init(g.M, g.N, G, c);
        EpiSwiglu E{UH};
        pg8::gemm_phase(lds, g, S, E);
      } else if (s == 2 || s == 11) {
        const int f = s == 11;
        pg8::Gemm g{UH, wl + W_FO + (size_t)f * 1024 * 2816, T_ALL, 1024, 2816};
        pg8::StaticOrder S; S.init(g.M, g.N, G, c);
        EpiResid E{X, modl, f ? 8 : 2, 0.5f};
        pg8::gemm_phase(lds, g, S, E);
      } else if (s == 4) {
        pg8::Gemm g{Nb, wl + W_IN, T_ALL, 5632, 1024};
        pg8::StaticOrder S; S.init(g.M, g.N, G, c);
        EpiWin E{UH, (bf16_t*)(ws + OFF_Q), (bf16_t*)(ws + OFF_K), (bf16_t*)(ws + OFF_V), p.out + 12582912, p.out + 12582912 + 8388608, (const float*)(ws + OFF_ROPE), layer};
        pg8::gemm_phase(lds, g, S, E);
      } else if (s == 5) {
        mixer_phase(p, layer, lds);
      } else if (s == 6) {
        pg8::Gemm g{(const bf16_t*)(ws + OFF_YA), wl + W_GLU, T_ALL, 512, 512};
        pg8::StaticOrder S; S.init(g.M, g.N, G, c);
        EpiGlu E{(const bf16_t*)(ws + OFF_YA), (bf16_t*)(ws + OFF_YS)};
        pg8::gemm_phase(lds, g, S, E);
      } else if (s == 7) {
        pg8::Gemm g{(const bf16_t*)(ws + OFF_YS), wl + W_BR, 3 * T_ALL, 3072, 512};
        pg8::BranchOrder S{G, c};
        EpiBranch E{UH, (float*)(ws + OFF_YP), Nb};
        pg8::gemm_phase(lds, g, S, E);
      } else if (s == 8) {
        pg8::Gemm g{Nb, wl + W_OUT, T_ALL, 1024, 1024};
        pg8::StaticOrder S; S.init(g.M, g.N, G, c);
        EpiResid E{X, modl, 5, 1.0f};
        pg8::gemm_phase(lds, g, S, E);
      }
    }
    if (phi + 1 < p0.ph_hi) { if (phi == p0.ph_lo) cg::this_grid().sync(); else xcd_barrier(xb); }
  }
}

extern "C" void kernel_launch(void* const* d_in, const int* in_sizes, int n_in, void* d_out, int out_size, void* d_ws, size_t ws_size, hipStream_t stream) {
  static int grid = 0;
  if (grid == 0) {
    int dev = 0, cus = 0, per_cu = 0;
    hipGetDevice(&dev);
    hipDeviceGetAttribute(&cus, hipDeviceAttributeMultiprocessorCount, dev);
    if (hipFuncSetAttribute((const void*)fwd_megakernel, hipFuncAttributeMaxDynamicSharedMemorySize, LDS_BYTES) != hipSuccess) fprintf(stderr, "hipFuncSetAttribute failed\n");
    hipOccupancyMaxActiveBlocksPerMultiprocessor(&per_cu, (const void*)fwd_megakernel, 512, LDS_BYTES);
    if (per_cu < 1) { fprintf(stderr, "occupancy query gave %d\n", per_cu); per_cu = 1; }
    (void)hipGetLastError();
    grid = cus * per_cu;
    if (ws_size < WS_END) fprintf(stderr, "workspace too small: %zu\n", ws_size);
  }
  if (hipMemsetAsync((unsigned char*)d_ws + OFF_BAR, 0, 16384, stream) != hipSuccess) fprintf(stderr, "memset failed\n");
  Params p{};
  for (int i = 0; i < 32; ++i) p.in[i] = (const float*)d_in[i];
  p.out = (float*)d_out; p.ws = (unsigned char*)d_ws;
#if COOP
  p.ph_lo = 0; p.ph_hi = NPH;
  void* args[] = {&p};
  hipError_t e = hipLaunchCooperativeKernel((const void*)fwd_megakernel, dim3(grid), dim3(512), args, LDS_BYTES, stream);
  if (e != hipSuccess) fprintf(stderr, "cooperative launch failed: %s (grid %d)\n", hipGetErrorString(e), grid);
#else
  for (int ph = 0; ph < NPH; ++ph) {
    p.ph_lo = ph; p.ph_hi = ph + 1;
    hipLaunchKernelGGL(fwd_megakernel, dim3(grid), dim3(512), LDS_BYTES, stream, p);
  }
#endif
}
```

```cpp
#include <hip/hip_runtime.h>
#include <hip/hip_cooperative_groups.h>
#include <cstdio>
namespace cg = cooperative_groups;

#ifndef COOP
#define COOP 1
#endif

#define LAS __attribute__((address_space(3)))
#define GAS __attribute__((address_space(1)))
typedef unsigned short bf16_t;
typedef short bf16x8 __attribute__((ext_vector_type(8)));
typedef short s16x4 __attribute__((ext_vector_type(4)));
typedef float f32x2 __attribute__((ext_vector_type(2)));
typedef float f32x4 __attribute__((ext_vector_type(4)));
typedef float f32x16 __attribute__((ext_vector_type(16)));
typedef unsigned u32x4 __attribute__((ext_vector_type(4)));
typedef unsigned u32x2 __attribute__((ext_vector_type(2)));
typedef __bf16 nbf16x2 __attribute__((ext_vector_type(2)));
#define DI __device__ __forceinline__

constexpr int T_CTX = 4096, T_ALL = 12288, DM = 1024, DFF = 2816, INW = 5632, NPH = 50;
constexpr size_t OFF_X = 0;
constexpr size_t OFF_N = OFF_X + 50331648;
constexpr size_t OFF_UH = OFF_N + 25165824;
constexpr size_t OFF_Q = OFF_UH + 138412032;
constexpr size_t OFF_K = OFF_Q + 12582912;
constexpr size_t OFF_V = OFF_K + 12582912;
constexpr size_t OFF_KC = OFF_V + 12582912;
constexpr size_t OFF_VC = OFF_KC + 16777216;
constexpr size_t OFF_YP = OFF_VC + 16777216;
constexpr size_t OFF_YA = OFF_YP + 50331648;
constexpr size_t OFF_YS = OFF_YA + 12582912;
constexpr size_t OFF_MOD = OFF_YS + 37748736;
constexpr size_t OFF_BB = OFF_MOD + 1327104;
constexpr size_t OFF_CM = OFF_BB + 1048576;
constexpr size_t OFF_AT = OFF_CM + 1048576;
constexpr size_t OFF_ROPE = OFF_AT + 131072;
constexpr size_t OFF_LAM = OFF_ROPE + 262144;
constexpr size_t OFF_W = OFF_LAM + 256;
constexpr size_t W_FI = 0;
constexpr size_t W_FO = W_FI + 11534336;
constexpr size_t W_IN = W_FO + 5767168;
constexpr size_t W_GLU = W_IN + 5767168;
constexpr size_t W_BR = W_GLU + 262144;
constexpr size_t W_OUT = W_BR + 1572864;
constexpr size_t W_P = W_OUT + 1048576;
constexpr size_t W_LAYER = W_P + 65536;
constexpr size_t OFF_BAR = OFF_W + 4 * W_LAYER * 2;
constexpr size_t WS_END = OFF_BAR + 16384;
constexpr int LDS_BYTES = 131072;

struct Params {
  const float* in[32];
  float* out;
  unsigned char* ws;
  int ph_lo, ph_hi;
};
struct InTab { const Params* pp; __device__ __forceinline__ const float* operator[](int i) const { asm volatile("" : "+s"(i)); return pp->in[i]; } };
struct Ctx { InTab in; float* out; unsigned char* ws; int wv; };

DI int opaque_tid(int wv) { int t = wv * 64 + (int)__builtin_amdgcn_mbcnt_hi(~0u, __builtin_amdgcn_mbcnt_lo(~0u, 0u)); asm volatile("" : "+v"(t)); return t; }
DI unsigned pk2(float lo, float hi) { f32x2 v = {lo, hi}; nbf16x2 b = __builtin_convertvector(v, nbf16x2); return __builtin_bit_cast(unsigned, b); }
DI float gldf(const float* p) { return *(const GAS float*)p; }
DI void gstf(float* p, float v) { *(GAS float*)p = v; }
DI float bf2f(unsigned short b) { return __uint_as_float(((unsigned)b) << 16); }
DI float bflo(unsigned u) { return __uint_as_float(u << 16); }
DI float bfhi(unsigned u) { return __uint_as_float(u & 0xffff0000u); }
DI float sigmoidf_(float x) { return __builtin_amdgcn_rcpf(1.f + __expf(-x)); }
DI float wave_sum(float v) {
#pragma unroll
  for (int o = 1; o < 64; o <<= 1) v += __shfl_xor(v, o);
  return v;
}
#define LDS_WAIT() asm volatile("s_waitcnt lgkmcnt(0)" ::: "memory")

namespace pg8 {
constexpr int BM = 256, BK = 64, HALF = 128, HTB = HALF * BK * 2, NXCD = 8, WGM = 8;
DI int lds_byte(int r, int c) { const int st = (r >> 4) * 2 + (c >> 5), rr = r & 15, cc = c & 31, ob = rr * 64 + cc * 2; return st * 1024 + (ob ^ (((ob >> 9) & 1) << 5)); }
DI void stage_rc(int b, int& R, int& C) { const int st = b / 1024, sb = b % 1024, swz = sb ^ (((sb >> 9) & 1) << 5); R = (st >> 1) * 16 + swz / 64; C = (st & 1) * 32 + (swz % 64) / 2; }
struct Unit { int pm, pn; };
struct Gemm { const bf16_t* A; const bf16_t* Bt; int M, N, K; };
struct StaticOrder {
  int nM, nN, nwg, G, c;
  DI void init(int M, int N, int G_, int c_) { nM = M / BM; nN = N / BM; nwg = nM * nN; G = G_; c = c_; }
  DI bool next(int i, Unit& u) const {
    const long L = (long)i * G + c; if (L >= nwg) return false;
    int wgid = (int)L; { const int q = nwg / NXCD, r = nwg % NXCD, xcd = wgid % NXCD, off = wgid / NXCD; wgid = (xcd < r ? xcd * (q + 1) : r * (q + 1) + (xcd - r) * q) + off; }
    const int nig = WGM * nN, gid = wgid / nig, fm = gid * WGM, gsz = (nM - fm) < WGM ? (nM - fm) : WGM;
    u.pm = fm + ((wgid % nig) % gsz); u.pn = (wgid % nig) / gsz; return true;
  }
};
struct BranchOrder {
  int G, c;
  DI bool next(int i, Unit& u) const { const int tile = (i / 3) * G + c; if (tile >= 192) return false; const int n = i % 3; u.pm = n * 48 + (tile >> 2); u.pn = n * 4 + (tile & 3); return true; }
};

template <class Epi, class Sched>
DI void gemm_phase(LAS unsigned char* lds, const Gemm g, const Sched& S, const Epi& E, int wv) {
  const int tid = opaque_tid(wv), wid = __builtin_amdgcn_readfirstlane(tid >> 6), lane = tid & 63, wr = wid >> 2, wc = wid & 3, fr = lane & 15, fq = lane >> 4;
  const int K = g.K, nt = K / BK;
  unsigned voffA[2], voffB[2];
#pragma unroll
  for (int i = 0; i < 2; ++i) { int R, C; stage_rc(tid * 16 + i * 8192, R, C); voffA[i] = (unsigned)(R * K + C) * 2u; voffB[i] = voffA[i]; }
  const size_t kstep = (size_t)(BK * 2);
  const size_t hstep = (size_t)HALF * K * 2;
  const size_t tstep = 2 * hstep;
  const unsigned ldsw = (unsigned)wid * 1024u;
  const int aoff = lds_byte(wr * 64 + fr, fq * 8), boff = lds_byte(wc * 32 + fr, fq * 8);
#define PG8_SA(b, h) (((b) * 2 + (h)) * HTB)
#define PG8_SB(b, h) ((4 + (b) * 2 + (h)) * HTB)
#define PG8_STAGE(bufoff, gbase, voff) do { _Pragma("unroll") for (int _i = 0; _i < 2; ++_i) \
    __builtin_amdgcn_global_load_lds((const unsigned*)((const char*)(gbase) + (voff)[_i]), (LAS unsigned*)(lds + (bufoff) + ldsw + _i * 8192), 16, 0, 0); } while (0)
#define PG8_LDA(dst, b, h) do { _Pragma("unroll") for (int m = 0; m < 4; ++m) _Pragma("unroll") for (int k = 0; k < 2; ++k) dst[m][k] = *(const LAS bf16x8*)(lds + PG8_SA(b, h) + aoff + m * 2048 + k * 1024); } while (0)
#define PG8_LDB(dst, b, h) do { _Pragma("unroll") for (int n = 0; n < 2; ++n) _Pragma("unroll") for (int k = 0; k < 2; ++k) dst[n][k] = *(const LAS bf16x8*)(lds + PG8_SB(b, h) + boff + n * 2048 + k * 1024); } while (0)
#define PG8_MMA(ai, bj, At, Bt) do { __builtin_amdgcn_s_setprio(1); _Pragma("unroll") for (int m = 0; m < 4; ++m) _Pragma("unroll") for (int n = 0; n < 2; ++n) _Pragma("unroll") for (int k = 0; k < 2; ++k) \
    acc[ai][bj][m][n] = __builtin_amdgcn_mfma_f32_16x16x32_bf16(Bt[n][k], At[m][k], acc[ai][bj][m][n], 0, 0, 0); __builtin_amdgcn_s_setprio(0); } while (0)
#define PG8_WAIT_V(n) asm volatile("s_waitcnt vmcnt(" #n ")" ::: "memory")
#define PG8_WAIT_L(n) asm volatile("s_waitcnt lgkmcnt(" #n ")" ::: "memory")
#define PG8_BAR __builtin_amdgcn_s_barrier()
#define PG8_SCHED __builtin_amdgcn_sched_barrier(0)
  Unit cur, nxt; int ui = 0;
  if (!S.next(0, cur)) return;
  f32x4 acc[2][2][4][2];
#pragma unroll
  for (int a = 0; a < 2; ++a)
#pragma unroll
    for (int b = 0; b < 2; ++b)
#pragma unroll
      for (int m = 0; m < 4; ++m)
#pragma unroll
        for (int n = 0; n < 2; ++n) acc[a][b][m][n] = (f32x4){0.f, 0.f, 0.f, 0.f};
  bf16x8 At[4][2], B0[2][2], B1[2][2];
  const char* cA = (const char*)g.A + (size_t)cur.pm * tstep; const char* cB = (const char*)g.Bt + (size_t)cur.pn * tstep;
  PG8_STAGE(PG8_SB(0, 0), cB, voffB); PG8_STAGE(PG8_SA(0, 0), cA, voffA); PG8_STAGE(PG8_SB(0, 1), cB + hstep, voffB); PG8_STAGE(PG8_SA(0, 1), cA + hstep, voffA);
  if (wr == 1) PG8_BAR;
  PG8_WAIT_V(4); PG8_BAR;
  PG8_STAGE(PG8_SB(1, 0), cB + kstep, voffB); PG8_STAGE(PG8_SA(1, 0), cA + kstep, voffA); PG8_STAGE(PG8_SB(1, 1), cB + hstep + kstep, voffB);
  PG8_WAIT_V(6); PG8_BAR;
  for (;;) {
    const bool has_next = S.next(ui + 1, nxt);
    const char* nA = has_next ? (const char*)g.A + (size_t)nxt.pm * tstep : cA; const char* nB = has_next ? (const char*)g.Bt + (size_t)nxt.pn * tstep : cB;
    for (int t = 0; t < nt; t += 2) {
      const bool last = (t == nt - 2);
      const char* a1 = cA + (size_t)(t + 1) * kstep;
      const char* a2 = last ? nA : cA + (size_t)(t + 2) * kstep; const char* b2 = last ? nB : cB + (size_t)(t + 2) * kstep;
      const char* a3 = a2 + kstep; const char* b3 = b2 + kstep;
      PG8_LDB(B0, 0, 0); PG8_SCHED; PG8_LDA(At, 0, 0); PG8_STAGE(PG8_SA(1, 1), a1 + hstep, voffA);
      PG8_WAIT_L(8); PG8_BAR; PG8_WAIT_L(0); PG8_MMA(0, 0, At, B0); PG8_BAR; PG8_SCHED;
      PG8_LDB(B1, 0, 1); PG8_STAGE(PG8_SB(0, 0), b2, voffB);
      PG8_BAR; PG8_WAIT_L(0); PG8_MMA(0, 1, At, B1); PG8_BAR;
      PG8_LDA(At, 0, 1); PG8_STAGE(PG8_SA(0, 0), a2, voffA);
      PG8_BAR; PG8_WAIT_L(0); PG8_MMA(1, 0, At, B0); PG8_BAR; PG8_SCHED;
      PG8_STAGE(PG8_SB(0, 1), b2 + hstep, voffB);
      PG8_WAIT_V(6); PG8_BAR; PG8_MMA(1, 1, At, B1); PG8_BAR;
      PG8_LDB(B0, 1, 0); PG8_SCHED; PG8_LDA(At, 1, 0); PG8_STAGE(PG8_SA(0, 1), a2 + hstep, voffA);
      PG8_WAIT_L(8); PG8_BAR; PG8_WAIT_L(0); PG8_MMA(0, 0, At, B0); PG8_BAR; PG8_SCHED;
      PG8_LDB(B1, 1, 1); PG8_STAGE(PG8_SB(1, 0), b3, voffB);
      PG8_BAR; PG8_WAIT_L(0); PG8_MMA(0, 1, At, B1); PG8_BAR;
      PG8_LDA(At, 1, 1); PG8_STAGE(PG8_SA(1, 0), a3, voffA);
      PG8_BAR; PG8_WAIT_L(0); PG8_MMA(1, 0, At, B0); PG8_BAR; PG8_SCHED;
      PG8_STAGE(PG8_SB(1, 1), b3 + hstep, voffB);
      PG8_WAIT_V(6); PG8_BAR; PG8_MMA(1, 1, At, B1); PG8_BAR;
    }
    E(acc, cur, wr, wc, fr, fq);
    if (!has_next) break;
#pragma unroll
    for (int a = 0; a < 2; ++a)
#pragma unroll
      for (int b = 0; b < 2; ++b)
#pragma unroll
        for (int m = 0; m < 4; ++m)
#pragma unroll
          for (int n = 0; n < 2; ++n) acc[a][b][m][n] = (f32x4){0.f, 0.f, 0.f, 0.f};
    cur = nxt; cA = nA; cB = nB; ++ui;
  }
  PG8_WAIT_V(0);
  if (wr == 0) PG8_BAR;
  PG8_BAR;
#undef PG8_SA
#undef PG8_SB
#undef PG8_STAGE
#undef PG8_LDA
#undef PG8_LDB
#undef PG8_MMA
#undef PG8_WAIT_V
#undef PG8_WAIT_L
#undef PG8_BAR
#undef PG8_SCHED
}
}
using pg8::Unit;

typedef f32x4 AccT[2][2][4][2];
DI void st_bf4(bf16_t* p, f32x4 v) { u32x2 w; w.x = pk2(v[0], v[1]); w.y = pk2(v[2], v[3]); *(GAS u32x2*)p = w; }
DI f32x4 ld_bf4(const bf16_t* p) { const u32x2 w = *(const GAS u32x2*)p; return (f32x4){bflo(w.x), bfhi(w.x), bflo(w.y), bfhi(w.y)}; }

struct EpiSwiglu {
  bf16_t* H;
  DI void operator()(const AccT& acc, const Unit& u, int wr, int wc, int fr, int fq) const {
    const int row0 = u.pm * 256 + wr * 64 + fr, col0 = u.pn * 128 + wc * 32 + 4 * fq;
#pragma unroll
    for (int ai = 0; ai < 2; ++ai)
#pragma unroll
      for (int m = 0; m < 4; ++m) {
        bf16_t* rowp = H + (size_t)(row0 + ai * 128 + m * 16) * DFF + col0;
#pragma unroll
        for (int n = 0; n < 2; ++n) {
          const f32x4 a = acc[ai][0][m][n], b = acc[ai][1][m][n]; f32x4 h;
#pragma unroll
          for (int j = 0; j < 4; ++j) h[j] = a[j] * sigmoidf_(a[j]) * b[j];
          st_bf4(rowp + n * 16, h);
        }
      }
  }
};
struct EpiResid {
  float* X; const float* modl; int gate_idx; float coef;
  DI void operator()(const AccT& acc, const Unit& u, int wr, int wc, int fr, int fq) const {
    const int mrow = u.pm < 16 ? 8 : ((u.pm - 16) >> 2);
    const int row0 = u.pm * 256 + wr * 64 + fr, col0 = u.pn * 256 + wc * 32 + 4 * fq;
    const float* gp = modl + (size_t)mrow * 9216 + gate_idx * 1024 + col0;
    f32x4 gv[2][2];
#pragma unroll
    for (int bj = 0; bj < 2; ++bj)
#pragma unroll
      for (int n = 0; n < 2; ++n) gv[bj][n] = *(const GAS f32x4*)(gp + bj * 128 + n * 16) * coef;
#pragma unroll
    for (int ai = 0; ai < 2; ++ai) {
      f32x4 xv[4][2][2];
#pragma unroll
      for (int m = 0; m < 4; ++m)
#pragma unroll
        for (int bj = 0; bj < 2; ++bj)
#pragma unroll
          for (int n = 0; n < 2; ++n) xv[m][bj][n] = *(const GAS f32x4*)(X + (size_t)(row0 + ai * 128 + m * 16) * DM + col0 + bj * 128 + n * 16);
#pragma unroll
      for (int m = 0; m < 4; ++m)
#pragma unroll
        for (int bj = 0; bj < 2; ++bj)
#pragma unroll
          for (int n = 0; n < 2; ++n) *(GAS f32x4*)(X + (size_t)(row0 + ai * 128 + m * 16) * DM + col0 + bj * 128 + n * 16) = xv[m][bj][n] + gv[bj][n] * acc[ai][bj][m][n];
    }
  }
};
struct EpiWin {
  bf16_t* U; bf16_t* Q; bf16_t* Kb; bf16_t* Vb; float* outk; float* outv; const float* rope; int layer;
  DI void operator()(const AccT& acc, const Unit& u, int wr, int wc, int fr, int fq) const {
    const int pn = u.pn, row0 = u.pm * 256 + wr * 64 + fr;
    const bool lat = u.pm >= 16;
    if (pn < 2 || pn >= 8) {
      const int col0 = pn * 256 + wc * 32 + 4 * fq;
#pragma unroll
      for (int ai = 0; ai < 2; ++ai)
#pragma unroll
        for (int m = 0; m < 4; ++m) {
          bf16_t* rowp = U + (size_t)(row0 + ai * 128 + m * 16) * INW + col0;
#pragma unroll
          for (int bj = 0; bj < 2; ++bj)
#pragma unroll
            for (int n = 0; n < 2; ++n) st_bf4(rowp + bj * 128 + n * 16, acc[ai][bj][m][n]);
        }
    } else if (pn < 6) {
      const bool isq = pn < 4;
      const int cq0 = (pn & 1) * 256 + wc * 32 + 4 * fq;
      const float scale = isq ? 0.125f * 1.4426950408889634f : 1.f;
      bf16_t* dstb = isq ? Q : Kb;
#pragma unroll
      for (int ai = 0; ai < 2; ++ai) {
        f32x4 csv[4], snv[4];
#pragma unroll
        for (int m = 0; m < 4; ++m) {
          csv[m] = (f32x4){1.f, 1.f, 1.f, 1.f}; snv[m] = (f32x4){0.f, 0.f, 0.f, 0.f};
          if (lat) {
            const int pos = (row0 + ai * 128 + m * 16 - T_CTX) & 1023;
            const float* rp = rope + (size_t)pos * 64 + ((wc & 1) * 16 + 4 * fq) * 2;
            const f32x4 r0 = *(const GAS f32x4*)rp, r1 = *(const GAS f32x4*)(rp + 4);
            csv[m] = (f32x4){r0[0], r0[2], r1[0], r1[2]}; snv[m] = (f32x4){r0[1], r0[3], r1[1], r1[3]};
          }
        }
#pragma unroll
        for (int m = 0; m < 4; ++m) {
          const int row = row0 + ai * 128 + m * 16;
          const f32x4 cs = csv[m], sn = snv[m];
#pragma unroll
          for (int bj = 0; bj < 2; ++bj) {
            const f32x4 y1 = acc[ai][bj][m][0], y2 = acc[ai][bj][m][1];
            const f32x4 o1 = y1 * cs - y2 * sn, o2 = y2 * cs + y1 * sn;
            bf16_t* d = dstb + (size_t)row * 512 + cq0 + bj * 128;
            st_bf4(d, o1 * scale); st_bf4(d + 16, o2 * scale);
            if (!isq && !lat) {
              float* o = outk + ((size_t)((row >> 8) * 4 + layer) * 256 + (row & 255)) * 512 + cq0 + bj * 128;
              *(GAS f32x4*)o = o1; *(GAS f32x4*)(o + 16) = o2;
            }
          }
        }
      }
    } else {
      const int cv0 = (pn & 1) * 256 + wc * 32 + 4 * fq;
#pragma unroll
      for (int ai = 0; ai < 2; ++ai)
#pragma unroll
        for (int m = 0; m < 4; ++m) {
          const int row = row0 + ai * 128 + m * 16;
#pragma unroll
          for (int bj = 0; bj < 2; ++bj)
#pragma unroll
            for (int n = 0; n < 2; ++n) {
              st_bf4(Vb + (size_t)row * 512 + cv0 + bj * 128 + n * 16, acc[ai][bj][m][n]);
              if (!lat) *(GAS f32x4*)(outv + ((size_t)((row >> 8) * 4 + layer) * 256 + (row & 255)) * 512 + cv0 + bj * 128 + n * 16) = acc[ai][bj][m][n];
            }
        }
    }
  }
};
struct EpiGlu {
  const bf16_t* ya; bf16_t* ys0;
  DI void operator()(const AccT& acc, const Unit& u, int wr, int wc, int fr, int fq) const {
    const int row0 = u.pm * 256 + wr * 64 + fr, col0 = u.pn * 256 + wc * 32 + 4 * fq;
#pragma unroll
    for (int ai = 0; ai < 2; ++ai) {
      u32x2 yv[4][2][2];
#pragma unroll
      for (int m = 0; m < 4; ++m)
#pragma unroll
        for (int bj = 0; bj < 2; ++bj)
#pragma unroll
          for (int n = 0; n < 2; ++n) yv[m][bj][n] = *(const GAS u32x2*)(ya + (size_t)(row0 + ai * 128 + m * 16) * 512 + col0 + bj * 128 + n * 16);
#pragma unroll
      for (int m = 0; m < 4; ++m)
#pragma unroll
        for (int bj = 0; bj < 2; ++bj)
#pragma unroll
          for (int n = 0; n < 2; ++n) {
            const u32x2 w = yv[m][bj][n]; const f32x4 y = {bflo(w.x), bfhi(w.x), bflo(w.y), bfhi(w.y)}, a = acc[ai][bj][m][n]; f32x4 o;
#pragma unroll
            for (int j = 0; j < 4; ++j) o[j] = y[j] * sigmoidf_(a[j]);
            st_bf4(ys0 + (size_t)(row0 + ai * 128 + m * 16) * 512 + col0 + bj * 128 + n * 16, o);
          }
    }
  }
};
struct EpiBranch {
  const bf16_t* U; float* MRG; bf16_t* MERGED;
  DI void operator()(const AccT& acc, const Unit& u, int wr, int wc, int fr, int fq) const {
    const int n3 = u.pm / 48, pm = u.pm - n3 * 48, pn = u.pn & 3;
    const int row0 = pm * 256 + wr * 64 + fr, col0 = pn * 256 + wc * 32 + 4 * fq;
#pragma unroll
    for (int ai = 0; ai < 2; ++ai)
#pragma unroll
      for (int mh = 0; mh < 2; ++mh) {
        u32x2 gt[2][2][2]; f32x4 mv[2][2][2];
#pragma unroll
        for (int m2 = 0; m2 < 2; ++m2)
#pragma unroll
          for (int bj = 0; bj < 2; ++bj)
#pragma unroll
            for (int n = 0; n < 2; ++n) {
              const int row = row0 + ai * 128 + (mh * 2 + m2) * 16;
              gt[m2][bj][n] = *(const GAS u32x2*)(U + (size_t)row * INW + 2560 + n3 * 1024 + col0 + bj * 128 + n * 16);
              mv[m2][bj][n] = n3 ? *(const GAS f32x4*)(MRG + (size_t)row * DM + col0 + bj * 128 + n * 16) : (f32x4){0.f, 0.f, 0.f, 0.f};
            }
#pragma unroll
        for (int m2 = 0; m2 < 2; ++m2)
#pragma unroll
          for (int bj = 0; bj < 2; ++bj)
#pragma unroll
            for (int n = 0; n < 2; ++n) {
              const int row = row0 + ai * 128 + (mh * 2 + m2) * 16;
              const u32x2 w = gt[m2][bj][n]; const f32x4 gg = {bflo(w.x), bfhi(w.x), bflo(w.y), bfhi(w.y)}, a = acc[ai][bj][mh * 2 + m2][n]; f32x4 o;
#pragma unroll
              for (int j = 0; j < 4; ++j) o[j] = mv[m2][bj][n][j] + sigmoidf_(gg[j]) * a[j];
              if (n3 < 2) *(GAS f32x4*)(MRG + (size_t)row * DM + col0 + bj * 128 + n * 16) = o;
              else st_bf4(MERGED + (size_t)row * DM + col0 + bj * 128 + n * 16, o);
            }
      }
  }
};

struct TrItem { const float* W; bf16_t* WT; int K, N, swiglu, item; };
DI void tr_load(const TrItem& t, int lane, float (&v)[32]) {
  const int nblk = t.N / 32, kb = t.item / nblk, nb = t.item % nblk, k0 = 64 * kb, n0 = 32 * nb;
#pragma unroll
  for (int i = 0; i < 32; ++i) { const int kk = 2 * i + (lane >> 5); v[i] = gldf(t.W + (size_t)(k0 + kk) * t.N + n0 + (lane & 31)); }
}
DI void tr_finish(const TrItem& t, int lane, const float (&v)[32], LAS float* scr) {
  const int nblk = t.N / 32, kb = t.item / nblk, nb = t.item % nblk, k0 = 64 * kb, n0 = 32 * nb;
#pragma unroll
  for (int i = 0; i < 32; ++i) { const int kk = 2 * i + (lane >> 5); scr[kk * 33 + (lane & 31)] = v[i]; }
  LDS_WAIT();
  const int c = lane & 7;
#pragma unroll
  for (int j = 0; j < 4; ++j) {
    const int n = (lane >> 3) + 8 * j; const LAS float* s = scr + (8 * c) * 33 + n;
    u32x4 o; o.x = pk2(s[0 * 33], s[1 * 33]); o.y = pk2(s[2 * 33], s[3 * 33]); o.z = pk2(s[4 * 33], s[5 * 33]); o.w = pk2(s[6 * 33], s[7 * 33]);
    int dr = n0 + n;
    if (t.swiglu) { const int isb = dr >= DFF, hh = isb ? dr - DFF : dr; dr = (hh >> 7) * 256 + isb * 128 + (hh & 127); }
    *(GAS u32x4*)(t.WT + (size_t)dr * t.K + k0 + 8 * c) = o;
  }
  LDS_WAIT();
}
DI TrItem tr_decode(const Ctx& p, int it) {
  constexpr int I_FI = 16 * 176, I_FO = 44 * 32, I_IN = 16 * 176, I_GLU = 8 * 16, I_BR = 8 * 32, I_OUT = 16 * 32, I_P = 2 * 4;
  constexpr int I_LAYER = 2 * I_FI + 2 * I_FO + I_IN + I_GLU + 3 * I_BR + I_OUT + 4 * I_P;
  const int l = it / I_LAYER; int r = it % I_LAYER;
  bf16_t* wl = (bf16_t*)(p.ws + OFF_W) + (size_t)l * W_LAYER;
  TrItem t;
  if (r < 2 * I_FI) { const int s = r / I_FI; t = TrItem{p.in[10] + (size_t)(l * 2 + s) * 1024 * 5632, wl + W_FI + (size_t)s * 5632 * 1024, 1024, 5632, 1, r % I_FI}; return t; } r -= 2 * I_FI;
  if (r < 2 * I_FO) { const int s = r / I_FO; t = TrItem{p.in[11] + (size_t)(l * 2 + s) * 2816 * 1024, wl + W_FO + (size_t)s * 1024 * 2816, 2816, 1024, 0, r % I_FO}; return t; } r -= 2 * I_FO;
  if (r < I_IN) { t = TrItem{p.in[12] + (size_t)l * 1024 * 5632, wl + W_IN, 1024, 5632, 0, r}; return t; } r -= I_IN;
  if (r < I_GLU) { t = TrItem{p.in[21] + (size_t)l * 512 * 512, wl + W_GLU, 512, 512, 0, r}; return t; } r -= I_GLU;
  if (r < 3 * I_BR) { const int s = r / I_BR; t = TrItem{p.in[29] + (size_t)(l * 3 + s) * 512 * 1024, wl + W_BR + (size_t)s * 1024 * 512, 512, 1024, 0, r % I_BR}; return t; } r -= 3 * I_BR;
  if (r < I_OUT) { t = TrItem{p.in[30] + (size_t)l * 1024 * 1024, wl + W_OUT, 1024, 1024, 0, r}; return t; } r -= I_OUT;
  { const int s = r / I_P; t = TrItem{p.in[27] + (size_t)(l * 4 + s) * 128 * 128, wl + W_P + (size_t)s * 128 * 128, 128, 128, 0, r % I_P}; return t; }
}
constexpr int TR_ITEMS = 4 * (2 * 16 * 176 + 2 * 44 * 32 + 16 * 176 + 8 * 16 + 3 * 8 * 32 + 16 * 32 + 4 * 2 * 4);

DI void tr_slice(const Ctx& p, LAS unsigned char* lds, int layer, int part) {
  const int tid = opaque_tid(p.wv), lane = tid & 63, wave = tid >> 6;
  const int G = gridDim.x, first = G > 64 ? 32 : 0;
  if ((int)blockIdx.x < first) return;
  constexpr int IL = TR_ITEMS / 4;
  const int lo = layer * IL + (part * IL) / 2, hi = layer * IL + ((part + 1) * IL) / 2;
  LAS float* scr = (LAS float*)(lds + wave * 8448);
  float va[32];
  for (int it = lo + ((int)blockIdx.x - first) * 8 + wave; it < hi; it += (G - first) * 8) {
    const TrItem t = tr_decode(p, it);
    tr_load(t, lane, va);
    tr_finish(t, lane, va, scr);
  }
}
DI void prep_phase(const Ctx& p, LAS unsigned char* lds) {
  const int tid = opaque_tid(p.wv), lane = tid & 63, wave = tid >> 6;
  unsigned char* ws = p.ws;
  for (int item = blockIdx.x; item < 144; item += gridDim.x) {
    const int l = item / 36, jc = item % 36;
    LAS float* sc = (LAS float*)lds;
    LAS float* red = sc + 9 * 1024;
    for (int i = tid; i < 9 * 1024; i += 512) { const int r = i >> 10, k = i & 1023; const float v = r < 8 ? gldf(p.in[5] + r * 1024 + k) : gldf(p.in[6] + k); sc[i] = v * sigmoidf_(v); }
    __syncthreads();
    const int j0 = jc * 256 + lane * 4;
    const float* w = p.in[8] + (size_t)l * 1024 * 9216 + (size_t)(wave * 128) * 9216 + j0;
    f32x4 acc[9];
#pragma unroll
    for (int r = 0; r < 9; ++r) acc[r] = (f32x4){0.f, 0.f, 0.f, 0.f};
    const LAS float* s0 = sc + wave * 128;
#pragma unroll 8
    for (int k = 0; k < 128; ++k) {
      const f32x4 wv = *(const GAS f32x4*)(w + (size_t)k * 9216);
#pragma unroll
      for (int r = 0; r < 9; ++r) acc[r] += wv * s0[r * 1024 + k];
    }
#pragma unroll
    for (int r = 0; r < 9; ++r) *(LAS f32x4*)(red + (wave * 9 + r) * 256 + lane * 4) = acc[r];
    __syncthreads();
    for (int o = tid; o < 9 * 256; o += 512) {
      const int r = o >> 8, col = o & 255; float s = 0.f;
#pragma unroll
      for (int w8 = 0; w8 < 8; ++w8) s += red[(w8 * 9 + r) * 256 + col];
      gstf((float*)(ws + OFF_MOD) + ((size_t)l * 9 + r) * 9216 + jc * 256 + col, s + gldf(p.in[9] + l * 9216 + jc * 256 + col));
    }
    __syncthreads();
  }
  {
    LAS float* scr = (LAS float*)(lds + wave * 8448);
    const int gw = blockIdx.x * 8 + wave, NGW = gridDim.x * 8;
    constexpr int TR0 = TR_ITEMS / 4;
    if (gw < TR0) {
      TrItem cur = tr_decode(p, gw); float va[32], vb[32];
      tr_load(cur, lane, va);
      for (int it = gw; it < TR0; it += 2 * NGW) {
        const bool h1 = it + NGW < TR0, h2 = it + 2 * NGW < TR0;
        TrItem nx = cur;
        if (h1) { nx = tr_decode(p, it + NGW); tr_load(nx, lane, vb); }
        tr_finish(cur, lane, va, scr);
        if (h1) {
          if (h2) { cur = tr_decode(p, it + 2 * NGW); tr_load(cur, lane, va); }
          tr_finish(nx, lane, vb, scr);
        }
      }
    }
  }
  const size_t gt = (size_t)blockIdx.x * 512 + tid, GT = (size_t)gridDim.x * 512;
  for (size_t i0 = gt; i0 < 2 * 1048576; i0 += 4 * GT) {
    f32x4 a[4], b[4];
#pragma unroll
    for (int q = 0; q < 4; ++q) {
      const size_t i = i0 + q * GT; if (i >= 2 * 1048576) { a[q] = (f32x4){0.f, 0.f, 0.f, 0.f}; b[q] = a[q]; continue; }
      const int which = i >= 1048576; const size_t e = (i & 1048575) * 8;
      const float* src = (which ? p.in[3] : p.in[2]) + e;
      a[q] = *(const GAS f32x4*)src; b[q] = *(const GAS f32x4*)(src + 4);
    }
#pragma unroll
    for (int q = 0; q < 4; ++q) {
      const size_t i = i0 + q * GT; if (i >= 2 * 1048576) continue;
      const int which = i >= 1048576; const size_t e = (i & 1048575) * 8;
      u32x4 o; o.x = pk2(a[q][0], a[q][1]); o.y = pk2(a[q][2], a[q][3]); o.z = pk2(b[q][0], b[q][1]); o.w = pk2(b[q][2], b[q][3]);
      *(GAS u32x4*)((bf16_t*)(ws + (which ? OFF_VC : OFF_KC)) + e) = o;
    }
  }
  for (size_t i = gt; i < 16384; i += GT) {
    const int pI = (int)(i & 63), ldg = (int)(i >> 6);
    const float lr = gldf(p.in[13] + i), li = gldf(p.in[14] + i), dt = expf(gldf(p.in[15] + ldg));
    const float mag = expf(lr * dt), abr = mag * cosf(li * dt), abi = mag * sinf(li * dt);
    const float den = lr * lr + li * li, nr = abr - 1.0f, kr = (nr * lr + abi * li) / den, ki = (abi * lr - nr * li) / den;
    float* at = (float*)(ws + OFF_AT) + i * 2; gstf(at, abr); gstf(at + 1, abi);
    bf16_t* bbp = (bf16_t*)(ws + OFF_BB) + (size_t)ldg * 2048;
    const float* bre = p.in[16] + i * 16; const float* bim = p.in[17] + i * 16;
    for (int c = 0; c < 16; c += 2) {
      const float br0 = gldf(bre + c), bi0 = gldf(bim + c), br1 = gldf(bre + c + 1), bi1 = gldf(bim + c + 1);
      *(GAS unsigned*)(bbp + (size_t)pI * 16 + c) = pk2(kr * br0 - ki * bi0, kr * br1 - ki * bi1);
      *(GAS unsigned*)(bbp + (size_t)(64 + pI) * 16 + c) = pk2(kr * bi0 + ki * br0, kr * bi1 + ki * br1);
    }
    bf16_t* cmp = (bf16_t*)(ws + OFF_CM) + (size_t)ldg * 2048;
    for (int c = 0; c < 16; ++c) {
      const float cr = gldf(p.in[18] + ((size_t)ldg * 16 + c) * 64 + pI), ci = gldf(p.in[19] + ((size_t)ldg * 16 + c) * 64 + pI);
      *(GAS unsigned*)(cmp + (size_t)c * 128 + 2 * pI) = pk2(cr, -ci);
    }
  }
  for (size_t i = gt; i < 32768; i += GT) {
    const int pos = (int)(i >> 5), j = (int)(i & 31);
    const float inv = powf(10000.0f, -(float)(j & 15) / 16.0f);
    const float ang = (float)(j < 16 ? (pos >> 6) : (pos & 63)) * inv;
    float* rp = (float*)(ws + OFF_ROPE) + i * 2; gstf(rp, cosf(ang)); gstf(rp + 1, sinf(ang));
  }
  if (gt < 4) {
    const int l = (int)gt; float s1 = 0.f, s2 = 0.f;
    for (int k = 0; k < 64; ++k) { s1 += gldf(p.in[22] + l * 64 + k) * gldf(p.in[23] + l * 64 + k); s2 += gldf(p.in[24] + l * 64 + k) * gldf(p.in[25] + l * 64 + k); }
    const float lam_init = 0.8f - 0.6f * expf(-0.3f * (float)l);
    gstf((float*)(ws + OFF_LAM) + l, expf(s1) - expf(s2) + lam_init);
  }
}

DI void norm_phase(const Ctx& p, int layer, int sub, bool first, bool final_) {
  const int tid = opaque_tid(p.wv), lane = tid & 63, wave = tid >> 6;
  float* X = (float*)(p.ws + OFF_X); bf16_t* Nb = (bf16_t*)(p.ws + OFF_N);
  const int gw = blockIdx.x * 8 + wave, NGW = gridDim.x * 8;
  f32x4 vn[4];
  {
    const int row = gw < T_ALL ? gw : 0;
    const float* src = first ? (row < T_CTX ? p.in[0] + (size_t)row * DM : p.in[1] + (size_t)(row - T_CTX) * DM) : X + (size_t)row * DM;
#pragma unroll
    for (int j = 0; j < 4; ++j) vn[j] = ((const GAS f32x4*)src)[lane + 64 * j];
  }
  for (int row = gw; row < T_ALL; row += NGW) {
    f32x4 v[4]; float ss = 0.f;
#pragma unroll
    for (int j = 0; j < 4; ++j) { v[j] = vn[j]; ss += (v[j][0] * v[j][0] + v[j][1] * v[j][1]) + (v[j][2] * v[j][2] + v[j][3] * v[j][3]); }
    {
      const int rown = row + NGW < T_ALL ? row + NGW : row;
      const float* src = first ? (rown < T_CTX ? p.in[0] + (size_t)rown * DM : p.in[1] + (size_t)(rown - T_CTX) * DM) : X + (size_t)rown * DM;
#pragma unroll
      for (int j = 0; j < 4; ++j) vn[j] = ((const GAS f32x4*)src)[lane + 64 * j];
    }
    const float rstd = 1.0f / sqrtf(wave_sum(ss) * (1.f / DM) + 1e-6f);
    if (final_) {
      const float* g = p.in[31];
#pragma unroll
      for (int j = 0; j < 4; ++j) { const f32x4 gv = ((const GAS f32x4*)g)[lane + 64 * j]; ((GAS f32x4*)(p.out + (size_t)row * DM))[lane + 64 * j] = v[j] * rstd * gv; }
    } else {
      const int mrow = row < T_CTX ? 8 : ((row - T_CTX) >> 10);
      const float* md = (const float*)(p.ws + OFF_MOD) + ((size_t)layer * 9 + mrow) * 9216;
      const float* sh = md + (3 * sub) * 1024; const float* sc = md + (3 * sub + 1) * 1024; const float* g = p.in[7] + (size_t)(layer * 3 + sub) * DM;
#pragma unroll
      for (int j = 0; j < 4; ++j) {
        const f32x4 gv = ((const GAS f32x4*)g)[lane + 64 * j], sv = ((const GAS f32x4*)sc)[lane + 64 * j], hv = ((const GAS f32x4*)sh)[lane + 64 * j];
        const f32x4 y = v[j] * rstd * gv * (sv + 1.f) + hv;
        st_bf4(Nb + (size_t)row * DM + (lane + 64 * j) * 4, y);
        if (first) ((GAS f32x4*)(X + (size_t)row * DM))[lane + 64 * j] = v[j];
      }
    }
  }
}

DI s16x4 tr_read(unsigned lds_addr) { s16x4 r; asm volatile("ds_read_b64_tr_b16 %0, %1\n\ts_waitcnt lgkmcnt(0)" : "=&v"(r) : "v"(lds_addr) : "memory"); return r; }
#define MFMA32(a, b, c) __builtin_amdgcn_mfma_f32_32x32x16_bf16((a), (b), (c), 0, 0, 0)
#define MFMA16(a, b, c) __builtin_amdgcn_mfma_f32_16x16x32_bf16((a), (b), (c), 0, 0, 0)

DI void attn_item(const Ctx& p, int layer, bool lat, int seq, int head, int qblk, LAS unsigned char* lds) {
  const int tid = opaque_tid(p.wv), lane = tid & 63, wave = tid >> 6, r16 = lane & 15, g4 = lane >> 4;
  unsigned char* ws = p.ws;
  const bf16_t* Qg = (const bf16_t*)(ws + OFF_Q); const bf16_t* Kg = (const bf16_t*)(ws + OFF_K); const bf16_t* Vg = (const bf16_t*)(ws + OFF_V);
  const int tok0 = lat ? T_CTX + seq * 1024 : seq * 256;
  const int n_own = lat ? 16 : 4, n_tiles = lat ? 24 : 4;
  const bf16_t* Kc = (const bf16_t*)(ws + OFF_KC) + (size_t)(seq * 4 + layer) * 512 * 512;
  const bf16_t* Vc = (const bf16_t*)(ws + OFF_VC) + (size_t)(seq * 4 + layer) * 512 * 512;
  constexpr int RS = 272;
  LAS unsigned char* Kt = lds; LAS unsigned char* Vt = lds + 64 * RS;
  const int qtok = tok0 + qblk * 128 + wave * 16 + r16;
  bf16x8 Qf[2][2];
#pragma unroll
  for (int m = 0; m < 2; ++m)
#pragma unroll
    for (int kk = 0; kk < 2; ++kk) Qf[m][kk] = *(const GAS bf16x8*)(Qg + (size_t)qtok * 512 + head * 128 + m * 64 + g4 * 8 + 32 * kk);
  u32x4 kreg[2], vreg[2];
  auto issue = [&](int kt) {
    const bf16_t* kb; const bf16_t* vb;
    if (kt < n_own) { kb = Kg + (size_t)(tok0 + kt * 64) * 512 + head * 128; vb = Vg + (size_t)(tok0 + kt * 64) * 512 + head * 128; }
    else { kb = Kc + (size_t)((kt - n_own) * 64) * 512 + head * 128; vb = Vc + (size_t)((kt - n_own) * 64) * 512 + head * 128; }
#pragma unroll
    for (int i = 0; i < 2; ++i) { const int ci = tid + 512 * i, row = ci >> 4, part = ci & 15; kreg[i] = *(const GAS u32x4*)(kb + (size_t)row * 512 + part * 8); vreg[i] = *(const GAS u32x4*)(vb + (size_t)row * 512 + part * 8); }
  };
  issue(0);
  f32x4 O[2][8];
#pragma unroll
  for (int m = 0; m < 2; ++m)
#pragma unroll
    for (int d = 0; d < 8; ++d) O[m][d] = (f32x4){0.f, 0.f, 0.f, 0.f};
  float mrun[2] = {-1e30f, -1e30f}, lsum[2] = {0.f, 0.f};
  const unsigned vbase = (unsigned)(size_t)Vt;
  const int tq = r16 >> 2, tp = r16 & 3;
  for (int kt = 0; kt < n_tiles; ++kt) {
    __syncthreads();
#pragma unroll
    for (int i = 0; i < 2; ++i) { const int ci = tid + 512 * i, row = ci >> 4, part = ci & 15; *(LAS u32x4*)(Kt + row * RS + part * 16) = kreg[i]; *(LAS u32x4*)(Vt + row * RS + part * 16) = vreg[i]; }
    __syncthreads();
    if (kt + 1 < n_tiles) issue(kt + 1);
    bf16x8 P[2][2];
#pragma unroll
    for (int m = 0; m < 2; ++m) {
      f32x4 S[4];
#pragma unroll
      for (int kb = 0; kb < 4; ++kb) {
        S[kb] = (f32x4){0.f, 0.f, 0.f, 0.f};
#pragma unroll
        for (int kk = 0; kk < 2; ++kk) { const bf16x8 Kf = *(const LAS bf16x8*)(Kt + (16 * kb + r16) * RS + m * 128 + (g4 * 8 + 32 * kk) * 2); S[kb] = MFMA16(Kf, Qf[m][kk], S[kb]); }
      }
      float mx = S[0][0];
#pragma unroll
      for (int kb = 0; kb < 4; ++kb)
#pragma unroll
        for (int j = 0; j < 4; ++j) mx = fmaxf(mx, S[kb][j]);
      mx = fmaxf(mx, __shfl_xor(mx, 16)); mx = fmaxf(mx, __shfl_xor(mx, 32));
      const float mnew = fmaxf(mrun[m], mx), alpha = __builtin_amdgcn_exp2f(mrun[m] - mnew);
      mrun[m] = mnew;
      float ps = 0.f;
#pragma unroll
      for (int kb = 0; kb < 4; ++kb)
#pragma unroll
        for (int j = 0; j < 4; ++j) { S[kb][j] = __builtin_amdgcn_exp2f(S[kb][j] - mnew); ps += S[kb][j]; }
      lsum[m] = lsum[m] * alpha + ps;
#pragma unroll
      for (int d = 0; d < 8; ++d) O[m][d] *= alpha;
#pragma unroll
      for (int s = 0; s < 2; ++s) {
        u32x4 w; w.x = pk2(S[2 * s][0], S[2 * s][1]); w.y = pk2(S[2 * s][2], S[2 * s][3]); w.z = pk2(S[2 * s + 1][0], S[2 * s + 1][1]); w.w = pk2(S[2 * s + 1][2], S[2 * s + 1][3]);
        P[m][s] = __builtin_bit_cast(bf16x8, w);
      }
    }
#pragma unroll
    for (int s = 0; s < 2; ++s) {
      s16x4 v0, v1, v2, v3, v4, v5, v6, v7, v8, v9, v10, v11, v12, v13, v14, v15;
      const unsigned a0 = vbase + (32 * s + 4 * g4 + tq) * RS + 8 * tp;
      asm volatile(
        "ds_read_b64_tr_b16 %0, %16\n\tds_read_b64_tr_b16 %1, %16 offset:4352\n\t"
        "ds_read_b64_tr_b16 %2, %16 offset:32\n\tds_read_b64_tr_b16 %3, %16 offset:4384\n\t"
        "ds_read_b64_tr_b16 %4, %16 offset:64\n\tds_read_b64_tr_b16 %5, %16 offset:4416\n\t"
        "ds_read_b64_tr_b16 %6, %16 offset:96\n\tds_read_b64_tr_b16 %7, %16 offset:4448\n\t"
        "ds_read_b64_tr_b16 %8, %16 offset:128\n\tds_read_b64_tr_b16 %9, %16 offset:4480\n\t"
        "ds_read_b64_tr_b16 %10, %16 offset:160\n\tds_read_b64_tr_b16 %11, %16 offset:4512\n\t"
        "ds_read_b64_tr_b16 %12, %16 offset:192\n\tds_read_b64_tr_b16 %13, %16 offset:4544\n\t"
        "ds_read_b64_tr_b16 %14, %16 offset:224\n\tds_read_b64_tr_b16 %15, %16 offset:4576\n\t"
        "s_waitcnt lgkmcnt(0)"
        : "=&v"(v0), "=&v"(v1), "=&v"(v2), "=&v"(v3), "=&v"(v4), "=&v"(v5), "=&v"(v6), "=&v"(v7),
          "=&v"(v8), "=&v"(v9), "=&v"(v10), "=&v"(v11), "=&v"(v12), "=&v"(v13), "=&v"(v14), "=&v"(v15)
        : "v"(a0) : "memory");
#define ATT_PV(d, lo, hi) { const bf16x8 Vf = __builtin_shufflevector(lo, hi, 0, 1, 2, 3, 4, 5, 6, 7); O[0][d] = MFMA16(Vf, P[0][s], O[0][d]); O[1][d] = MFMA16(Vf, P[1][s], O[1][d]); }
      ATT_PV(0, v0, v1) ATT_PV(1, v2, v3) ATT_PV(2, v4, v5) ATT_PV(3, v6, v7) ATT_PV(4, v8, v9) ATT_PV(5, v10, v11) ATT_PV(6, v12, v13) ATT_PV(7, v14, v15)
#undef ATT_PV
    }
  }
  float l1 = lsum[0], l2 = lsum[1];
  l1 += __shfl_xor(l1, 16); l1 += __shfl_xor(l1, 32); l2 += __shfl_xor(l2, 16); l2 += __shfl_xor(l2, 32);
  const float lam = gldf((const float*)(ws + OFF_LAM) + layer);
  const float lam_init = 0.8f - 0.6f * expf(-0.3f * (float)layer);
  const float c1 = 1.f / l1, c2 = lam / l2;
  float ss = 0.f;
#pragma unroll
  for (int d = 0; d < 8; ++d) { const f32x4 o = O[0][d] * c1 - O[1][d] * c2; O[0][d] = o; ss += (o[0] * o[0] + o[1] * o[1]) + (o[2] * o[2] + o[3] * o[3]); }
  ss += __shfl_xor(ss, 16); ss += __shfl_xor(ss, 32);
  const float rn = (1.f - lam_init) / sqrtf(ss * (1.f / 128.f) + 1e-6f);
  const float* ag = p.in[26] + layer * 128;
  bf16_t* yb = (bf16_t*)(ws + OFF_YS) + (size_t)T_ALL * 512 + (size_t)qtok * 512 + head * 128;
#pragma unroll
  for (int d = 0; d < 8; ++d) {
    const int dv = 16 * d + 4 * g4;
    const f32x4 gv = *(const GAS f32x4*)(ag + dv);
    st_bf4(yb + dv, O[0][d] * rn * gv);
  }
}

DI void s5_item(const Ctx& p, int layer, bool lat, int pairIdx, int gsel, LAS unsigned char* lds) {
  const int tid = opaque_tid(p.wv), lane = tid & 63, wave = __builtin_amdgcn_readfirstlane(tid >> 6), r32 = lane & 31, h = lane >> 5;
  unsigned char* ws = p.ws;
  const int d = wave & 1, g = lat ? gsel : gsel * 4 + (wave >> 1), chunk = lat ? (wave >> 1) : 0;
  const int L = lat ? 1024 : 256;
  constexpr int nt = 16;
  const int seq0 = pairIdx * 2;
  const int tb0 = (lat ? T_CTX + seq0 * 1024 : seq0 * 256) + chunk * 256;
  const int ldg = (layer * 2 + d) * 32 + g;
  const float* at = (const float*)(ws + OFF_AT) + (size_t)ldg * 128;
  const float a0r = gldf(at + r32 * 2), a0i = gldf(at + r32 * 2 + 1), a1r = gldf(at + (r32 + 32) * 2), a1i = gldf(at + (r32 + 32) * 2 + 1);
  float h0r = 0.f, h0i = 0.f, h1r = 0.f, h1i = 0.f;
  if (lat) {
    const float* st = p.in[4] + ((size_t)(((seq0 + h) * 4 + layer) * 2 + d) * 2) * 2048 + g * 64;
    h0r = gldf(st + r32); h1r = gldf(st + r32 + 32); h0i = gldf(st + 2048 + r32); h1i = gldf(st + 2048 + r32 + 32);
  }
  bf16x8 BBf[4], Cmf[4];
  {
    const bf16_t* bb = (const bf16_t*)(ws + OFF_BB) + (size_t)ldg * 2048;
    const bf16_t* cm = (const bf16_t*)(ws + OFF_CM) + (size_t)ldg * 2048;
#pragma unroll
    for (int b = 0; b < 4; ++b) { BBf[b] = *(const GAS bf16x8*)(bb + (size_t)(b * 32 + r32) * 16 + h * 8); Cmf[b] = *(const GAS bf16x8*)(cm + (size_t)(lane & 15) * 128 + (lane >> 4) * 8 + 32 * b); }
  }
  const bf16_t* U = (const bf16_t*)(ws + OFF_UH);
  float* YP = (float*)(ws + OFF_YP);
  bf16_t* YA = (bf16_t*)(ws + OFF_YA);
  const int sA = (r32 >> 2) & 1, iA = 4 * (r32 >> 3) + (r32 & 3);
  const bf16_t* uA = U + (size_t)(tb0 + sA * L + iA) * INW + g * 16 + h * 8;
  constexpr int RS = 272;
  LAS unsigned char* hb = lds + wave * (32 * RS);
  const f32x4 dsk = *(const GAS f32x4*)(p.in[20] + layer * 512 + g * 16 + (lane >> 4) * 4);
  __syncthreads();
  if (lat) {
    float e0r = 0.f, e0i = 0.f, e1r = 0.f, e1i = 0.f;
    const bool need = d == 0 ? chunk < 3 : chunk > 0;
    if (need) {
      bf16x8 Af1 = *(const GAS bf16x8*)(uA + (size_t)(d ? nt - 1 : 0) * 16 * INW);
      for (int n = 0; n < nt; ++n) {
        const int tile = d ? nt - 1 - n : n;
        const int tilen = (n + 1 < nt) ? (d ? tile - 1 : tile + 1) : tile;
        const bf16x8 Afn = *(const GAS bf16x8*)(uA + (size_t)tilen * 16 * INW);
        f32x16 x0, x1, x2, x3;
#pragma unroll
        for (int i = 0; i < 16; ++i) { x0[i] = 0.f; x1[i] = 0.f; x2[i] = 0.f; x3[i] = 0.f; }
        x0 = MFMA32(Af1, BBf[0], x0); x1 = MFMA32(Af1, BBf[1], x1); x2 = MFMA32(Af1, BBf[2], x2); x3 = MFMA32(Af1, BBf[3], x3);
#define S5_STEP1(i) { const float nr0 = a0r * e0r - a0i * e0i + x0[i], ni0 = a0r * e0i + a0i * e0r + x2[i]; e0r = nr0; e0i = ni0; \
                      const float nr1 = a1r * e1r - a1i * e1i + x1[i], ni1 = a1r * e1i + a1i * e1r + x3[i]; e1r = nr1; e1i = ni1; }
        if (d == 0) {
#pragma unroll
          for (int i = 0; i < 16; ++i) S5_STEP1(i)
        } else {
#pragma unroll
          for (int i = 15; i >= 0; --i) S5_STEP1(i)
        }
#undef S5_STEP1
        Af1 = Afn;
      }
    }
    LAS float* Eb = (LAS float*)(lds + 8 * 32 * RS);
    Eb[(wave * 4 + 0) * 64 + lane] = e0r; Eb[(wave * 4 + 1) * 64 + lane] = e0i; Eb[(wave * 4 + 2) * 64 + lane] = e1r; Eb[(wave * 4 + 3) * 64 + lane] = e1i;
    __syncthreads();
    float p0r = a0r, p0i = a0i, p1r = a1r, p1i = a1i;
#pragma unroll
    for (int q = 0; q < 8; ++q) { const float t0 = p0r * p0r - p0i * p0i, u0 = 2.f * p0r * p0i; p0r = t0; p0i = u0; const float t1 = p1r * p1r - p1i * p1i, u1 = 2.f * p1r * p1i; p1r = t1; p1i = u1; }
    const int nprev = d == 0 ? chunk : 3 - chunk;
    for (int q = 0; q < nprev; ++q) {
      const int j = d == 0 ? q : 3 - q, wj = j * 2 + d;
      const float f0r = Eb[(wj * 4 + 0) * 64 + lane], f0i = Eb[(wj * 4 + 1) * 64 + lane], f1r = Eb[(wj * 4 + 2) * 64 + lane], f1i = Eb[(wj * 4 + 3) * 64 + lane];
      const float n0r = p0r * h0r - p0i * h0i + f0r, n0i = p0r * h0i + p0i * h0r + f0i; h0r = n0r; h0i = n0i;
      const float n1r = p1r * h1r - p1i * h1i + f1r, n1i = p1r * h1i + p1i * h1r + f1i; h1r = n1r; h1i = n1i;
    }
  }
  bf16x8 Af = *(const GAS bf16x8*)(uA + (size_t)(d ? nt - 1 : 0) * 16 * INW);
  for (int n = 0; n < nt; ++n) {
    if (n == nt / 2) __syncthreads();
    const int tile = d ? nt - 1 - n : n;
    const int tilen = (n + 1 < nt) ? (d ? tile - 1 : tile + 1) : tile;
    const bf16x8 Afn = *(const GAS bf16x8*)(uA + (size_t)tilen * 16 * INW);
    const bool second = n >= nt / 2;
    f32x4 po[2] = {{0.f, 0.f, 0.f, 0.f}, {0.f, 0.f, 0.f, 0.f}}; u32x2 pu[2] = {{0u, 0u}, {0u, 0u}};
    if (second) {
#pragma unroll
      for (int ss = 0; ss < 2; ++ss) {
        const int tok = tb0 + ss * L + tile * 16 + (lane & 15), ch = g * 16 + (lane >> 4) * 4;
        po[ss] = *(const GAS f32x4*)(YP + ((size_t)(1 - d) * T_ALL + tok) * 512 + ch);
        pu[ss] = *(const GAS u32x2*)(U + (size_t)tok * INW + ch);
      }
    }
    f32x16 x0, x1, x2, x3;
#pragma unroll
    for (int i = 0; i < 16; ++i) { x0[i] = 0.f; x1[i] = 0.f; x2[i] = 0.f; x3[i] = 0.f; }
    x0 = MFMA32(Af, BBf[0], x0); x1 = MFMA32(Af, BBf[1], x1); x2 = MFMA32(Af, BBf[2], x2); x3 = MFMA32(Af, BBf[3], x3);
#define S5_STEP(i) { const float nr0 = a0r * h0r - a0i * h0i + x0[i], ni0 = a0r * h0i + a0i * h0r + x2[i]; h0r = nr0; h0i = ni0; \
                     const float nr1 = a1r * h1r - a1i * h1i + x1[i], ni1 = a1r * h1i + a1i * h1r + x3[i]; h1r = nr1; h1i = ni1; \
                     *(LAS unsigned*)(hb + (h * 16 + (i)) * RS + r32 * 4) = pk2(h0r, h0i); *(LAS unsigned*)(hb + (h * 16 + (i)) * RS + (r32 + 32) * 4) = pk2(h1r, h1i); }
    if (d == 0) {
#pragma unroll
      for (int i = 0; i < 16; ++i) S5_STEP(i)
    } else {
#pragma unroll
      for (int i = 15; i >= 0; --i) S5_STEP(i)
    }
#undef S5_STEP
    LDS_WAIT();
#pragma unroll
    for (int ss = 0; ss < 2; ++ss) {
      f32x4 y = {0.f, 0.f, 0.f, 0.f};
#pragma unroll
      for (int kb = 0; kb < 4; ++kb) { const bf16x8 Hf = *(const LAS bf16x8*)(hb + (ss * 16 + (lane & 15)) * RS + ((lane >> 4) * 8 + 32 * kb) * 2); y = MFMA16(Cmf[kb], Hf, y); }
      const int tok = tb0 + ss * L + tile * 16 + (lane & 15), ch = g * 16 + (lane >> 4) * 4;
      if (!second) {
        *(GAS f32x4*)(YP + ((size_t)d * T_ALL + tok) * 512 + ch) = y;
      } else {
        const f32x4 uu = {bflo(pu[ss].x), bfhi(pu[ss].x), bflo(pu[ss].y), bfhi(pu[ss].y)};
        f32x4 v = y + po[ss] + uu * dsk, r;
#pragma unroll
        for (int j = 0; j < 4; ++j) { const float t = v[j]; r[j] = t * sigmoidf_(1.5957691216057308f * (t + 0.044715f * t * t * t)); }
        st_bf4(YA + (size_t)tok * 512 + ch, r);
      }
    }
    LDS_WAIT();
    Af = Afn;
  }
  if (!lat) {
    float* so = p.out + 12582912 + 8388608 + 8388608 + ((size_t)(((seq0 + h) * 4 + layer) * 2 + d) * 2) * 2048 + g * 64;
    gstf(so + r32, h0r); gstf(so + r32 + 32, h1r); gstf(so + 2048 + r32, h0i); gstf(so + 2048 + r32 + 32, h1i);
  }
}

template <int W>
DI void pool_body(const Ctx& p, int layer, int g, int t0, int lane) {
  const int r32 = lane & 31, h = lane >> 5;
  unsigned char* ws = p.ws;
  const int t = t0 + r32;
  const int sbase = t < T_CTX ? (t & ~255) : T_CTX + ((t - T_CTX) & ~1023), L = t < T_CTX ? 256 : 1024, tl = t - sbase;
  int lo = tl - W / 2, hi = lo + W; lo = lo < 0 ? 0 : lo; hi = hi > L ? L : hi;
  const float inv = 1.f / (float)(hi - lo);
  const bf16_t* Z = (const bf16_t*)(ws + OFF_UH) + 2048 + g * 128 + h * 8;
  bf16x8 Af[8];
#pragma unroll
  for (int kk = 0; kk < 8; ++kk) {
    u32x4 zz[W]; float ff[W];
#pragma unroll
    for (int dt = 0; dt < W; ++dt) {
      const int tp = tl - W / 2 + dt; const bool ok = tp >= 0 && tp < L; const int tc = ok ? tp : tl; ff[dt] = ok ? 1.f : 0.f;
      zz[dt] = *(const GAS u32x4*)(Z + (size_t)(sbase + tc) * INW + 16 * kk);
    }
    float s[8];
#pragma unroll
    for (int j = 0; j < 8; ++j) s[j] = 0.f;
#pragma unroll
    for (int dt = 0; dt < W; ++dt) {
      const u32x4 z = zz[dt]; const float f = ff[dt];
      s[0] += f * bflo(z.x); s[1] += f * bfhi(z.x); s[2] += f * bflo(z.y); s[3] += f * bfhi(z.y); s[4] += f * bflo(z.z); s[5] += f * bfhi(z.z); s[6] += f * bflo(z.w); s[7] += f * bfhi(z.w);
    }
    const u32x4 z = zz[W / 2];
    u32x4 o;
    o.x = pk2(s[0] * inv - bflo(z.x), s[1] * inv - bfhi(z.x)); o.y = pk2(s[2] * inv - bflo(z.y), s[3] * inv - bfhi(z.y));
    o.z = pk2(s[4] * inv - bflo(z.z), s[5] * inv - bfhi(z.z)); o.w = pk2(s[6] * inv - bflo(z.w), s[7] * inv - bfhi(z.w));
    Af[kk] = __builtin_bit_cast(bf16x8, o);
  }
  const bf16_t* Wp = (const bf16_t*)(ws + OFF_W) + (size_t)layer * W_LAYER + W_P + (size_t)g * 16384;
  bf16_t* yc = (bf16_t*)(ws + OFF_YS) + (size_t)2 * T_ALL * 512;
#pragma unroll
  for (int nb = 0; nb < 4; ++nb) {
    f32x16 acc;
#pragma unroll
    for (int i = 0; i < 16; ++i) acc[i] = 0.f;
#pragma unroll
    for (int kk = 0; kk < 8; ++kk) { const bf16x8 Bf = *(const GAS bf16x8*)(Wp + (size_t)(nb * 32 + r32) * 128 + h * 8 + 16 * kk); acc = MFMA32(Af[kk], Bf, acc); }
    const int dcol = g * 128 + nb * 32 + r32;
    const float sc = gldf(p.in[28] + layer * 512 + dcol);
#pragma unroll
    for (int i = 0; i < 16; ++i) { const int row = 8 * (i >> 2) + 4 * h + (i & 3); *(GAS bf16_t*)(yc + (size_t)(t0 + row) * 512 + dcol) = (bf16_t)(pk2(acc[i] * sc, 0.f) & 0xffffu); }
  }
}
DI void pool_item(const Ctx& p, int layer, int item) {
  const int tid = opaque_tid(p.wv), lane = tid & 63, wave = __builtin_amdgcn_readfirstlane(tid >> 6);
  const int wi = item * 8 + wave, tt = wi >> 2, g = wi & 3, t0 = tt * 32;
  if (g == 0) pool_body<2>(p, layer, 0, t0, lane);
  else if (g == 1) pool_body<4>(p, layer, 1, t0, lane);
  else if (g == 2) pool_body<8>(p, layer, 2, t0, lane);
  else pool_body<16>(p, layer, 3, t0, lane);
}

DI void mixer_item(const Ctx& p, int layer, int it, LAS unsigned char* lds) {
  if (it < 128) s5_item(p, layer, true, it >> 5, it & 31, lds);
  else if (it < 192) { const int j = it - 128; s5_item(p, layer, false, j >> 3, j & 7, lds); }
  else if (it < 448) { const int j = it - 192; attn_item(p, layer, true, j >> 5, (j >> 3) & 3, j & 7, lds); }
  else if (it < 576) { const int j = it - 448; attn_item(p, layer, false, j >> 3, (j >> 1) & 3, j & 1, lds); }
  else pool_item(p, layer, it - 576);
}
DI void mixer_phase(const Ctx& p, int layer, LAS unsigned char* lds) {
  constexpr int NIT = 576 + 192;
  const int Gd = gridDim.x, w = blockIdx.x;
  for (int r = 0;; ++r) {
    const int it = r * Gd + ((r & 1) ? Gd - 1 - w : w);
    if (r * Gd >= NIT) break;
    if (it < NIT) mixer_item(p, layer, it, lds);
  }
}

#define XB_TMO      128
#define XB_XCNT(j)  (256  + 64 * (j))
#define XB_XSUB(j)  (1280 + 64 * (j))
#define XB_XGEN(j)  (2304 + 64 * (j))
#define XB_TOP      3328
#define XB_TOPGEN   3392
#define XCD_BAR_WORDS 3456
#define XB_SPIN_CAP (1u << 22)
DI unsigned xb_ld(unsigned* p)              { return __hip_atomic_load(p, __ATOMIC_RELAXED, __HIP_MEMORY_SCOPE_AGENT); }
DI unsigned xb_add(unsigned* p, unsigned v) { return __hip_atomic_fetch_add(p, v, __ATOMIC_RELAXED, __HIP_MEMORY_SCOPE_AGENT); }
DI unsigned xb_xcc_id() { return (unsigned)__builtin_amdgcn_s_getreg((3 << 11) | 20) & 0xFu; }
#define XB_SPIN(cond, bar) do { unsigned _sp = 0; while (cond) { __builtin_amdgcn_s_sleep(1); \
    if ((++_sp & 255u) == 0u) { if (xb_ld(&(bar)[XB_TMO])) break; if (_sp > XB_SPIN_CAP) { atomicAdd(&(bar)[XB_TMO], 1u); break; } } } } while (0)
struct XcdBarrier { unsigned* bar; unsigned x; volatile LAS unsigned* st; int wv; };
DI XcdBarrier xcd_barrier_post(unsigned* bar, volatile LAS unsigned* st) {
  XcdBarrier b; b.bar = bar; b.x = xb_xcc_id(); b.st = st; b.wv = 0;
  if (threadIdx.x == 0) (void)xb_add(&bar[XB_XCNT(b.x)], 1u);
  return b;
}
DI void xcd_barrier_complete(unsigned* bar, unsigned x, unsigned& nloc, unsigned& nx) {
  const unsigned G = gridDim.x * gridDim.y * gridDim.z;
  unsigned sum, cnt, mine, sp = 0u;
  for (;;) {
    sum = 0u; cnt = 0u; mine = 0u;
#pragma unroll
    for (unsigned j = 0; j < 16; ++j) { const unsigned c = xb_ld(&bar[XB_XCNT(j)]); sum += c; cnt += (c > 0u) ? 1u : 0u; mine = (j == x) ? c : mine; }
    if (sum == G) break;
    __builtin_amdgcn_s_sleep(1);
    if ((++sp & 255u) == 0u) { if (xb_ld(&bar[XB_TMO])) break; if (sp > XB_SPIN_CAP) { atomicAdd(&bar[XB_TMO], 1u); break; } }
  }
  nloc = mine > 0u ? mine : 1u; nx = cnt > 0u ? cnt : 1u;
}
DI void xcd_barrier(const XcdBarrier& b) {
  asm volatile("s_waitcnt vmcnt(0)" ::: "memory");
  __syncthreads();
  if (b.wv == 0 && __builtin_amdgcn_mbcnt_hi(~0u, __builtin_amdgcn_mbcnt_lo(~0u, 0u)) == 0u) {
    unsigned* bar = b.bar;
    __builtin_amdgcn_s_waitcnt(0);
    unsigned nloc = b.st[0], nx = b.st[1];
    if (nloc == 0u) { xcd_barrier_complete(bar, b.x, nloc, nx); b.st[0] = nloc; b.st[1] = nx; }
    const unsigned old = xb_add(&bar[XB_XSUB(b.x)], 1u);
    const unsigned gen = old / nloc;
    if (old + 1u == (gen + 1u) * nloc) {
      __builtin_amdgcn_fence(__ATOMIC_RELEASE, "agent");
      asm volatile("s_waitcnt vmcnt(0)" ::: "memory");
      const unsigned og = xb_add(&bar[XB_TOP], 1u);
      const unsigned tg = og / nx;
      if (og + 1u == (tg + 1u) * nx) xb_add(&bar[XB_TOPGEN], 1u);
      else XB_SPIN(xb_ld(&bar[XB_TOPGEN]) == tg, bar);
      __builtin_amdgcn_fence(__ATOMIC_ACQUIRE, "agent");
      xb_add(&bar[XB_XGEN(b.x)], 1u);
      asm volatile("s_waitcnt vmcnt(0)" ::: "memory");
    } else {
      XB_SPIN(xb_ld(&bar[XB_XGEN(b.x)]) == gen, bar);
      __builtin_amdgcn_fence(__ATOMIC_ACQUIRE, "agent");
      asm volatile("s_waitcnt vmcnt(0)" ::: "memory");
    }
  }
  __syncthreads();
}

__global__ void __launch_bounds__(512, 2) fwd_megakernel(Params p0) {
  extern __shared__ __attribute__((aligned(16))) unsigned char shm[];
  LAS unsigned char* lds = (LAS unsigned char*)shm;
  const int G = gridDim.x, c = blockIdx.x;
  const int wv0 = __builtin_amdgcn_readfirstlane((int)threadIdx.x >> 6);
  __shared__ uint4 xb_words;
  if (threadIdx.x == 0) xb_words = make_uint4(0u, 0u, 0u, 0u);
  __syncthreads();
  XcdBarrier xb = xcd_barrier_post((unsigned*)(p0.ws + OFF_BAR), (volatile LAS unsigned*)&xb_words); xb.wv = wv0;
  for (int phi = p0.ph_lo; phi < p0.ph_hi; ++phi) {
    int ph = phi; asm volatile("" : "+s"(ph));
    Ctx p; p.in.pp = &p0; p.out = p0.out; p.ws = p0.ws; p.wv = wv0;
    asm volatile("" : "+s"(p.out)); asm volatile("" : "+s"(p.ws));
    unsigned char* ws = p.ws;
    if (ph == 0) prep_phase(p, lds);
    else if (ph == NPH - 1) norm_phase(p, 0, 0, false, true);
    else {
      const int layer = (ph - 1) / 12, s = (ph - 1) % 12;
      const bf16_t* wl = (const bf16_t*)(ws + OFF_W) + (size_t)layer * W_LAYER;
      const float* modl = (const float*)(ws + OFF_MOD) + (size_t)layer * 9 * 9216;
      bf16_t* Nb = (bf16_t*)(ws + OFF_N); bf16_t* UH = (bf16_t*)(ws + OFF_UH); float* X = (float*)(ws + OFF_X);
      if (s == 0) norm_phase(p, layer, 0, layer == 0, false);
      else if (s == 3) norm_phase(p, layer, 1, false, false);
      else if (s == 9) norm_phase(p, layer, 2, false, false);
      else if (s == 1 || s == 10) {
        const int f = s == 10;
        if (layer < 3) { tr_slice(p, lds, layer + 1, f); __syncthreads(); }
        pg8::Gemm g{Nb, wl + W_FI + (size_t)f * 5632 * 1024, T_ALL, 5632, 1024};
        pg8::StaticOrder S; S.init(g.M, g.N, G, c);
        EpiSwiglu E{UH};
        pg8::gemm_phase(lds, g, S, E, p.wv);
      } else if (s == 2 || s == 11) {
        const int f = s == 11;
        pg8::Gemm g{UH, wl + W_FO + (size_t)f * 1024 * 2816, T_ALL, 1024, 2816};
        pg8::StaticOrder S; S.init(g.M, g.N, G, c);
        EpiResid E{X, modl, f ? 8 : 2, 0.5f};
        pg8::gemm_phase(lds, g, S, E, p.wv);
      } else if (s == 4) {
        pg8::Gemm g{Nb, wl + W_IN, T_ALL, 5632, 1024};
        pg8::StaticOrder S; S.init(g.M, g.N, G, c);
        EpiWin E{UH, (bf16_t*)(ws + OFF_Q), (bf16_t*)(ws + OFF_K), (bf16_t*)(ws + OFF_V), p.out + 12582912, p.out + 12582912 + 8388608, (const float*)(ws + OFF_ROPE), layer};
        pg8::gemm_phase(lds, g, S, E, p.wv);
      } else if (s == 5) {
        mixer_phase(p, layer, lds);
      } else if (s == 6) {
        pg8::Gemm g{(const bf16_t*)(ws + OFF_YA), wl + W_GLU, T_ALL, 512, 512};
        pg8::StaticOrder S; S.init(g.M, g.N, G, c);
        EpiGlu E{(const bf16_t*)(ws + OFF_YA), (bf16_t*)(ws + OFF_YS)};
        pg8::gemm_phase(lds, g, S, E, p.wv);
      } else if (s == 7) {
        pg8::Gemm g{(const bf16_t*)(ws + OFF_YS), wl + W_BR, 3 * T_ALL, 3072, 512};
        pg8::BranchOrder S{G, c};
        EpiBranch E{UH, (float*)(ws + OFF_YP), Nb};
        pg8::gemm_phase(lds, g, S, E, p.wv);
      } else if (s == 8) {
        pg8::Gemm g{Nb, wl + W_OUT, T_ALL, 1024, 1024};
        pg8::StaticOrder S; S.init(g.M, g.N, G, c);
        EpiResid E{X, modl, 5, 1.0f};
        pg8::gemm_phase(lds, g, S, E, p.wv);
      }
    }
    if (phi + 1 < p0.ph_hi) { if (phi == p0.ph_lo) cg::this_grid().sync(); else xcd_barrier(xb); }
  }
}

extern "C" void kernel_launch(void* const* d_in, const int* in_sizes, int n_in, void* d_out, int out_size, void* d_ws, size_t ws_size, hipStream_t stream) {
  static int grid = 0;
  if (grid == 0) {
    int dev = 0, cus = 0, per_cu = 0;
    hipGetDevice(&dev);
    hipDeviceGetAttribute(&cus, hipDeviceAttributeMultiprocessorCount, dev);
    if (hipFuncSetAttribute((const void*)fwd_megakernel, hipFuncAttributeMaxDynamicSharedMemorySize, LDS_BYTES) != hipSuccess) fprintf(stderr, "hipFuncSetAttribute failed\n");
    hipOccupancyMaxActiveBlocksPerMultiprocessor(&per_cu, (const void*)fwd_megakernel, 512, LDS_BYTES);
    if (per_cu < 1) { fprintf(stderr, "occupancy query gave %d\n", per_cu); per_cu = 1; }
    (void)hipGetLastError();
    grid = cus * per_cu;
    if (ws_size < WS_END) fprintf(stderr, "workspace too small: %zu\n", ws_size);
  }
  if (hipMemsetAsync((unsigned char*)d_ws + OFF_BAR, 0, 16384, stream) != hipSuccess) fprintf(stderr, "memset failed\n");
  Params p{};
  for (int i = 0; i < 32; ++i) p.in[i] = (const float*)d_in[i];
  p.out = (float*)d_out; p.ws = (unsigned char*)d_ws;
#if COOP
  p.ph_lo = 0; p.ph_hi = NPH;
  void* args[] = {&p};
  hipError_t e = hipLaunchCooperativeKernel((const void*)fwd_megakernel, dim3(grid), dim3(512), args, LDS_BYTES, stream);
  if (e != hipSuccess) fprintf(stderr, "cooperative launch failed: %s (grid %d)\n", hipGetErrorString(e), grid);
#else
  for (int ph = 0; ph < NPH; ++ph) {
    p.ph_lo = ph; p.ph_hi = ph + 1;
    hipLaunchKernelGGL(fwd_megakernel, dim3(grid), dim3(512), LDS_BYTES, stream, p);
  }
#endif
}
```

```cpp
#include <hip/hip_runtime.h>
#include <hip/hip_cooperative_groups.h>
#include <cstdio>
namespace cg = cooperative_groups;

#ifndef COOP
#define COOP 1
#endif

#define LAS __attribute__((address_space(3)))
#define GAS __attribute__((address_space(1)))
typedef unsigned short bf16_t;
typedef short bf16x8 __attribute__((ext_vector_type(8)));
typedef short s16x4 __attribute__((ext_vector_type(4)));
typedef float f32x2 __attribute__((ext_vector_type(2)));
typedef float f32x4 __attribute__((ext_vector_type(4)));
typedef float f32x16 __attribute__((ext_vector_type(16)));
typedef unsigned u32x4 __attribute__((ext_vector_type(4)));
typedef unsigned u32x2 __attribute__((ext_vector_type(2)));
typedef __bf16 nbf16x2 __attribute__((ext_vector_type(2)));
#define DI __device__ __forceinline__

constexpr int T_CTX = 4096, T_ALL = 12288, DM = 1024, DFF = 2816, INW = 5632, NPH = 50;
constexpr size_t OFF_X = 0;
constexpr size_t OFF_N = OFF_X + 50331648;
constexpr size_t OFF_UH = OFF_N + 25165824;
constexpr size_t OFF_Q = OFF_UH + 138412032;
constexpr size_t OFF_K = OFF_Q + 12582912;
constexpr size_t OFF_V = OFF_K + 12582912;
constexpr size_t OFF_KC = OFF_V + 12582912;
constexpr size_t OFF_VC = OFF_KC + 16777216;
constexpr size_t OFF_YP = OFF_VC + 16777216;
constexpr size_t OFF_YA = OFF_YP + 50331648;
constexpr size_t OFF_YS = OFF_YA + 12582912;
constexpr size_t OFF_MOD = OFF_YS + 37748736;
constexpr size_t OFF_BB = OFF_MOD + 1327104;
constexpr size_t OFF_CM = OFF_BB + 1048576;
constexpr size_t OFF_AT = OFF_CM + 1048576;
constexpr size_t OFF_ROPE = OFF_AT + 131072;
constexpr size_t OFF_LAM = OFF_ROPE + 262144;
constexpr size_t OFF_W = OFF_LAM + 256;
constexpr size_t W_FI = 0;
constexpr size_t W_FO = W_FI + 11534336;
constexpr size_t W_IN = W_FO + 5767168;
constexpr size_t W_GLU = W_IN + 5767168;
constexpr size_t W_BR = W_GLU + 262144;
constexpr size_t W_OUT = W_BR + 1572864;
constexpr size_t W_P = W_OUT + 1048576;
constexpr size_t W_LAYER = W_P + 65536;
constexpr size_t OFF_BAR = OFF_W + 4 * W_LAYER * 2;
constexpr size_t WS_END = OFF_BAR + 16384;
constexpr int LDS_BYTES = 131072;

struct Params {
  const float* in[32];
  float* out;
  unsigned char* ws;
  int ph_lo, ph_hi;
};
struct InTab { const Params* pp; __device__ __forceinline__ const float* operator[](int i) const { asm volatile("" : "+s"(i)); return pp->in[i]; } };
struct Ctx { InTab in; float* out; unsigned char* ws; int wv; };

DI int opaque_tid(int wv) { int t = wv * 64 + (int)__builtin_amdgcn_mbcnt_hi(~0u, __builtin_amdgcn_mbcnt_lo(~0u, 0u)); asm volatile("" : "+v"(t)); return t; }
DI unsigned pk2(float lo, float hi) { f32x2 v = {lo, hi}; nbf16x2 b = __builtin_convertvector(v, nbf16x2); return __builtin_bit_cast(unsigned, b); }
DI float gldf(const float* p) { return *(const GAS float*)p; }
DI void gstf(float* p, float v) { *(GAS float*)p = v; }
DI float bf2f(unsigned short b) { return __uint_as_float(((unsigned)b) << 16); }
DI float bflo(unsigned u) { return __uint_as_float(u << 16); }
DI float bfhi(unsigned u) { return __uint_as_float(u & 0xffff0000u); }
DI float sigmoidf_(float x) { return __builtin_amdgcn_rcpf(1.f + __expf(-x)); }
DI float wave_sum(float v) {
#pragma unroll
  for (int o = 1; o < 64; o <<= 1) v += __shfl_xor(v, o);
  return v;
}
#define LDS_WAIT() asm volatile("s_waitcnt lgkmcnt(0)" ::: "memory")

namespace pg8 {
constexpr int BM = 256, BK = 64, HALF = 128, HTB = HALF * BK * 2, NXCD = 8, WGM = 8;
DI int lds_byte(int r, int c) { const int st = (r >> 4) * 2 + (c >> 5), rr = r & 15, cc = c & 31, ob = rr * 64 + cc * 2; return st * 1024 + (ob ^ (((ob >> 9) & 1) << 5)); }
DI void stage_rc(int b, int& R, int& C) { const int st = b / 1024, sb = b % 1024, swz = sb ^ (((sb >> 9) & 1) << 5); R = (st >> 1) * 16 + swz / 64; C = (st & 1) * 32 + (swz % 64) / 2; }
struct Unit { int pm, pn; };
struct Gemm { const bf16_t* A; const bf16_t* Bt; int M, N, K; };
struct StaticOrder {
  int nM, nN, nwg, G, c;
  DI void init(int M, int N, int G_, int c_) { nM = M / BM; nN = N / BM; nwg = nM * nN; G = G_; c = c_; }
  DI bool next(int i, Unit& u) const {
    const long L = (long)i * G + c; if (L >= nwg) return false;
    int wgid = (int)L; { const int q = nwg / NXCD, r = nwg % NXCD, xcd = wgid % NXCD, off = wgid / NXCD; wgid = (xcd < r ? xcd * (q + 1) : r * (q + 1) + (xcd - r) * q) + off; }
    const int nig = WGM * nN, gid = wgid / nig, fm = gid * WGM, gsz = (nM - fm) < WGM ? (nM - fm) : WGM;
    u.pm = fm + ((wgid % nig) % gsz); u.pn = (wgid % nig) / gsz; return true;
  }
};
struct MixAOrder {
  int G, c;
  DI bool next(int i, Unit& u) const {
    int job, sub;
    if (G == 256) {
      if (c < 192) { if (i >= 2) return false; job = c; sub = i; }
      else { const int q = (c - 192) + 64 * i; if (i >= 2 || q >= 96) return false; job = 192 + q; sub = 0; }
    } else {
      const int np = c < 192 ? (191 - c) / G + 1 : 0;
      if (i < 2 * np) { job = c + (i >> 1) * G; sub = i & 1; }
      else { job = c + (np + (i - 2 * np)) * G; sub = 0; if (job >= 288) return false; }
    }
    if (job < 192) { const int n = 1 + sub; u.pm = 48 * (n + 1) + (job >> 2); u.pn = 2 + 4 * n + (job & 3); }
    else { const int q = job - 192; u.pm = q >> 1; u.pn = q & 1; }
    return true;
  }
};
struct MixBOrder {
  int G, c;
  DI bool next(int i, Unit& u) const { const int tile = i * G + c; if (tile >= 192) return false; u.pm = 48 + (tile >> 2); u.pn = 2 + (tile & 3); return true; }
};

template <class Epi, class Sched>
DI void gemm_phase(LAS unsigned char* lds, const Gemm g, const Sched& S, const Epi& E, int wv) {
  const int tid = opaque_tid(wv), wid = __builtin_amdgcn_readfirstlane(tid >> 6), lane = tid & 63, wr = wid >> 2, wc = wid & 3, fr = lane & 15, fq = lane >> 4;
  const int K = g.K, nt = K / BK;
  unsigned voffA[2], voffB[2];
#pragma unroll
  for (int i = 0; i < 2; ++i) { int R, C; stage_rc(tid * 16 + i * 8192, R, C); voffA[i] = (unsigned)(R * K + C) * 2u; voffB[i] = voffA[i]; }
  const size_t kstep = (size_t)(BK * 2);
  const size_t hstep = (size_t)HALF * K * 2;
  const size_t tstep = 2 * hstep;
  const unsigned ldsw = (unsigned)wid * 1024u;
  const int aoff = lds_byte(wr * 64 + fr, fq * 8), boff = lds_byte(wc * 32 + fr, fq * 8);
#define PG8_SA(b, h) (((b) * 2 + (h)) * HTB)
#define PG8_SB(b, h) ((4 + (b) * 2 + (h)) * HTB)
#define PG8_STAGE(bufoff, gbase, voff) do { _Pragma("unroll") for (int _i = 0; _i < 2; ++_i) \
    __builtin_amdgcn_global_load_lds((const unsigned*)((const char*)(gbase) + (voff)[_i]), (LAS unsigned*)(lds + (bufoff) + ldsw + _i * 8192), 16, 0, 0); } while (0)
#define PG8_LDA(dst, b, h) do { _Pragma("unroll") for (int m = 0; m < 4; ++m) _Pragma("unroll") for (int k = 0; k < 2; ++k) dst[m][k] = *(const LAS bf16x8*)(lds + PG8_SA(b, h) + aoff + m * 2048 + k * 1024); } while (0)
#define PG8_LDB(dst, b, h) do { _Pragma("unroll") for (int n = 0; n < 2; ++n) _Pragma("unroll") for (int k = 0; k < 2; ++k) dst[n][k] = *(const LAS bf16x8*)(lds + PG8_SB(b, h) + boff + n * 2048 + k * 1024); } while (0)
#define PG8_MMA(ai, bj, At, Bt) do { __builtin_amdgcn_s_setprio(1); _Pragma("unroll") for (int m = 0; m < 4; ++m) _Pragma("unroll") for (int n = 0; n < 2; ++n) _Pragma("unroll") for (int k = 0; k < 2; ++k) \
    acc[ai][bj][m][n] = __builtin_amdgcn_mfma_f32_16x16x32_bf16(Bt[n][k], At[m][k], acc[ai][bj][m][n], 0, 0, 0); __builtin_amdgcn_s_setprio(0); } while (0)
#define PG8_WAIT_V(n) asm volatile("s_waitcnt vmcnt(" #n ")" ::: "memory")
#define PG8_WAIT_L(n) asm volatile("s_waitcnt lgkmcnt(" #n ")" ::: "memory")
#define PG8_BAR __builtin_amdgcn_s_barrier()
#define PG8_SCHED __builtin_amdgcn_sched_barrier(0)
  Unit cur, nxt; int ui = 0;
  if (!S.next(0, cur)) return;
  f32x4 acc[2][2][4][2];
#pragma unroll
  for (int a = 0; a < 2; ++a)
#pragma unroll
    for (int b = 0; b < 2; ++b)
#pragma unroll
      for (int m = 0; m < 4; ++m)
#pragma unroll
        for (int n = 0; n < 2; ++n) acc[a][b][m][n] = (f32x4){0.f, 0.f, 0.f, 0.f};
  bf16x8 At[4][2], B0[2][2], B1[2][2];
  const char* cA = (const char*)g.A + (size_t)cur.pm * tstep; const char* cB = (const char*)g.Bt + (size_t)cur.pn * tstep;
  PG8_STAGE(PG8_SB(0, 0), cB, voffB); PG8_STAGE(PG8_SA(0, 0), cA, voffA); PG8_STAGE(PG8_SB(0, 1), cB + hstep, voffB); PG8_STAGE(PG8_SA(0, 1), cA + hstep, voffA);
  if (wr == 1) PG8_BAR;
  PG8_WAIT_V(4); PG8_BAR;
  PG8_STAGE(PG8_SB(1, 0), cB + kstep, voffB); PG8_STAGE(PG8_SA(1, 0), cA + kstep, voffA); PG8_STAGE(PG8_SB(1, 1), cB + hstep + kstep, voffB);
  PG8_WAIT_V(6); PG8_BAR;
  for (;;) {
    const bool has_next = S.next(ui + 1, nxt);
    const char* nA = has_next ? (const char*)g.A + (size_t)nxt.pm * tstep : cA; const char* nB = has_next ? (const char*)g.Bt + (size_t)nxt.pn * tstep : cB;
    for (int t = 0; t < nt; t += 2) {
      const bool last = (t == nt - 2);
      const char* a1 = cA + (size_t)(t + 1) * kstep;
      const char* a2 = last ? nA : cA + (size_t)(t + 2) * kstep; const char* b2 = last ? nB : cB + (size_t)(t + 2) * kstep;
      const char* a3 = a2 + kstep; const char* b3 = b2 + kstep;
      PG8_LDB(B0, 0, 0); PG8_SCHED; PG8_LDA(At, 0, 0); PG8_STAGE(PG8_SA(1, 1), a1 + hstep, voffA);
      PG8_WAIT_L(8); PG8_BAR; PG8_WAIT_L(0); PG8_MMA(0, 0, At, B0); PG8_BAR; PG8_SCHED;
      PG8_LDB(B1, 0, 1); PG8_STAGE(PG8_SB(0, 0), b2, voffB);
      PG8_BAR; PG8_WAIT_L(0); PG8_MMA(0, 1, At, B1); PG8_BAR;
      PG8_LDA(At, 0, 1); PG8_STAGE(PG8_SA(0, 0), a2, voffA);
      PG8_BAR; PG8_WAIT_L(0); PG8_MMA(1, 0, At, B0); PG8_BAR; PG8_SCHED;
      PG8_STAGE(PG8_SB(0, 1), b2 + hstep, voffB);
      PG8_WAIT_V(6); PG8_BAR; PG8_MMA(1, 1, At, B1); PG8_BAR;
      PG8_LDB(B0, 1, 0); PG8_SCHED; PG8_LDA(At, 1, 0); PG8_STAGE(PG8_SA(0, 1), a2 + hstep, voffA);
      PG8_WAIT_L(8); PG8_BAR; PG8_WAIT_L(0); PG8_MMA(0, 0, At, B0); PG8_BAR; PG8_SCHED;
      PG8_LDB(B1, 1, 1); PG8_STAGE(PG8_SB(1, 0), b3, voffB);
      PG8_BAR; PG8_WAIT_L(0); PG8_MMA(0, 1, At, B1); PG8_BAR;
      PG8_LDA(At, 1, 1); PG8_STAGE(PG8_SA(1, 0), a3, voffA);
      PG8_BAR; PG8_WAIT_L(0); PG8_MMA(1, 0, At, B0); PG8_BAR; PG8_SCHED;
      PG8_STAGE(PG8_SB(1, 1), b3 + hstep, voffB);
      PG8_WAIT_V(6); PG8_BAR; PG8_MMA(1, 1, At, B1); PG8_BAR;
    }
    E(acc, cur, wr, wc, fr, fq);
    if (!has_next) break;
#pragma unroll
    for (int a = 0; a < 2; ++a)
#pragma unroll
      for (int b = 0; b < 2; ++b)
#pragma unroll
        for (int m = 0; m < 4; ++m)
#pragma unroll
          for (int n = 0; n < 2; ++n) acc[a][b][m][n] = (f32x4){0.f, 0.f, 0.f, 0.f};
    cur = nxt; cA = nA; cB = nB; ++ui;
  }
  PG8_WAIT_V(0);
  if (wr == 0) PG8_BAR;
  PG8_BAR;
#undef PG8_SA
#undef PG8_SB
#undef PG8_STAGE
#undef PG8_LDA
#undef PG8_LDB
#undef PG8_MMA
#undef PG8_WAIT_V
#undef PG8_WAIT_L
#undef PG8_BAR
#undef PG8_SCHED
}
}
using pg8::Unit;

typedef f32x4 AccT[2][2][4][2];
DI void st_bf4(bf16_t* p, f32x4 v) { u32x2 w; w.x = pk2(v[0], v[1]); w.y = pk2(v[2], v[3]); *(GAS u32x2*)p = w; }
DI f32x4 ld_bf4(const bf16_t* p) { const u32x2 w = *(const GAS u32x2*)p; return (f32x4){bflo(w.x), bfhi(w.x), bflo(w.y), bfhi(w.y)}; }

struct EpiSwiglu {
  bf16_t* H;
  DI void operator()(const AccT& acc, const Unit& u, int wr, int wc, int fr, int fq) const {
    const int row0 = u.pm * 256 + wr * 64 + fr, col0 = u.pn * 128 + wc * 32 + 4 * fq;
#pragma unroll
    for (int ai = 0; ai < 2; ++ai)
#pragma unroll
      for (int m = 0; m < 4; ++m) {
        bf16_t* rowp = H + (size_t)(row0 + ai * 128 + m * 16) * DFF + col0;
#pragma unroll
        for (int n = 0; n < 2; ++n) {
          const f32x4 a = acc[ai][0][m][n], b = acc[ai][1][m][n]; f32x4 h;
#pragma unroll
          for (int j = 0; j < 4; ++j) h[j] = a[j] * sigmoidf_(a[j]) * b[j];
          st_bf4(rowp + n * 16, h);
        }
      }
  }
};
struct EpiResid {
  float* X; const float* modl; int gate_idx; float coef;
  DI void operator()(const AccT& acc, const Unit& u, int wr, int wc, int fr, int fq) const {
    const int mrow = u.pm < 16 ? 8 : ((u.pm - 16) >> 2);
    const int row0 = u.pm * 256 + wr * 64 + fr, col0 = u.pn * 256 + wc * 32 + 4 * fq;
    const float* gp = modl + (size_t)mrow * 9216 + gate_idx * 1024 + col0;
    f32x4 gv[2][2];
#pragma unroll
    for (int bj = 0; bj < 2; ++bj)
#pragma unroll
      for (int n = 0; n < 2; ++n) gv[bj][n] = *(const GAS f32x4*)(gp + bj * 128 + n * 16) * coef;
#pragma unroll
    for (int ai = 0; ai < 2; ++ai) {
      f32x4 xv[4][2][2];
#pragma unroll
      for (int m = 0; m < 4; ++m)
#pragma unroll
        for (int bj = 0; bj < 2; ++bj)
#pragma unroll
          for (int n = 0; n < 2; ++n) xv[m][bj][n] = *(const GAS f32x4*)(X + (size_t)(row0 + ai * 128 + m * 16) * DM + col0 + bj * 128 + n * 16);
#pragma unroll
      for (int m = 0; m < 4; ++m)
#pragma unroll
        for (int bj = 0; bj < 2; ++bj)
#pragma unroll
          for (int n = 0; n < 2; ++n) *(GAS f32x4*)(X + (size_t)(row0 + ai * 128 + m * 16) * DM + col0 + bj * 128 + n * 16) = xv[m][bj][n] + gv[bj][n] * acc[ai][bj][m][n];
    }
  }
};
struct EpiWin {
  bf16_t* U; bf16_t* Q; bf16_t* Kb; bf16_t* Vb; float* outk; float* outv; const float* rope; int layer;
  DI void operator()(const AccT& acc, const Unit& u, int wr, int wc, int fr, int fq) const {
    const int pn = u.pn, row0 = u.pm * 256 + wr * 64 + fr;
    const bool lat = u.pm >= 16;
    if (pn < 2 || pn >= 8) {
      const int col0 = pn * 256 + wc * 32 + 4 * fq;
#pragma unroll
      for (int ai = 0; ai < 2; ++ai)
#pragma unroll
        for (int m = 0; m < 4; ++m) {
          bf16_t* rowp = U + (size_t)(row0 + ai * 128 + m * 16) * INW + col0;
#pragma unroll
          for (int bj = 0; bj < 2; ++bj)
#pragma unroll
            for (int n = 0; n < 2; ++n) st_bf4(rowp + bj * 128 + n * 16, acc[ai][bj][m][n]);
        }
    } else if (pn < 6) {
      const bool isq = pn < 4;
      const int cq0 = (pn & 1) * 256 + wc * 32 + 4 * fq;
      const float scale = isq ? 0.125f * 1.4426950408889634f : 1.f;
      bf16_t* dstb = isq ? Q : Kb;
#pragma unroll
      for (int ai = 0; ai < 2; ++ai) {
        f32x4 csv[4], snv[4];
#pragma unroll
        for (int m = 0; m < 4; ++m) {
          csv[m] = (f32x4){1.f, 1.f, 1.f, 1.f}; snv[m] = (f32x4){0.f, 0.f, 0.f, 0.f};
          if (lat) {
            const int pos = (row0 + ai * 128 + m * 16 - T_CTX) & 1023;
            const float* rp = rope + (size_t)pos * 64 + ((wc & 1) * 16 + 4 * fq) * 2;
            const f32x4 r0 = *(const GAS f32x4*)rp, r1 = *(const GAS f32x4*)(rp + 4);
            csv[m] = (f32x4){r0[0], r0[2], r1[0], r1[2]}; snv[m] = (f32x4){r0[1], r0[3], r1[1], r1[3]};
          }
        }
#pragma unroll
        for (int m = 0; m < 4; ++m) {
          const int row = row0 + ai * 128 + m * 16;
          const f32x4 cs = csv[m], sn = snv[m];
#pragma unroll
          for (int bj = 0; bj < 2; ++bj) {
            const f32x4 y1 = acc[ai][bj][m][0], y2 = acc[ai][bj][m][1];
            const f32x4 o1 = y1 * cs - y2 * sn, o2 = y2 * cs + y1 * sn;
            bf16_t* d = dstb + (size_t)row * 512 + cq0 + bj * 128;
            st_bf4(d, o1 * scale); st_bf4(d + 16, o2 * scale);
            if (!isq && !lat) {
              float* o = outk + ((size_t)((row >> 8) * 4 + layer) * 256 + (row & 255)) * 512 + cq0 + bj * 128;
              *(GAS f32x4*)o = o1; *(GAS f32x4*)(o + 16) = o2;
            }
          }
        }
      }
    } else {
      const int cv0 = (pn & 1) * 256 + wc * 32 + 4 * fq;
#pragma unroll
      for (int ai = 0; ai < 2; ++ai)
#pragma unroll
        for (int m = 0; m < 4; ++m) {
          const int row = row0 + ai * 128 + m * 16;
#pragma unroll
          for (int bj = 0; bj < 2; ++bj)
#pragma unroll
            for (int n = 0; n < 2; ++n) {
              st_bf4(Vb + (size_t)row * 512 + cv0 + bj * 128 + n * 16, acc[ai][bj][m][n]);
              if (!lat) *(GAS f32x4*)(outv + ((size_t)((row >> 8) * 4 + layer) * 256 + (row & 255)) * 512 + cv0 + bj * 128 + n * 16) = acc[ai][bj][m][n];
            }
        }
    }
  }
};
struct EpiGlu {
  const bf16_t* ya; bf16_t* ys0;
  DI void operator()(const AccT& acc, const Unit& u, int wr, int wc, int fr, int fq) const {
    const int row0 = u.pm * 256 + wr * 64 + fr, col0 = u.pn * 256 + wc * 32 + 4 * fq;
#pragma unroll
    for (int ai = 0; ai < 2; ++ai) {
      u32x2 yv[4][2][2];
#pragma unroll
      for (int m = 0; m < 4; ++m)
#pragma unroll
        for (int bj = 0; bj < 2; ++bj)
#pragma unroll
          for (int n = 0; n < 2; ++n) yv[m][bj][n] = *(const GAS u32x2*)(ya + (size_t)(row0 + ai * 128 + m * 16) * 512 + col0 + bj * 128 + n * 16);
#pragma unroll
      for (int m = 0; m < 4; ++m)
#pragma unroll
        for (int bj = 0; bj < 2; ++bj)
#pragma unroll
          for (int n = 0; n < 2; ++n) {
            const u32x2 w = yv[m][bj][n]; const f32x4 y = {bflo(w.x), bfhi(w.x), bflo(w.y), bfhi(w.y)}, a = acc[ai][bj][m][n]; f32x4 o;
#pragma unroll
            for (int j = 0; j < 4; ++j) o[j] = y[j] * sigmoidf_(a[j]);
            st_bf4(ys0 + (size_t)(row0 + ai * 128 + m * 16) * 512 + col0 + bj * 128 + n * 16, o);
          }
    }
  }
};
struct EpiMix {
  const bf16_t* U; float* MRG; bf16_t* MERGED; const bf16_t* ya; bf16_t* ys0;
  DI void operator()(const AccT& acc, const Unit& u, int wr, int wc, int fr, int fq) const {
    if (u.pm < 48) { EpiGlu eg{ya, ys0}; eg(acc, u, wr, wc, fr, fq); return; }
    const int n3 = u.pm / 48 - 1, pm = u.pm - (n3 + 1) * 48, pn = (u.pn - 2) & 3;
    const int row0 = pm * 256 + wr * 64 + fr, col0 = pn * 256 + wc * 32 + 4 * fq;
#pragma unroll
    for (int ai = 0; ai < 2; ++ai)
#pragma unroll
      for (int mh = 0; mh < 2; ++mh) {
        u32x2 gt[2][2][2]; f32x4 mv[2][2][2];
#pragma unroll
        for (int m2 = 0; m2 < 2; ++m2)
#pragma unroll
          for (int bj = 0; bj < 2; ++bj)
#pragma unroll
            for (int n = 0; n < 2; ++n) {
              const int row = row0 + ai * 128 + (mh * 2 + m2) * 16;
              gt[m2][bj][n] = *(const GAS u32x2*)(U + (size_t)row * INW + 2560 + n3 * 1024 + col0 + bj * 128 + n * 16);
              mv[m2][bj][n] = n3 != 1 ? *(const GAS f32x4*)(MRG + (size_t)row * DM + col0 + bj * 128 + n * 16) : (f32x4){0.f, 0.f, 0.f, 0.f};
            }
#pragma unroll
        for (int m2 = 0; m2 < 2; ++m2)
#pragma unroll
          for (int bj = 0; bj < 2; ++bj)
#pragma unroll
            for (int n = 0; n < 2; ++n) {
              const int row = row0 + ai * 128 + (mh * 2 + m2) * 16;
              const u32x2 w = gt[m2][bj][n]; const f32x4 gg = {bflo(w.x), bfhi(w.x), bflo(w.y), bfhi(w.y)}, a = acc[ai][bj][mh * 2 + m2][n]; f32x4 o;
#pragma unroll
              for (int j = 0; j < 4; ++j) o[j] = mv[m2][bj][n][j] + sigmoidf_(gg[j]) * a[j];
              if (n3 != 0) *(GAS f32x4*)(MRG + (size_t)row * DM + col0 + bj * 128 + n * 16) = o;
              else st_bf4(MERGED + (size_t)row * DM + col0 + bj * 128 + n * 16, o);
            }
      }
  }
};

struct TrItem { const float* W; bf16_t* WT; int K, N, swiglu, item; };
DI void tr_load(const TrItem& t, int lane, float (&v)[32]) {
  const int nblk = t.N / 32, kb = t.item / nblk, nb = t.item % nblk, k0 = 64 * kb, n0 = 32 * nb;
#pragma unroll
  for (int i = 0; i < 32; ++i) { const int kk = 2 * i + (lane >> 5); v[i] = gldf(t.W + (size_t)(k0 + kk) * t.N + n0 + (lane & 31)); }
}
DI void tr_finish(const TrItem& t, int lane, const float (&v)[32], LAS float* scr) {
  const int nblk = t.N / 32, kb = t.item / nblk, nb = t.item % nblk, k0 = 64 * kb, n0 = 32 * nb;
#pragma unroll
  for (int i = 0; i < 32; ++i) { const int kk = 2 * i + (lane >> 5); scr[kk * 33 + (lane & 31)] = v[i]; }
  LDS_WAIT();
  const int c = lane & 7;
#pragma unroll
  for (int j = 0; j < 4; ++j) {
    const int n = (lane >> 3) + 8 * j; const LAS float* s = scr + (8 * c) * 33 + n;
    u32x4 o; o.x = pk2(s[0 * 33], s[1 * 33]); o.y = pk2(s[2 * 33], s[3 * 33]); o.z = pk2(s[4 * 33], s[5 * 33]); o.w = pk2(s[6 * 33], s[7 * 33]);
    int dr = n0 + n;
    if (t.swiglu) { const int isb = dr >= DFF, hh = isb ? dr - DFF : dr; dr = (hh >> 7) * 256 + isb * 128 + (hh & 127); }
    *(GAS u32x4*)(t.WT + (size_t)dr * t.K + k0 + 8 * c) = o;
  }
  LDS_WAIT();
}
DI TrItem tr_decode(const Ctx& p, int it) {
  constexpr int I_FI = 16 * 176, I_FO = 44 * 32, I_IN = 16 * 176, I_GLU = 8 * 16, I_BR = 8 * 32, I_OUT = 16 * 32, I_P = 2 * 4;
  constexpr int I_LAYER = 2 * I_FI + 2 * I_FO + I_IN + I_GLU + 3 * I_BR + I_OUT + 4 * I_P;
  const int l = it / I_LAYER; int r = it % I_LAYER;
  bf16_t* wl = (bf16_t*)(p.ws + OFF_W) + (size_t)l * W_LAYER;
  TrItem t;
  if (r < 2 * I_FI) { const int s = r / I_FI; t = TrItem{p.in[10] + (size_t)(l * 2 + s) * 1024 * 5632, wl + W_FI + (size_t)s * 5632 * 1024, 1024, 5632, 1, r % I_FI}; return t; } r -= 2 * I_FI;
  if (r < 2 * I_FO) { const int s = r / I_FO; t = TrItem{p.in[11] + (size_t)(l * 2 + s) * 2816 * 1024, wl + W_FO + (size_t)s * 1024 * 2816, 2816, 1024, 0, r % I_FO}; return t; } r -= 2 * I_FO;
  if (r < I_IN) { t = TrItem{p.in[12] + (size_t)l * 1024 * 5632, wl + W_IN, 1024, 5632, 0, r}; return t; } r -= I_IN;
  if (r < I_GLU) { t = TrItem{p.in[21] + (size_t)l * 512 * 512, wl + W_GLU, 512, 512, 0, r}; return t; } r -= I_GLU;
  if (r < 3 * I_BR) { const int s = r / I_BR; t = TrItem{p.in[29] + (size_t)(l * 3 + s) * 512 * 1024, wl + W_BR + (size_t)s * 1024 * 512, 512, 1024, 0, r % I_BR}; return t; } r -= 3 * I_BR;
  if (r < I_OUT) { t = TrItem{p.in[30] + (size_t)l * 1024 * 1024, wl + W_OUT, 1024, 1024, 0, r}; return t; } r -= I_OUT;
  { const int s = r / I_P; t = TrItem{p.in[27] + (size_t)(l * 4 + s) * 128 * 128, wl + W_P + (size_t)s * 128 * 128, 128, 128, 0, r % I_P}; return t; }
}
constexpr int TR_ITEMS = 4 * (2 * 16 * 176 + 2 * 44 * 32 + 16 * 176 + 8 * 16 + 3 * 8 * 32 + 16 * 32 + 4 * 2 * 4);

DI void tr_slice(const Ctx& p, LAS unsigned char* lds, int layer, int part) {
  const int tid = opaque_tid(p.wv), lane = tid & 63, wave = tid >> 6;
  const int G = gridDim.x, first = G > 64 ? 32 : 0;
  if ((int)blockIdx.x < first) return;
  constexpr int IL = TR_ITEMS / 4;
  const int lo = layer * IL + (part * IL) / 2, hi = layer * IL + ((part + 1) * IL) / 2;
  LAS float* scr = (LAS float*)(lds + wave * 8448);
  float va[32];
  for (int it = lo + ((int)blockIdx.x - first) * 8 + wave; it < hi; it += (G - first) * 8) {
    const TrItem t = tr_decode(p, it);
    tr_load(t, lane, va);
    tr_finish(t, lane, va, scr);
  }
}
DI void prep_phase(const Ctx& p, LAS unsigned char* lds) {
  const int tid = opaque_tid(p.wv), lane = tid & 63, wave = tid >> 6;
  unsigned char* ws = p.ws;
  for (int item = blockIdx.x; item < 144; item += gridDim.x) {
    const int l = item / 36, jc = item % 36;
    LAS float* sc = (LAS float*)lds;
    LAS float* red = sc + 9 * 1024;
    for (int i = tid; i < 9 * 1024; i += 512) { const int r = i >> 10, k = i & 1023; const float v = r < 8 ? gldf(p.in[5] + r * 1024 + k) : gldf(p.in[6] + k); sc[i] = v * sigmoidf_(v); }
    __syncthreads();
    const int j0 = jc * 256 + lane * 4;
    const float* w = p.in[8] + (size_t)l * 1024 * 9216 + (size_t)(wave * 128) * 9216 + j0;
    f32x4 acc[9];
#pragma unroll
    for (int r = 0; r < 9; ++r) acc[r] = (f32x4){0.f, 0.f, 0.f, 0.f};
    const LAS float* s0 = sc + wave * 128;
#pragma unroll 8
    for (int k = 0; k < 128; ++k) {
      const f32x4 wv = *(const GAS f32x4*)(w + (size_t)k * 9216);
#pragma unroll
      for (int r = 0; r < 9; ++r) acc[r] += wv * s0[r * 1024 + k];
    }
#pragma unroll
    for (int r = 0; r < 9; ++r) *(LAS f32x4*)(red + (wave * 9 + r) * 256 + lane * 4) = acc[r];
    __syncthreads();
    for (int o = tid; o < 9 * 256; o += 512) {
      const int r = o >> 8, col = o & 255; float s = 0.f;
#pragma unroll
      for (int w8 = 0; w8 < 8; ++w8) s += red[(w8 * 9 + r) * 256 + col];
      gstf((float*)(ws + OFF_MOD) + ((size_t)l * 9 + r) * 9216 + jc * 256 + col, s + gldf(p.in[9] + l * 9216 + jc * 256 + col));
    }
    __syncthreads();
  }
  {
    LAS float* scr = (LAS float*)(lds + wave * 8448);
    const int gw = blockIdx.x * 8 + wave, NGW = gridDim.x * 8;
    constexpr int TR0 = TR_ITEMS / 4;
    if (gw < TR0) {
      TrItem cur = tr_decode(p, gw); float va[32], vb[32];
      tr_load(cur, lane, va);
      for (int it = gw; it < TR0; it += 2 * NGW) {
        const bool h1 = it + NGW < TR0, h2 = it + 2 * NGW < TR0;
        TrItem nx = cur;
        if (h1) { nx = tr_decode(p, it + NGW); tr_load(nx, lane, vb); }
        tr_finish(cur, lane, va, scr);
        if (h1) {
          if (h2) { cur = tr_decode(p, it + 2 * NGW); tr_load(cur, lane, va); }
          tr_finish(nx, lane, vb, scr);
        }
      }
    }
  }
  const size_t gt = (size_t)blockIdx.x * 512 + tid, GT = (size_t)gridDim.x * 512;
  for (size_t i0 = gt; i0 < 2 * 1048576; i0 += 4 * GT) {
    f32x4 a[4], b[4];
#pragma unroll
    for (int q = 0; q < 4; ++q) {
      const size_t i = i0 + q * GT; if (i >= 2 * 1048576) { a[q] = (f32x4){0.f, 0.f, 0.f, 0.f}; b[q] = a[q]; continue; }
      const int which = i >= 1048576; const size_t e = (i & 1048575) * 8;
      const float* src = (which ? p.in[3] : p.in[2]) + e;
      a[q] = *(const GAS f32x4*)src; b[q] = *(const GAS f32x4*)(src + 4);
    }
#pragma unroll
    for (int q = 0; q < 4; ++q) {
      const size_t i = i0 + q * GT; if (i >= 2 * 1048576) continue;
      const int which = i >= 1048576; const size_t e = (i & 1048575) * 8;
      u32x4 o; o.x = pk2(a[q][0], a[q][1]); o.y = pk2(a[q][2], a[q][3]); o.z = pk2(b[q][0], b[q][1]); o.w = pk2(b[q][2], b[q][3]);
      *(GAS u32x4*)((bf16_t*)(ws + (which ? OFF_VC : OFF_KC)) + e) = o;
    }
  }
  for (size_t i = gt; i < 16384; i += GT) {
    const int pI = (int)(i & 63), ldg = (int)(i >> 6);
    const float lr = gldf(p.in[13] + i), li = gldf(p.in[14] + i), dt = expf(gldf(p.in[15] + ldg));
    const float mag = expf(lr * dt), abr = mag * cosf(li * dt), abi = mag * sinf(li * dt);
    const float den = lr * lr + li * li, nr = abr - 1.0f, kr = (nr * lr + abi * li) / den, ki = (abi * lr - nr * li) / den;
    float* at = (float*)(ws + OFF_AT) + i * 2; gstf(at, abr); gstf(at + 1, abi);
    bf16_t* bbp = (bf16_t*)(ws + OFF_BB) + (size_t)ldg * 2048;
    const float* bre = p.in[16] + i * 16; const float* bim = p.in[17] + i * 16;
    for (int c = 0; c < 16; c += 2) {
      const float br0 = gldf(bre + c), bi0 = gldf(bim + c), br1 = gldf(bre + c + 1), bi1 = gldf(bim + c + 1);
      *(GAS unsigned*)(bbp + (size_t)pI * 16 + c) = pk2(kr * br0 - ki * bi0, kr * br1 - ki * bi1);
      *(GAS unsigned*)(bbp + (size_t)(64 + pI) * 16 + c) = pk2(kr * bi0 + ki * br0, kr * bi1 + ki * br1);
    }
    bf16_t* cmp = (bf16_t*)(ws + OFF_CM) + (size_t)ldg * 2048;
    for (int c = 0; c < 16; ++c) {
      const float cr = gldf(p.in[18] + ((size_t)ldg * 16 + c) * 64 + pI), ci = gldf(p.in[19] + ((size_t)ldg * 16 + c) * 64 + pI);
      *(GAS unsigned*)(cmp + (size_t)c * 128 + 2 * pI) = pk2(cr, -ci);
    }
  }
  for (size_t i = gt; i < 32768; i += GT) {
    const int pos = (int)(i >> 5), j = (int)(i & 31);
    const float inv = powf(10000.0f, -(float)(j & 15) / 16.0f);
    const float ang = (float)(j < 16 ? (pos >> 6) : (pos & 63)) * inv;
    float* rp = (float*)(ws + OFF_ROPE) + i * 2; gstf(rp, cosf(ang)); gstf(rp + 1, sinf(ang));
  }
  if (gt < 4) {
    const int l = (int)gt; float s1 = 0.f, s2 = 0.f;
    for (int k = 0; k < 64; ++k) { s1 += gldf(p.in[22] + l * 64 + k) * gldf(p.in[23] + l * 64 + k); s2 += gldf(p.in[24] + l * 64 + k) * gldf(p.in[25] + l * 64 + k); }
    const float lam_init = 0.8f - 0.6f * expf(-0.3f * (float)l);
    gstf((float*)(ws + OFF_LAM) + l, expf(s1) - expf(s2) + lam_init);
  }
}

DI void norm_phase(const Ctx& p, int layer, int sub, bool first, bool final_) {
  const int tid = opaque_tid(p.wv), lane = tid & 63, wave = tid >> 6;
  float* X = (float*)(p.ws + OFF_X); bf16_t* Nb = (bf16_t*)(p.ws + OFF_N);
  const int gw = blockIdx.x * 8 + wave, NGW = gridDim.x * 8;
  f32x4 vn[4];
  {
    const int row = gw < T_ALL ? gw : 0;
    const float* src = first ? (row < T_CTX ? p.in[0] + (size_t)row * DM : p.in[1] + (size_t)(row - T_CTX) * DM) : X + (size_t)row * DM;
#pragma unroll
    for (int j = 0; j < 4; ++j) vn[j] = ((const GAS f32x4*)src)[lane + 64 * j];
  }
  for (int row = gw; row < T_ALL; row += NGW) {
    f32x4 v[4]; float ss = 0.f;
#pragma unroll
    for (int j = 0; j < 4; ++j) { v[j] = vn[j]; ss += (v[j][0] * v[j][0] + v[j][1] * v[j][1]) + (v[j][2] * v[j][2] + v[j][3] * v[j][3]); }
    {
      const int rown = row + NGW < T_ALL ? row + NGW : row;
      const float* src = first ? (rown < T_CTX ? p.in[0] + (size_t)rown * DM : p.in[1] + (size_t)(rown - T_CTX) * DM) : X + (size_t)rown * DM;
#pragma unroll
      for (int j = 0; j < 4; ++j) vn[j] = ((const GAS f32x4*)src)[lane + 64 * j];
    }
    const float rstd = 1.0f / sqrtf(wave_sum(ss) * (1.f / DM) + 1e-6f);
    if (final_) {
      const float* g = p.in[31];
#pragma unroll
      for (int j = 0; j < 4; ++j) { const f32x4 gv = ((const GAS f32x4*)g)[lane + 64 * j]; ((GAS f32x4*)(p.out + (size_t)row * DM))[lane + 64 * j] = v[j] * rstd * gv; }
    } else {
      const int mrow = row < T_CTX ? 8 : ((row - T_CTX) >> 10);
      const float* md = (const float*)(p.ws + OFF_MOD) + ((size_t)layer * 9 + mrow) * 9216;
      const float* sh = md + (3 * sub) * 1024; const float* sc = md + (3 * sub + 1) * 1024; const float* g = p.in[7] + (size_t)(layer * 3 + sub) * DM;
#pragma unroll
      for (int j = 0; j < 4; ++j) {
        const f32x4 gv = ((const GAS f32x4*)g)[lane + 64 * j], sv = ((const GAS f32x4*)sc)[lane + 64 * j], hv = ((const GAS f32x4*)sh)[lane + 64 * j];
        const f32x4 y = v[j] * rstd * gv * (sv + 1.f) + hv;
        st_bf4(Nb + (size_t)row * DM + (lane + 64 * j) * 4, y);
        if (first) ((GAS f32x4*)(X + (size_t)row * DM))[lane + 64 * j] = v[j];
      }
    }
  }
}

DI s16x4 tr_read(unsigned lds_addr) { s16x4 r; asm volatile("ds_read_b64_tr_b16 %0, %1\n\ts_waitcnt lgkmcnt(0)" : "=&v"(r) : "v"(lds_addr) : "memory"); return r; }
#define MFMA32(a, b, c) __builtin_amdgcn_mfma_f32_32x32x16_bf16((a), (b), (c), 0, 0, 0)
#define MFMA16(a, b, c) __builtin_amdgcn_mfma_f32_16x16x32_bf16((a), (b), (c), 0, 0, 0)

DI void attn_item(const Ctx& p, int layer, bool lat, int seq, int head, int qblk, LAS unsigned char* lds) {
  const int tid = opaque_tid(p.wv), lane = tid & 63, wave = tid >> 6, r16 = lane & 15, g4 = lane >> 4;
  unsigned char* ws = p.ws;
  const bf16_t* Qg = (const bf16_t*)(ws + OFF_Q); const bf16_t* Kg = (const bf16_t*)(ws + OFF_K); const bf16_t* Vg = (const bf16_t*)(ws + OFF_V);
  const int tok0 = lat ? T_CTX + seq * 1024 : seq * 256;
  const int n_own = lat ? 16 : 4, n_tiles = lat ? 24 : 4;
  const bf16_t* Kc = (const bf16_t*)(ws + OFF_KC) + (size_t)(seq * 4 + layer) * 512 * 512;
  const bf16_t* Vc = (const bf16_t*)(ws + OFF_VC) + (size_t)(seq * 4 + layer) * 512 * 512;
  constexpr int RS = 272;
  LAS unsigned char* Kt = lds; LAS unsigned char* Vt = lds + 64 * RS;
  const int qtok = tok0 + qblk * 128 + wave * 16 + r16;
  bf16x8 Qf[2][2];
#pragma unroll
  for (int m = 0; m < 2; ++m)
#pragma unroll
    for (int kk = 0; kk < 2; ++kk) Qf[m][kk] = *(const GAS bf16x8*)(Qg + (size_t)qtok * 512 + head * 128 + m * 64 + g4 * 8 + 32 * kk);
  u32x4 kreg[2], vreg[2];
  auto issue = [&](int kt) {
    const bf16_t* kb; const bf16_t* vb;
    if (kt < n_own) { kb = Kg + (size_t)(tok0 + kt * 64) * 512 + head * 128; vb = Vg + (size_t)(tok0 + kt * 64) * 512 + head * 128; }
    else { kb = Kc + (size_t)((kt - n_own) * 64) * 512 + head * 128; vb = Vc + (size_t)((kt - n_own) * 64) * 512 + head * 128; }
#pragma unroll
    for (int i = 0; i < 2; ++i) { const int ci = tid + 512 * i, row = ci >> 4, part = ci & 15; kreg[i] = *(const GAS u32x4*)(kb + (size_t)row * 512 + part * 8); vreg[i] = *(const GAS u32x4*)(vb + (size_t)row * 512 + part * 8); }
  };
  issue(0);
  f32x4 O[2][8];
#pragma unroll
  for (int m = 0; m < 2; ++m)
#pragma unroll
    for (int d = 0; d < 8; ++d) O[m][d] = (f32x4){0.f, 0.f, 0.f, 0.f};
  float mrun[2] = {-1e30f, -1e30f}, lsum[2] = {0.f, 0.f};
  const unsigned vbase = (unsigned)(size_t)Vt;
  const int tq = r16 >> 2, tp = r16 & 3;
  for (int kt = 0; kt < n_tiles; ++kt) {
    __syncthreads();
#pragma unroll
    for (int i = 0; i < 2; ++i) { const int ci = tid + 512 * i, row = ci >> 4, part = ci & 15; *(LAS u32x4*)(Kt + row * RS + part * 16) = kreg[i]; *(LAS u32x4*)(Vt + row * RS + part * 16) = vreg[i]; }
    __syncthreads();
    if (kt + 1 < n_tiles) issue(kt + 1);
    bf16x8 P[2][2];
#pragma unroll
    for (int m = 0; m < 2; ++m) {
      f32x4 S[4];
#pragma unroll
      for (int kb = 0; kb < 4; ++kb) {
        S[kb] = (f32x4){0.f, 0.f, 0.f, 0.f};
#pragma unroll
        for (int kk = 0; kk < 2; ++kk) { const bf16x8 Kf = *(const LAS bf16x8*)(Kt + (16 * kb + r16) * RS + m * 128 + (g4 * 8 + 32 * kk) * 2); S[kb] = MFMA16(Kf, Qf[m][kk], S[kb]); }
      }
      float mx = S[0][0];
#pragma unroll
      for (int kb = 0; kb < 4; ++kb)
#pragma unroll
        for (int j = 0; j < 4; ++j) mx = fmaxf(mx, S[kb][j]);
      mx = fmaxf(mx, __shfl_xor(mx, 16)); mx = fmaxf(mx, __shfl_xor(mx, 32));
      const float mnew = fmaxf(mrun[m], mx), alpha = __builtin_amdgcn_exp2f(mrun[m] - mnew);
      mrun[m] = mnew;
      float ps = 0.f;
#pragma unroll
      for (int kb = 0; kb < 4; ++kb)
#pragma unroll
        for (int j = 0; j < 4; ++j) { S[kb][j] = __builtin_amdgcn_exp2f(S[kb][j] - mnew); ps += S[kb][j]; }
      lsum[m] = lsum[m] * alpha + ps;
#pragma unroll
      for (int d = 0; d < 8; ++d) O[m][d] *= alpha;
#pragma unroll
      for (int s = 0; s < 2; ++s) {
        u32x4 w; w.x = pk2(S[2 * s][0], S[2 * s][1]); w.y = pk2(S[2 * s][2], S[2 * s][3]); w.z = pk2(S[2 * s + 1][0], S[2 * s + 1][1]); w.w = pk2(S[2 * s + 1][2], S[2 * s + 1][3]);
        P[m][s] = __builtin_bit_cast(bf16x8, w);
      }
    }
#pragma unroll
    for (int s = 0; s < 2; ++s) {
      s16x4 v0, v1, v2, v3, v4, v5, v6, v7, v8, v9, v10, v11, v12, v13, v14, v15;
      const unsigned a0 = vbase + (32 * s + 4 * g4 + tq) * RS + 8 * tp;
      asm volatile(
        "ds_read_b64_tr_b16 %0, %16\n\tds_read_b64_tr_b16 %1, %16 offset:4352\n\t"
        "ds_read_b64_tr_b16 %2, %16 offset:32\n\tds_read_b64_tr_b16 %3, %16 offset:4384\n\t"
        "ds_read_b64_tr_b16 %4, %16 offset:64\n\tds_read_b64_tr_b16 %5, %16 offset:4416\n\t"
        "ds_read_b64_tr_b16 %6, %16 offset:96\n\tds_read_b64_tr_b16 %7, %16 offset:4448\n\t"
        "ds_read_b64_tr_b16 %8, %16 offset:128\n\tds_read_b64_tr_b16 %9, %16 offset:4480\n\t"
        "ds_read_b64_tr_b16 %10, %16 offset:160\n\tds_read_b64_tr_b16 %11, %16 offset:4512\n\t"
        "ds_read_b64_tr_b16 %12, %16 offset:192\n\tds_read_b64_tr_b16 %13, %16 offset:4544\n\t"
        "ds_read_b64_tr_b16 %14, %16 offset:224\n\tds_read_b64_tr_b16 %15, %16 offset:4576\n\t"
        "s_waitcnt lgkmcnt(0)"
        : "=&v"(v0), "=&v"(v1), "=&v"(v2), "=&v"(v3), "=&v"(v4), "=&v"(v5), "=&v"(v6), "=&v"(v7),
          "=&v"(v8), "=&v"(v9), "=&v"(v10), "=&v"(v11), "=&v"(v12), "=&v"(v13), "=&v"(v14), "=&v"(v15)
        : "v"(a0) : "memory");
#define ATT_PV(d, lo, hi) { const bf16x8 Vf = __builtin_shufflevector(lo, hi, 0, 1, 2, 3, 4, 5, 6, 7); O[0][d] = MFMA16(Vf, P[0][s], O[0][d]); O[1][d] = MFMA16(Vf, P[1][s], O[1][d]); }
      ATT_PV(0, v0, v1) ATT_PV(1, v2, v3) ATT_PV(2, v4, v5) ATT_PV(3, v6, v7) ATT_PV(4, v8, v9) ATT_PV(5, v10, v11) ATT_PV(6, v12, v13) ATT_PV(7, v14, v15)
#undef ATT_PV
    }
  }
  float l1 = lsum[0], l2 = lsum[1];
  l1 += __shfl_xor(l1, 16); l1 += __shfl_xor(l1, 32); l2 += __shfl_xor(l2, 16); l2 += __shfl_xor(l2, 32);
  const float lam = gldf((const float*)(ws + OFF_LAM) + layer);
  const float lam_init = 0.8f - 0.6f * expf(-0.3f * (float)layer);
  const float c1 = 1.f / l1, c2 = lam / l2;
  float ss = 0.f;
#pragma unroll
  for (int d = 0; d < 8; ++d) { const f32x4 o = O[0][d] * c1 - O[1][d] * c2; O[0][d] = o; ss += (o[0] * o[0] + o[1] * o[1]) + (o[2] * o[2] + o[3] * o[3]); }
  ss += __shfl_xor(ss, 16); ss += __shfl_xor(ss, 32);
  const float rn = (1.f - lam_init) / sqrtf(ss * (1.f / 128.f) + 1e-6f);
  const float* ag = p.in[26] + layer * 128;
  bf16_t* yb = (bf16_t*)(ws + OFF_YS) + (size_t)T_ALL * 512 + (size_t)qtok * 512 + head * 128;
#pragma unroll
  for (int d = 0; d < 8; ++d) {
    const int dv = 16 * d + 4 * g4;
    const f32x4 gv = *(const GAS f32x4*)(ag + dv);
    st_bf4(yb + dv, O[0][d] * rn * gv);
  }
}

DI void s5_item(const Ctx& p, int layer, bool lat, int pairIdx, int gsel, LAS unsigned char* lds) {
  const int tid = opaque_tid(p.wv), lane = tid & 63, wave = __builtin_amdgcn_readfirstlane(tid >> 6), r32 = lane & 31, h = lane >> 5;
  unsigned char* ws = p.ws;
  const int d = wave & 1, g = lat ? gsel : gsel * 4 + (wave >> 1), chunk = lat ? (wave >> 1) : 0;
  const int L = lat ? 1024 : 256;
  constexpr int nt = 16;
  const int seq0 = pairIdx * 2;
  const int tb0 = (lat ? T_CTX + seq0 * 1024 : seq0 * 256) + chunk * 256;
  const int ldg = (layer * 2 + d) * 32 + g;
  const float* at = (const float*)(ws + OFF_AT) + (size_t)ldg * 128;
  const float a0r = gldf(at + r32 * 2), a0i = gldf(at + r32 * 2 + 1), a1r = gldf(at + (r32 + 32) * 2), a1i = gldf(at + (r32 + 32) * 2 + 1);
  float h0r = 0.f, h0i = 0.f, h1r = 0.f, h1i = 0.f;
  if (lat) {
    const float* st = p.in[4] + ((size_t)(((seq0 + h) * 4 + layer) * 2 + d) * 2) * 2048 + g * 64;
    h0r = gldf(st + r32); h1r = gldf(st + r32 + 32); h0i = gldf(st + 2048 + r32); h1i = gldf(st + 2048 + r32 + 32);
  }
  bf16x8 BBf[4], Cmf[4];
  {
    const bf16_t* bb = (const bf16_t*)(ws + OFF_BB) + (size_t)ldg * 2048;
    const bf16_t* cm = (const bf16_t*)(ws + OFF_CM) + (size_t)ldg * 2048;
#pragma unroll
    for (int b = 0; b < 4; ++b) { BBf[b] = *(const GAS bf16x8*)(bb + (size_t)(b * 32 + r32) * 16 + h * 8); Cmf[b] = *(const GAS bf16x8*)(cm + (size_t)(lane & 15) * 128 + (lane >> 4) * 8 + 32 * b); }
  }
  const bf16_t* U = (const bf16_t*)(ws + OFF_UH);
  float* YP = (float*)(ws + OFF_YP);
  bf16_t* YA = (bf16_t*)(ws + OFF_YA);
  const int sA = (r32 >> 2) & 1, iA = 4 * (r32 >> 3) + (r32 & 3);
  const bf16_t* uA = U + (size_t)(tb0 + sA * L + iA) * INW + g * 16 + h * 8;
  constexpr int RS = 272;
  LAS unsigned char* hb = lds + wave * (32 * RS);
  const f32x4 dsk = *(const GAS f32x4*)(p.in[20] + layer * 512 + g * 16 + (lane >> 4) * 4);
  __syncthreads();
  if (lat) {
    float e0r = 0.f, e0i = 0.f, e1r = 0.f, e1i = 0.f;
    const bool need = d == 0 ? chunk < 3 : chunk > 0;
    if (need) {
      bf16x8 Af1 = *(const GAS bf16x8*)(uA + (size_t)(d ? nt - 1 : 0) * 16 * INW);
      for (int n = 0; n < nt; ++n) {
        const int tile = d ? nt - 1 - n : n;
        const int tilen = (n + 1 < nt) ? (d ? tile - 1 : tile + 1) : tile;
        const bf16x8 Afn = *(const GAS bf16x8*)(uA + (size_t)tilen * 16 * INW);
        f32x16 x0, x1, x2, x3;
#pragma unroll
        for (int i = 0; i < 16; ++i) { x0[i] = 0.f; x1[i] = 0.f; x2[i] = 0.f; x3[i] = 0.f; }
        x0 = MFMA32(Af1, BBf[0], x0); x1 = MFMA32(Af1, BBf[1], x1); x2 = MFMA32(Af1, BBf[2], x2); x3 = MFMA32(Af1, BBf[3], x3);
#define S5_STEP1(i) { const float nr0 = a0r * e0r - a0i * e0i + x0[i], ni0 = a0r * e0i + a0i * e0r + x2[i]; e0r = nr0; e0i = ni0; \
                      const float nr1 = a1r * e1r - a1i * e1i + x1[i], ni1 = a1r * e1i + a1i * e1r + x3[i]; e1r = nr1; e1i = ni1; }
        if (d == 0) {
#pragma unroll
          for (int i = 0; i < 16; ++i) S5_STEP1(i)
        } else {
#pragma unroll
          for (int i = 15; i >= 0; --i) S5_STEP1(i)
        }
#undef S5_STEP1
        Af1 = Afn;
      }
    }
    LAS float* Eb = (LAS float*)(lds + 8 * 32 * RS);
    Eb[(wave * 4 + 0) * 64 + lane] = e0r; Eb[(wave * 4 + 1) * 64 + lane] = e0i; Eb[(wave * 4 + 2) * 64 + lane] = e1r; Eb[(wave * 4 + 3) * 64 + lane] = e1i;
    __syncthreads();
    float p0r = a0r, p0i = a0i, p1r = a1r, p1i = a1i;
#pragma unroll
    for (int q = 0; q < 8; ++q) { const float t0 = p0r * p0r - p0i * p0i, u0 = 2.f * p0r * p0i; p0r = t0; p0i = u0; const float t1 = p1r * p1r - p1i * p1i, u1 = 2.f * p1r * p1i; p1r = t1; p1i = u1; }
    const int nprev = d == 0 ? chunk : 3 - chunk;
    for (int q = 0; q < nprev; ++q) {
      const int j = d == 0 ? q : 3 - q, wj = j * 2 + d;
      const float f0r = Eb[(wj * 4 + 0) * 64 + lane], f0i = Eb[(wj * 4 + 1) * 64 + lane], f1r = Eb[(wj * 4 + 2) * 64 + lane], f1i = Eb[(wj * 4 + 3) * 64 + lane];
      const float n0r = p0r * h0r - p0i * h0i + f0r, n0i = p0r * h0i + p0i * h0r + f0i; h0r = n0r; h0i = n0i;
      const float n1r = p1r * h1r - p1i * h1i + f1r, n1i = p1r * h1i + p1i * h1r + f1i; h1r = n1r; h1i = n1i;
    }
  }
  bf16x8 Af = *(const GAS bf16x8*)(uA + (size_t)(d ? nt - 1 : 0) * 16 * INW);
  for (int n = 0; n < nt; ++n) {
    if (n == nt / 2) __syncthreads();
    const int tile = d ? nt - 1 - n : n;
    const int tilen = (n + 1 < nt) ? (d ? tile - 1 : tile + 1) : tile;
    const bf16x8 Afn = *(const GAS bf16x8*)(uA + (size_t)tilen * 16 * INW);
    const bool second = n >= nt / 2;
    f32x4 po[2] = {{0.f, 0.f, 0.f, 0.f}, {0.f, 0.f, 0.f, 0.f}}; u32x2 pu[2] = {{0u, 0u}, {0u, 0u}};
    if (second) {
#pragma unroll
      for (int ss = 0; ss < 2; ++ss) {
        const int tok = tb0 + ss * L + tile * 16 + (lane & 15), ch = g * 16 + (lane >> 4) * 4;
        po[ss] = *(const GAS f32x4*)(YP + ((size_t)(1 - d) * T_ALL + tok) * 512 + ch);
        pu[ss] = *(const GAS u32x2*)(U + (size_t)tok * INW + ch);
      }
    }
    f32x16 x0, x1, x2, x3;
#pragma unroll
    for (int i = 0; i < 16; ++i) { x0[i] = 0.f; x1[i] = 0.f; x2[i] = 0.f; x3[i] = 0.f; }
    x0 = MFMA32(Af, BBf[0], x0); x1 = MFMA32(Af, BBf[1], x1); x2 = MFMA32(Af, BBf[2], x2); x3 = MFMA32(Af, BBf[3], x3);
#define S5_STEP(i) { const float nr0 = a0r * h0r - a0i * h0i + x0[i], ni0 = a0r * h0i + a0i * h0r + x2[i]; h0r = nr0; h0i = ni0; \
                     const float nr1 = a1r * h1r - a1i * h1i + x1[i], ni1 = a1r * h1i + a1i * h1r + x3[i]; h1r = nr1; h1i = ni1; \
                     *(LAS unsigned*)(hb + (h * 16 + (i)) * RS + r32 * 4) = pk2(h0r, h0i); *(LAS unsigned*)(hb + (h * 16 + (i)) * RS + (r32 + 32) * 4) = pk2(h1r, h1i); }
    if (d == 0) {
#pragma unroll
      for (int i = 0; i < 16; ++i) S5_STEP(i)
    } else {
#pragma unroll
      for (int i = 15; i >= 0; --i) S5_STEP(i)
    }
#undef S5_STEP
    LDS_WAIT();
#pragma unroll
    for (int ss = 0; ss < 2; ++ss) {
      f32x4 y = {0.f, 0.f, 0.f, 0.f};
#pragma unroll
      for (int kb = 0; kb < 4; ++kb) { const bf16x8 Hf = *(const LAS bf16x8*)(hb + (ss * 16 + (lane & 15)) * RS + ((lane >> 4) * 8 + 32 * kb) * 2); y = MFMA16(Cmf[kb], Hf, y); }
      const int tok = tb0 + ss * L + tile * 16 + (lane & 15), ch = g * 16 + (lane >> 4) * 4;
      if (!second) {
        *(GAS f32x4*)(YP + ((size_t)d * T_ALL + tok) * 512 + ch) = y;
      } else {
        const f32x4 uu = {bflo(pu[ss].x), bfhi(pu[ss].x), bflo(pu[ss].y), bfhi(pu[ss].y)};
        f32x4 v = y + po[ss] + uu * dsk, r;
#pragma unroll
        for (int j = 0; j < 4; ++j) { const float t = v[j]; r[j] = t * sigmoidf_(1.5957691216057308f * (t + 0.044715f * t * t * t)); }
        st_bf4(YA + (size_t)tok * 512 + ch, r);
      }
    }
    LDS_WAIT();
    Af = Afn;
  }
  if (!lat) {
    float* so = p.out + 12582912 + 8388608 + 8388608 + ((size_t)(((seq0 + h) * 4 + layer) * 2 + d) * 2) * 2048 + g * 64;
    gstf(so + r32, h0r); gstf(so + r32 + 32, h1r); gstf(so + 2048 + r32, h0i); gstf(so + 2048 + r32 + 32, h1i);
  }
}

template <int W>
DI void pool_body(const Ctx& p, int layer, int g, int t0, int lane) {
  const int r32 = lane & 31, h = lane >> 5;
  unsigned char* ws = p.ws;
  const int t = t0 + r32;
  const int sbase = t < T_CTX ? (t & ~255) : T_CTX + ((t - T_CTX) & ~1023), L = t < T_CTX ? 256 : 1024, tl = t - sbase;
  int lo = tl - W / 2, hi = lo + W; lo = lo < 0 ? 0 : lo; hi = hi > L ? L : hi;
  const float inv = 1.f / (float)(hi - lo);
  const bf16_t* Z = (const bf16_t*)(ws + OFF_UH) + 2048 + g * 128 + h * 8;
  bf16x8 Af[8];
#pragma unroll
  for (int kk = 0; kk < 8; ++kk) {
    u32x4 zz[W]; float ff[W];
#pragma unroll
    for (int dt = 0; dt < W; ++dt) {
      const int tp = tl - W / 2 + dt; const bool ok = tp >= 0 && tp < L; const int tc = ok ? tp : tl; ff[dt] = ok ? 1.f : 0.f;
      zz[dt] = *(const GAS u32x4*)(Z + (size_t)(sbase + tc) * INW + 16 * kk);
    }
    float s[8];
#pragma unroll
    for (int j = 0; j < 8; ++j) s[j] = 0.f;
#pragma unroll
    for (int dt = 0; dt < W; ++dt) {
      const u32x4 z = zz[dt]; const float f = ff[dt];
      s[0] += f * bflo(z.x); s[1] += f * bfhi(z.x); s[2] += f * bflo(z.y); s[3] += f * bfhi(z.y); s[4] += f * bflo(z.z); s[5] += f * bfhi(z.z); s[6] += f * bflo(z.w); s[7] += f * bfhi(z.w);
    }
    const u32x4 z = zz[W / 2];
    u32x4 o;
    o.x = pk2(s[0] * inv - bflo(z.x), s[1] * inv - bfhi(z.x)); o.y = pk2(s[2] * inv - bflo(z.y), s[3] * inv - bfhi(z.y));
    o.z = pk2(s[4] * inv - bflo(z.z), s[5] * inv - bfhi(z.z)); o.w = pk2(s[6] * inv - bflo(z.w), s[7] * inv - bfhi(z.w));
    Af[kk] = __builtin_bit_cast(bf16x8, o);
  }
  const bf16_t* Wp = (const bf16_t*)(ws + OFF_W) + (size_t)layer * W_LAYER + W_P + (size_t)g * 16384;
  bf16_t* yc = (bf16_t*)(ws + OFF_YS) + (size_t)2 * T_ALL * 512;
#pragma unroll
  for (int nb = 0; nb < 4; ++nb) {
    f32x16 acc;
#pragma unroll
    for (int i = 0; i < 16; ++i) acc[i] = 0.f;
#pragma unroll
    for (int kk = 0; kk < 8; ++kk) { const bf16x8 Bf = *(const GAS bf16x8*)(Wp + (size_t)(nb * 32 + r32) * 128 + h * 8 + 16 * kk); acc = MFMA32(Af[kk], Bf, acc); }
    const int dcol = g * 128 + nb * 32 + r32;
    const float sc = gldf(p.in[28] + layer * 512 + dcol);
#pragma unroll
    for (int i = 0; i < 16; ++i) { const int row = 8 * (i >> 2) + 4 * h + (i & 3); *(GAS bf16_t*)(yc + (size_t)(t0 + row) * 512 + dcol) = (bf16_t)(pk2(acc[i] * sc, 0.f) & 0xffffu); }
  }
}
DI void pool_item(const Ctx& p, int layer, int item) {
  const int tid = opaque_tid(p.wv), lane = tid & 63, wave = __builtin_amdgcn_readfirstlane(tid >> 6);
  const int wi = item * 8 + wave, tt = wi >> 2, g = wi & 3, t0 = tt * 32;
  if (g == 0) pool_body<2>(p, layer, 0, t0, lane);
  else if (g == 1) pool_body<4>(p, layer, 1, t0, lane);
  else if (g == 2) pool_body<8>(p, layer, 2, t0, lane);
  else pool_body<16>(p, layer, 3, t0, lane);
}

DI void mixer_item(const Ctx& p, int layer, int it, LAS unsigned char* lds) {
  if (it < 128) s5_item(p, layer, true, it >> 5, it & 31, lds);
  else if (it < 192) { const int j = it - 128; s5_item(p, layer, false, j >> 3, j & 7, lds); }
  else if (it < 448) { const int j = it - 192; attn_item(p, layer, true, j >> 5, (j >> 3) & 3, j & 7, lds); }
  else if (it < 576) { const int j = it - 448; attn_item(p, layer, false, j >> 3, (j >> 1) & 3, j & 1, lds); }
  else pool_item(p, layer, it - 576);
}
DI void mixer_phase(const Ctx& p, int layer, LAS unsigned char* lds) {
  constexpr int NIT = 576 + 192;
  const int Gd = gridDim.x, w = blockIdx.x;
  for (int r = 0;; ++r) {
    const int it = r * Gd + ((r & 1) ? Gd - 1 - w : w);
    if (r * Gd >= NIT) break;
    if (it < NIT) mixer_item(p, layer, it, lds);
  }
}

#define XB_TMO      128
#define XB_XCNT(j)  (256  + 64 * (j))
#define XB_XSUB(j)  (1280 + 64 * (j))
#define XB_XGEN(j)  (2304 + 64 * (j))
#define XB_TOP      3328
#define XB_TOPGEN   3392
#define XCD_BAR_WORDS 3456
#define XB_SPIN_CAP (1u << 22)
DI unsigned xb_ld(unsigned* p)              { return __hip_atomic_load(p, __ATOMIC_RELAXED, __HIP_MEMORY_SCOPE_AGENT); }
DI unsigned xb_add(unsigned* p, unsigned v) { return __hip_atomic_fetch_add(p, v, __ATOMIC_RELAXED, __HIP_MEMORY_SCOPE_AGENT); }
DI unsigned xb_xcc_id() { return (unsigned)__builtin_amdgcn_s_getreg((3 << 11) | 20) & 0xFu; }
#define XB_SPIN(cond, bar) do { unsigned _sp = 0; while (cond) { __builtin_amdgcn_s_sleep(1); \
    if ((++_sp & 255u) == 0u) { if (xb_ld(&(bar)[XB_TMO])) break; if (_sp > XB_SPIN_CAP) { atomicAdd(&(bar)[XB_TMO], 1u); break; } } } } while (0)
struct XcdBarrier { unsigned* bar; unsigned x; volatile LAS unsigned* st; int wv; };
DI XcdBarrier xcd_barrier_post(unsigned* bar, volatile LAS unsigned* st) {
  XcdBarrier b; b.bar = bar; b.x = xb_xcc_id(); b.st = st; b.wv = 0;
  if (threadIdx.x == 0) (void)xb_add(&bar[XB_XCNT(b.x)], 1u);
  return b;
}
DI void xcd_barrier_complete(unsigned* bar, unsigned x, unsigned& nloc, unsigned& nx) {
  const unsigned G = gridDim.x * gridDim.y * gridDim.z;
  unsigned sum, cnt, mine, sp = 0u;
  for (;;) {
    sum = 0u; cnt = 0u; mine = 0u;
#pragma unroll
    for (unsigned j = 0; j < 16; ++j) { const unsigned c = xb_ld(&bar[XB_XCNT(j)]); sum += c; cnt += (c > 0u) ? 1u : 0u; mine = (j == x) ? c : mine; }
    if (sum == G) break;
    __builtin_amdgcn_s_sleep(1);
    if ((++sp & 255u) == 0u) { if (xb_ld(&bar[XB_TMO])) break; if (sp > XB_SPIN_CAP) { atomicAdd(&bar[XB_TMO], 1u); break; } }
  }
  nloc = mine > 0u ? mine : 1u; nx = cnt > 0u ? cnt : 1u;
}
DI void xcd_barrier(const XcdBarrier& b) {
  asm volatile("s_waitcnt vmcnt(0)" ::: "memory");
  __syncthreads();
  if (b.wv == 0 && __builtin_amdgcn_mbcnt_hi(~0u, __builtin_amdgcn_mbcnt_lo(~0u, 0u)) == 0u) {
    unsigned* bar = b.bar;
    __builtin_amdgcn_s_waitcnt(0);
    unsigned nloc = b.st[0], nx = b.st[1];
    if (nloc == 0u) { xcd_barrier_complete(bar, b.x, nloc, nx); b.st[0] = nloc; b.st[1] = nx; }
    const unsigned old = xb_add(&bar[XB_XSUB(b.x)], 1u);
    const unsigned gen = old / nloc;
    if (old + 1u == (gen + 1u) * nloc) {
      __builtin_amdgcn_fence(__ATOMIC_RELEASE, "agent");
      asm volatile("s_waitcnt vmcnt(0)" ::: "memory");
      const unsigned og = xb_add(&bar[XB_TOP], 1u);
      const unsigned tg = og / nx;
      if (og + 1u == (tg + 1u) * nx) xb_add(&bar[XB_TOPGEN], 1u);
      else XB_SPIN(xb_ld(&bar[XB_TOPGEN]) == tg, bar);
      __builtin_amdgcn_fence(__ATOMIC_ACQUIRE, "agent");
      xb_add(&bar[XB_XGEN(b.x)], 1u);
      asm volatile("s_waitcnt vmcnt(0)" ::: "memory");
    } else {
      XB_SPIN(xb_ld(&bar[XB_XGEN(b.x)]) == gen, bar);
      __builtin_amdgcn_fence(__ATOMIC_ACQUIRE, "agent");
      asm volatile("s_waitcnt vmcnt(0)" ::: "memory");
    }
  }
  __syncthreads();
}

__global__ void __launch_bounds__(512, 2) fwd_megakernel(Params p0) {
  extern __shared__ __attribute__((aligned(16))) unsigned char shm[];
  LAS unsigned char* lds = (LAS unsigned char*)shm;
  const int G = gridDim.x, c = blockIdx.x;
  const int wv0 = __builtin_amdgcn_readfirstlane((int)threadIdx.x >> 6);
  __shared__ uint4 xb_words;
  if (threadIdx.x == 0) xb_words = make_uint4(0u, 0u, 0u, 0u);
  __syncthreads();
  XcdBarrier xb = xcd_barrier_post((unsigned*)(p0.ws + OFF_BAR), (volatile LAS unsigned*)&xb_words); xb.wv = wv0;
  for (int phi = p0.ph_lo; phi < p0.ph_hi; ++phi) {
    int ph = phi; asm volatile("" : "+s"(ph));
    Ctx p; p.in.pp = &p0; p.out = p0.out; p.ws = p0.ws; p.wv = wv0;
    asm volatile("" : "+s"(p.out)); asm volatile("" : "+s"(p.ws));
    unsigned char* ws = p.ws;
    if (ph == 0) prep_phase(p, lds);
    else if (ph == NPH - 1) norm_phase(p, 0, 0, false, true);
    else {
      const int layer = (ph - 1) / 12, s = (ph - 1) % 12;
      const bf16_t* wl = (const bf16_t*)(ws + OFF_W) + (size_t)layer * W_LAYER;
      const float* modl = (const float*)(ws + OFF_MOD) + (size_t)layer * 9 * 9216;
      bf16_t* Nb = (bf16_t*)(ws + OFF_N); bf16_t* UH = (bf16_t*)(ws + OFF_UH); float* X = (float*)(ws + OFF_X);
      if (s == 0) norm_phase(p, layer, 0, layer == 0, false);
      else if (s == 3) norm_phase(p, layer, 1, false, false);
      else if (s == 9) norm_phase(p, layer, 2, false, false);
      else if (s == 1 || s == 10) {
        const int f = s == 10;
        if (layer < 3) { tr_slice(p, lds, layer + 1, f); __syncthreads(); }
        pg8::Gemm g{Nb, wl + W_FI + (size_t)f * 5632 * 1024, T_ALL, 5632, 1024};
        pg8::StaticOrder S; S.init(g.M, g.N, G, c);
        EpiSwiglu E{UH};
        pg8::gemm_phase(lds, g, S, E, p.wv);
      } else if (s == 2 || s == 11) {
        const int f = s == 11;
        pg8::Gemm g{UH, wl + W_FO + (size_t)f * 1024 * 2816, T_ALL, 1024, 2816};
        pg8::StaticOrder S; S.init(g.M, g.N, G, c);
        EpiResid E{X, modl, f ? 8 : 2, 0.5f};
        pg8::gemm_phase(lds, g, S, E, p.wv);
      } else if (s == 4) {
        pg8::Gemm g{Nb, wl + W_IN, T_ALL, 5632, 1024};
        pg8::StaticOrder S; S.init(g.M, g.N, G, c);
        EpiWin E{UH, (bf16_t*)(ws + OFF_Q), (bf16_t*)(ws + OFF_K), (bf16_t*)(ws + OFF_V), p.out + 12582912, p.out + 12582912 + 8388608, (const float*)(ws + OFF_ROPE), layer};
        pg8::gemm_phase(lds, g, S, E, p.wv);
      } else if (s == 5) {
        mixer_phase(p, layer, lds);
      } else if (s == 6) {
        pg8::Gemm g{(const bf16_t*)(ws + OFF_YA), wl + W_GLU, 4 * T_ALL, 3584, 512};
        pg8::MixAOrder S{G, c};
        EpiMix E{UH, (float*)(ws + OFF_YP), Nb, (const bf16_t*)(ws + OFF_YA), (bf16_t*)(ws + OFF_YS)};
        pg8::gemm_phase(lds, g, S, E, p.wv);
      } else if (s == 7) {
        pg8::Gemm g{(const bf16_t*)(ws + OFF_YA), wl + W_GLU, 4 * T_ALL, 3584, 512};
        pg8::MixBOrder S{G, c};
        EpiMix E{UH, (float*)(ws + OFF_YP), Nb, (const bf16_t*)(ws + OFF_YA), (bf16_t*)(ws + OFF_YS)};
        pg8::gemm_phase(lds, g, S, E, p.wv);
      } else if (s == 8) {
        pg8::Gemm g{Nb, wl + W_OUT, T_ALL, 1024, 1024};
        pg8::StaticOrder S; S.init(g.M, g.N, G, c);
        EpiResid E{X, modl, 5, 1.0f};
        pg8::gemm_phase(lds, g, S, E, p.wv);
      }
    }
    if (phi + 1 < p0.ph_hi) { if (phi == p0.ph_lo) cg::this_grid().sync(); else xcd_barrier(xb); }
  }
}

extern "C" void kernel_launch(void* const* d_in, const int* in_sizes, int n_in, void* d_out, int out_size, void* d_ws, size_t ws_size, hipStream_t stream) {
  static int grid = 0;
  if (grid == 0) {
    int dev = 0, cus = 0, per_cu = 0;
    hipGetDevice(&dev);
    hipDeviceGetAttribute(&cus, hipDeviceAttributeMultiprocessorCount, dev);
    if (hipFuncSetAttribute((const void*)fwd_megakernel, hipFuncAttributeMaxDynamicSharedMemorySize, LDS_BYTES) != hipSuccess) fprintf(stderr, "hipFuncSetAttribute failed\n");
    hipOccupancyMaxActiveBlocksPerMultiprocessor(&per_cu, (const void*)fwd_megakernel, 512, LDS_BYTES);
    if (per_cu < 1) { fprintf(stderr, "occupancy query gave %d\n", per_cu); per_cu = 1; }
    (void)hipGetLastError();
    grid = cus * per_cu;
    if (ws_size < WS_END) fprintf(stderr, "workspace too small: %zu\n", ws_size);
  }
  if (hipMemsetAsync((unsigned char*)d_ws + OFF_BAR, 0, 16384, stream) != hipSuccess) fprintf(stderr, "memset failed\n");
  Params p{};
  for (int i = 0; i < 32; ++i) p.in[i] = (const float*)d_in[i];
  p.out = (float*)d_out; p.ws = (unsigned char*)d_ws;
#if COOP
  p.ph_lo = 0; p.ph_hi = NPH;
  void* args[] = {&p};
  hipError_t e = hipLaunchCooperativeKernel((const void*)fwd_megakernel, dim3(grid), dim3(512), args, LDS_BYTES, stream);
  if (e != hipSuccess) fprintf(stderr, "cooperative launch failed: %s (grid %d)\n", hipGetErrorString(e), grid);
#else
  for (int ph = 0; ph < NPH; ++ph) {
    p.ph_lo = ph; p.ph_hi = ph + 1;
    hipLaunchKernelGGL(fwd_megakernel, dim3(grid), dim3(512), LDS_BYTES, stream, p);
  }
#endif
}
```
